# Optimizing an MI355X kernel written in HIP

```python
import jax, jax.numpy as jnp
from jax import lax
import numpy as np

D_MODEL = 1024
BATCH = 1
SEQ = 16384
DEPTH = 2

GRID_W = 64
CTX_LEN = 256
N_MIXERS = 2
N_HEADS = 8
N_KV_HEADS = 2
HEAD_DIM = 128
KV_GROUP = N_HEADS // N_KV_HEADS
ROPE_THETA = 10000.0
Q_BLOCK = 128
POOL_WINDOWS = (2, 4, 8, 16)
N_POOL_GROUPS = len(POOL_WINDOWS)
POOL_GROUP = D_MODEL // N_POOL_GROUPS
N_EXPERTS = 32
TOP_K = 4
D_FF_EXPERT = D_MODEL
SWIGLU_LIMIT = 7.0
SWIGLU_ALPHA = 1.702
NORM_EPS = 1e-6
N_MOD = 6

kernel_name = "hybrid_attn_pool_moe_dit_block"


def _rmsnorm(x, g):
    x32 = x.astype(jnp.float32)
    y = x32 * lax.rsqrt(jnp.mean(x32 * x32, axis=-1, keepdims=True) + NORM_EPS)
    return (y * g.astype(jnp.float32)).astype(x.dtype)


def _modulate(h, shift, scale):
    return h * (1 + scale) + shift


def _rope_1d(x, pos):
    half = x.shape[-1] // 2
    inv_freq = ROPE_THETA ** (-jnp.arange(half, dtype=jnp.float32) / half)
    ang = pos.astype(jnp.float32)[:, None] * inv_freq[None, :]
    cos = jnp.cos(ang)[:, None, :]
    sin = jnp.sin(ang)[:, None, :]
    x32 = x.astype(jnp.float32)
    x1, x2 = x32[..., :half], x32[..., half:]
    return jnp.concatenate([x1 * cos - x2 * sin, x2 * cos + x1 * sin], axis=-1).astype(x.dtype)


def _rope_2d(x, row, col):
    rd = HEAD_DIM // 2
    return jnp.concatenate([_rope_1d(x[..., :rd], row), _rope_1d(x[..., rd:], col)], axis=-1)


def _attend(q, k, v):
    s = jnp.einsum('bqkgd,btkd->bkgqt', q, k, preferred_element_type=jnp.float32) * (HEAD_DIM ** -0.5)
    p = jax.nn.softmax(s, axis=-1)
    o = jnp.einsum('bkgqt,btkd->bqkgd', p, v.astype(jnp.float32))
    return o.astype(v.dtype)


def _attention_mixer(h_lat, h_ctx, w_qkv, q_g, k_g, w_o, row, col, need_ctx_out):
    B, S, _ = h_lat.shape
    C = h_ctx.shape[1]

    def project(h):
        qkv = h @ w_qkv
        q, k, v = jnp.split(qkv, [N_HEADS * HEAD_DIM, (N_HEADS + N_KV_HEADS) * HEAD_DIM], axis=-1)
        q = _rmsnorm(q.reshape(B, -1, N_HEADS, HEAD_DIM), q_g)
        k = _rmsnorm(k.reshape(B, -1, N_KV_HEADS, HEAD_DIM), k_g)
        v = v.reshape(B, -1, N_KV_HEADS, HEAD_DIM)
        return q, k, v

    q_l, k_l, v_l = project(h_lat)
    q_c, k_c, v_c = project(h_ctx)
    q_l = _rope_2d(q_l, row, col)
    k_l = _rope_2d(k_l, row, col)
    k_all = jnp.concatenate([k_l, k_c], axis=1)
    v_all = jnp.concatenate([v_l, v_c], axis=1)

    n_blk = S // Q_BLOCK
    q_blocks = q_l.reshape(B, n_blk, Q_BLOCK, N_KV_HEADS, KV_GROUP, HEAD_DIM).transpose(1, 0, 2, 3, 4, 5)
    o_l = lax.map(lambda qb: _attend(qb, k_all, v_all), q_blocks)
    o_l = o_l.transpose(1, 0, 2, 3, 4, 5).reshape(B, S, N_HEADS * HEAD_DIM) @ w_o
    if need_ctx_out:
        o_c = _attend(q_c.reshape(B, C, N_KV_HEADS, KV_GROUP, HEAD_DIM), k_c, v_c)
        o_c = o_c.reshape(B, C, N_HEADS * HEAD_DIM) @ w_o
    else:
        o_c = None
    return o_l, o_c


def _pool_mixer(h, w_pool, scale):
    B, S, D = h.shape
    h32 = h.astype(jnp.float32)
    cs = jnp.concatenate([jnp.zeros((B, 1, D), jnp.float32), lax.cumsum(h32, axis=1)], axis=1)
    t = jnp.arange(S)
    outs = []
    for gi, w in enumerate(POOL_WINDOWS):
        lo = jnp.clip(t - w // 2, 0, S)
        hi = jnp.clip(t - w // 2 + w, 0, S)
        sl = slice(gi * POOL_GROUP, (gi + 1) * POOL_GROUP)
        csg = cs[:, :, sl]
        mean = (csg[:, hi, :] - csg[:, lo, :]) / (hi - lo).astype(jnp.float32)[None, :, None]
        outs.append(mean - h32[:, :, sl])
    pooled = jnp.concatenate(outs, axis=-1).astype(h.dtype).reshape(B, S, N_POOL_GROUPS, POOL_GROUP)
    y = jnp.einsum('bsgc,gcd->bsgd', pooled, w_pool).reshape(B, S, D)
    return y * scale


def _moe(h, router_w, router_b, w_gu, b_gu, w_down, b_down):
    logits = (h @ router_w + router_b).astype(jnp.float32)
    top_val, top_idx = lax.top_k(logits, TOP_K)
    top_w = jax.nn.softmax(top_val, axis=-1)
    gates = jnp.sum(jax.nn.one_hot(top_idx, N_EXPERTS, dtype=jnp.float32) * top_w[..., None], axis=1)

    def expert(acc, p):
        wgu, bgu, wd, bd, g = p
        gu = h @ wgu + bgu
        gate = jnp.minimum(gu[:, :D_FF_EXPERT], SWIGLU_LIMIT)
        up = jnp.clip(gu[:, D_FF_EXPERT:], -SWIGLU_LIMIT, SWIGLU_LIMIT)
        glu = gate * jax.nn.sigmoid(SWIGLU_ALPHA * gate)
        y = ((up + 1) * glu) @ wd + bd
        return acc + g[:, None].astype(acc.dtype) * y, None

    out, _ = lax.scan(expert, jnp.zeros_like(h), (w_gu, b_gu, w_down, b_down, gates.T))
    return out


def setup_inputs(seed: int = 0) -> dict:
    key = jax.random.key(seed)
    ks = jax.random.split(key, 24)
    f32 = jnp.float32

    def nrm(k, shape, s):
        return jax.random.normal(k, shape, f32) * s

    n_attn = len([i for i in range(DEPTH) if i % N_MIXERS == 0])
    n_pool = DEPTH - n_attn
    D, E, F = D_MODEL, N_EXPERTS, D_FF_EXPERT
    qkv_w = (N_HEADS + 2 * N_KV_HEADS) * HEAD_DIM
    return {
        "x": nrm(ks[0], (BATCH, SEQ, D), 1.0),
        "c": nrm(ks[1], (BATCH, D), 1.0),
        "ctx": nrm(ks[2], (BATCH, CTX_LEN, D), 1.0),
        "c_ctx": nrm(ks[3], (D,), 1.0),
        "ada_w": nrm(ks[4], (DEPTH, D, N_MOD * D), 0.5 * D ** -0.5),
        "ada_b": nrm(ks[5], (DEPTH, N_MOD * D), 0.01),
        "norm_mix": 1.0 + nrm(ks[6], (DEPTH, D), 0.05),
        "norm_ffn": 1.0 + nrm(ks[7], (DEPTH, D), 0.05),
        "attn_w_qkv": nrm(ks[8], (n_attn, D, qkv_w), D ** -0.5),
        "attn_q_norm": 1.0 + nrm(ks[9], (n_attn, HEAD_DIM), 0.05),
        "attn_k_norm": 1.0 + nrm(ks[10], (n_attn, HEAD_DIM), 0.05),
        "attn_w_o": nrm(ks[11], (n_attn, N_HEADS * HEAD_DIM, D), (N_HEADS * HEAD_DIM) ** -0.5),
        "pool_w": nrm(ks[12], (n_pool, N_POOL_GROUPS, POOL_GROUP, POOL_GROUP), POOL_GROUP ** -0.5),
        "pool_scale": 1.0 + nrm(ks[13], (n_pool, D), 0.1),
        "moe_router_w": nrm(ks[14], (DEPTH, D, E), D ** -0.5),
        "moe_router_b": nrm(ks[15], (DEPTH, E), 0.01),
        "moe_w_gu": nrm(ks[16], (DEPTH, E, D, 2 * F), D ** -0.5),
        "moe_b_gu": nrm(ks[17], (DEPTH, E, 2 * F), 0.01),
        "moe_w_down": nrm(ks[18], (DEPTH, E, F, D), F ** -0.5),
        "moe_b_down": nrm(ks[19], (DEPTH, E, D), 0.01),
        "final_norm": 1.0 + nrm(ks[20], (D,), 0.05),
    }


def reference(x, c, ctx, c_ctx, ada_w, ada_b, norm_mix, norm_ffn, attn_w_qkv, attn_q_norm, attn_k_norm,
              attn_w_o, pool_w, pool_scale, moe_router_w, moe_router_b, moe_w_gu, moe_b_gu, moe_w_down,
              moe_b_down, final_norm):
    B, S, D = x.shape
    C = ctx.shape[1]
    ROWS = S // GRID_W
    row = jnp.repeat(jnp.arange(ROWS), GRID_W)
    col = jnp.tile(jnp.arange(GRID_W), ROWS)

    x_lat, x_ctx = x, ctx
    for i in range(DEPTH):
        kind = i % N_MIXERS
        mix_idx = i // N_MIXERS
        ctx_needed = any((j % N_MIXERS) == 0 for j in range(i + 1, DEPTH))

        m_l = jax.nn.silu(c) @ ada_w[i] + ada_b[i]
        m_c = jax.nn.silu(c_ctx) @ ada_w[i] + ada_b[i]
        sh_l, sc_l, g_l, shf_l, scf_l, gf_l = jnp.split(m_l[:, None, :], N_MOD, axis=-1)
        sh_c, sc_c, g_c, shf_c, scf_c, gf_c = jnp.split(m_c[None, None, :], N_MOD, axis=-1)

        h_l = _modulate(_rmsnorm(x_lat, norm_mix[i]), sh_l, sc_l)
        h_c = _modulate(_rmsnorm(x_ctx, norm_mix[i]), sh_c, sc_c)
        if kind == 0:
            y_l, y_c = _attention_mixer(h_l, h_c, attn_w_qkv[mix_idx], attn_q_norm[mix_idx],
                                        attn_k_norm[mix_idx], attn_w_o[mix_idx], row, col, ctx_needed)
        else:
            y_l = _pool_mixer(h_l, pool_w[mix_idx], pool_scale[mix_idx])
            y_c = _pool_mixer(h_c, pool_w[mix_idx], pool_scale[mix_idx]) if ctx_needed else None
        x_lat = x_lat + g_l * y_l
        if ctx_needed:
            x_ctx = x_ctx + g_c * y_c

        hf_l = _modulate(_rmsnorm(x_lat, norm_ffn[i]), shf_l, scf_l).reshape(B * S, D)
        moe_args = (moe_router_w[i], moe_router_b[i], moe_w_gu[i], moe_b_gu[i], moe_w_down[i], moe_b_down[i])
        if ctx_needed:
            hf_c = _modulate(_rmsnorm(x_ctx, norm_ffn[i]), shf_c, scf_c).reshape(B * C, D)
            f = _moe(jnp.concatenate([hf_l, hf_c], axis=0), *moe_args)
            x_lat = x_lat + gf_l * f[:B * S].reshape(B, S, D)
            x_ctx = x_ctx + gf_c * f[B * S:].reshape(B, C, D)
        else:
            f = _moe(hf_l, *moe_args)
            x_lat = x_lat + gf_l * f.reshape(B, S, D)

    return _rmsnorm(x_lat, final_norm)
```

```cpp
#include <hip/hip_runtime.h>
#include <cstdio>
#include <cstdint>

#ifndef MK_N_LAUNCHES
#define MK_N_LAUNCHES 1
#endif
#ifndef PROBE_REP
#define PROBE_REP -1
#endif

#define GAS __attribute__((address_space(1)))
#define LAS __attribute__((address_space(3)))
typedef unsigned short bf16;
typedef unsigned v4u __attribute__((ext_vector_type(4)));
typedef unsigned v2u __attribute__((ext_vector_type(2)));
typedef int v4i __attribute__((ext_vector_type(4)));
typedef float f32x4 __attribute__((ext_vector_type(4)));
typedef float f32x2 __attribute__((ext_vector_type(2)));
typedef float f32x16 __attribute__((ext_vector_type(16)));
typedef short bf16x8 __attribute__((ext_vector_type(8)));
typedef short s16x4 __attribute__((ext_vector_type(4)));
typedef int v8i __attribute__((ext_vector_type(8)));

constexpr int S = 16384, CT = 256, NTOK = S + CT, D = 1024, NQKV = 1536, NE = 32, HD = 128, NH = 8, NKV = 2;
constexpr int GRID_W = 64;
constexpr float NORM_EPS = 1e-6f;
constexpr int NPHASE = 15;
constexpr float WSCALE = 32.0f;
enum Phase { PH_PRO = 0, PH_NORM1, PH_QKV, PH_QKROPE, PH_ATTN, PH_WO, PH_ROUTE0, PH_MOE1_0, PH_MOE2_0, PH_COMB0, PH_POOLG, PH_ROUTE1, PH_MOE1_1, PH_MOE2_1, PH_FINAL };

constexpr size_t MiB = 1u << 20;
constexpr size_t WS_CTL = 0, CTL_ZERO_BYTES = 1 * MiB;
constexpr size_t WS_MOD = 1 * MiB;
constexpr size_t WS_WQKV = 2 * MiB;
constexpr size_t WS_WO = 5 * MiB;
constexpr size_t WS_WPOOL = 7 * MiB;
constexpr size_t WS_TOKLIST = 8 * MiB;
constexpr size_t WS_TOKE = 10 * MiB;
constexpr size_t WS_TOKP = 10 * MiB + 256 * 1024;
constexpr size_t WS_TOKW = 10 * MiB + 512 * 1024;
constexpr size_t WS_H = 16 * MiB;
constexpr size_t WS_QKV = 52 * MiB;
constexpr size_t WS_O = 104 * MiB;
constexpr size_t WS_XA = 136 * MiB;
constexpr size_t WS_XB = 200 * MiB;
constexpr size_t WS_XC = 264 * MiB;
constexpr size_t WS_H1F = 328 * MiB;
constexpr size_t WS_POOLED = 392 * MiB;
constexpr size_t WS_ACT = 424 * MiB;
constexpr size_t WS_Y = 568 * MiB;
constexpr size_t WS_WGU = 712 * MiB;
constexpr size_t WS_WD = 968 * MiB;
constexpr size_t WS_Q8 = 1040 * MiB;
constexpr size_t WS_K8 = 1056 * MiB;
constexpr size_t WS_VT8 = 1062 * MiB;
constexpr size_t WS_END = 1096 * MiB;
constexpr int CW_BAR = 4096;
constexpr int CW_CNT = 8192;

constexpr int RING_BYTES = 131072;
constexpr int MISC_OFF = RING_BYTES;
constexpr int L_LCNT = MISC_OFF + 64;
constexpr int L_LBASE = MISC_OFF + 192;
constexpr int L_TB = MISC_OFF + 320;
constexpr int L_CNT = MISC_OFF + 480;
constexpr int L_UT = MISC_OFF + 640;
constexpr int L_ENT = MISC_OFF + 1280;
constexpr int L_OFFS = MISC_OFF + 4608;
constexpr int LDS_BYTES = MISC_OFF + 4608 + 16384 + 256;
static_assert(LDS_BYTES <= 163840, "LDS");

#define RLX_AGENT __ATOMIC_RELAXED, __HIP_MEMORY_SCOPE_AGENT
#define LDS_WAIT() asm volatile("s_waitcnt lgkmcnt(0)" ::: "memory")
#define VM_WAIT() asm volatile("s_waitcnt vmcnt(0)" ::: "memory")

__device__ __forceinline__ int fresh_lane() { int l; asm volatile("v_mbcnt_lo_u32_b32 %0, -1, 0\n\tv_mbcnt_hi_u32_b32 %0, -1, %0" : "=v"(l)); return l; }
__device__ __forceinline__ unsigned cvt_pk_bf16(float lo, float hi) { unsigned r; asm volatile("v_cvt_pk_bf16_f32 %0, %1, %2" : "=v"(r) : "v"(lo), "v"(hi)); return r; }
__device__ __forceinline__ unsigned cvt_pk_fp8x4(float a, float b, float c, float d) { int w = 0; w = __builtin_amdgcn_cvt_pk_fp8_f32(a, b, w, false); w = __builtin_amdgcn_cvt_pk_fp8_f32(c, d, w, true); return (unsigned)w; }
__device__ __forceinline__ float bf_lo(unsigned w) { return __uint_as_float(w << 16); }
__device__ __forceinline__ float bf_hi(unsigned w) { return __uint_as_float(w & 0xffff0000u); }
__device__ __forceinline__ float wave_sum(float v) {
#pragma unroll
    for (int o = 32; o >= 1; o >>= 1) v += __shfl_xor(v, o);
    return v;
}
__device__ __forceinline__ float wave_max(float v) {
#pragma unroll
    for (int o = 32; o >= 1; o >>= 1) v = fmaxf(v, __shfl_xor(v, o));
    return v;
}

#define XB_TMO      128
#define XB_XCNT(j)  (256  + 64 * (j))
#define XB_XSUB(j)  (1280 + 64 * (j))
#define XB_XGEN(j)  (2304 + 64 * (j))
#define XB_TOP      3328
#define XB_TOPGEN   3392
#define XCD_BAR_WORDS 3456
#define XB_SPIN_CAP (1u << 18)
__device__ __forceinline__ unsigned xb_ld(unsigned* p)              { return __hip_atomic_load(p, __ATOMIC_RELAXED, __HIP_MEMORY_SCOPE_AGENT); }
__device__ __forceinline__ unsigned xb_add(unsigned* p, unsigned v) { return __hip_atomic_fetch_add(p, v, __ATOMIC_RELAXED, __HIP_MEMORY_SCOPE_AGENT); }
__device__ __forceinline__ unsigned xb_xcc_id() { return (unsigned)__builtin_amdgcn_s_getreg((3 << 11) | 20) & 0xFu; }
#define XB_SPIN(cond, bar) do { unsigned _sp = 0; while (cond) { __builtin_amdgcn_s_sleep(1); \
    if ((++_sp & 255u) == 0u) { if (xb_ld(&(bar)[XB_TMO])) break; if (_sp > XB_SPIN_CAP) { atomicAdd(&(bar)[XB_TMO], 1u); break; } } } } while (0)
struct XcdBarrier { unsigned* bar; unsigned x; volatile LAS unsigned* st; int wave; };
__device__ __forceinline__ XcdBarrier xcd_barrier_post(unsigned* bar, volatile LAS unsigned* st, int wave) {
    XcdBarrier b; b.bar = bar; b.x = xb_xcc_id(); b.st = st; b.wave = wave;
    if (wave == 0 && fresh_lane() == 0) (void)xb_add(&bar[XB_XCNT(b.x)], 1u);
    return b;
}
__device__ __forceinline__ void xcd_barrier_complete(unsigned* bar, unsigned x, unsigned& nloc, unsigned& nx) {
    const unsigned G = gridDim.x * gridDim.y * gridDim.z;
    unsigned sum, cnt, mine, sp = 0u;
    for (;;) {
        sum = 0u; cnt = 0u; mine = 0u;
#pragma unroll
        for (unsigned j = 0; j < 16; ++j) { const unsigned c = xb_ld(&bar[XB_XCNT(j)]); sum += c; cnt += (c > 0u) ? 1u : 0u; mine = (j == x) ? c : mine; }
        if (sum == G) break;
        __builtin_amdgcn_s_sleep(1);
        if ((++sp & 255u) == 0u) { if (xb_ld(&bar[XB_TMO])) break; if (sp > XB_SPIN_CAP) { atomicAdd(&bar[XB_TMO], 1u); break; } }
    }
    nloc = mine > 0u ? mine : 1u; nx = cnt > 0u ? cnt : 1u;
}
__device__ __forceinline__ void xcd_barrier(const XcdBarrier& b) {
    asm volatile("s_waitcnt vmcnt(0)" ::: "memory");
    __syncthreads();
    if (b.wave == 0 && fresh_lane() == 0) {
        unsigned* bar = b.bar;
        __builtin_amdgcn_s_waitcnt(0);
        unsigned nloc = b.st[0], nx = b.st[1];
        if (nloc == 0u) { xcd_barrier_complete(bar, b.x, nloc, nx); b.st[0] = nloc; b.st[1] = nx; }
        const unsigned old = xb_add(&bar[XB_XSUB(b.x)], 1u);
        const unsigned gen = old / nloc;
        if (old + 1u == (gen + 1u) * nloc) {
            __builtin_amdgcn_fence(__ATOMIC_RELEASE, "agent");
            asm volatile("s_waitcnt vmcnt(0)" ::: "memory");
            const unsigned og = xb_add(&bar[XB_TOP], 1u);
            const unsigned tg = og / nx;
            if (og + 1u == (tg + 1u) * nx) xb_add(&bar[XB_TOPGEN], 1u);
            else XB_SPIN(xb_ld(&bar[XB_TOPGEN]) == tg, bar);
            __builtin_amdgcn_fence(__ATOMIC_ACQUIRE, "agent");
            xb_add(&bar[XB_XGEN(b.x)], 1u);
            asm volatile("s_waitcnt vmcnt(0)" ::: "memory");
        } else {
            XB_SPIN(xb_ld(&bar[XB_XGEN(b.x)]) == gen, bar);
            __builtin_amdgcn_fence(__ATOMIC_ACQUIRE, "agent");
            asm volatile("s_waitcnt vmcnt(0)" ::: "memory");
        }
    }
    __syncthreads();
}

namespace pg8 {
constexpr int BM = 256, BK = 64, HALF = 128, HTB = HALF * BK * 2, NXCD = 8, WGM = 8;
__device__ __forceinline__ int lds_byte(int r, int c) { const int st = (r >> 4) * 2 + (c >> 5), rr = r & 15, cc = c & 31, ob = rr * 64 + cc * 2; return st * 1024 + (ob ^ (((ob >> 9) & 1) << 5)); }
__device__ __forceinline__ void stage_rc(int b, int& R, int& C) { const int st = b / 1024, sb = b % 1024, swz = sb ^ (((sb >> 9) & 1) << 5); R = (st >> 1) * 16 + swz / 64; C = (st & 1) * 32 + (swz % 64) / 2; }
__device__ __forceinline__ int perm32(int rho) { const int n = rho >> 4, i = rho & 15; return 8 * (i >> 2) + 4 * n + (i & 3); }

struct GU { const char* A; const char* B; int orow0; int pn; int e; int slot; };

template <int ESZ_> struct ProbDense {
    static constexpr int ESZ = ESZ_; static constexpr bool BIL = false; static constexpr int nB = 0;
    const unsigned char* A; const unsigned char* Bt; int lda, ldb, K, acol; int nM, nN, nwg, G, c;
    __device__ __forceinline__ void init(const void* A_, const void* Bt_, int M, int N, int K_, int lda_, int ldb_, int acol_, int G_, int c_) {
        A = (const unsigned char*)A_; Bt = (const unsigned char*)Bt_; lda = lda_; ldb = ldb_; K = K_; acol = acol_; nM = M / BM; nN = N / BM; nwg = nM * nN; G = G_; c = c_; }
    __device__ __forceinline__ bool next(int i, GU& u) const {
        const long L = (long)i * G + c; if (L >= nwg) return false;
        int wgid = (int)L; { const int q = nwg / NXCD, r = nwg % NXCD, xcd = wgid % NXCD, off = wgid / NXCD; wgid = (xcd < r ? xcd * (q + 1) : r * (q + 1) + (xcd - r) * q) + off; }
        const int nig = WGM * nN, gid = wgid / nig, fm = gid * WGM, gsz = (nM - fm) < WGM ? (nM - fm) : WGM;
        const int pm = fm + ((wgid % nig) % gsz), pn = (wgid % nig) / gsz;
        u.A = (const char*)(A + ((size_t)pm * BM * lda + (size_t)pn * acol) * ESZ); u.B = (const char*)(Bt + (size_t)pn * BM * ldb * ESZ); u.orow0 = pm * BM; u.pn = pn; u.e = 0; u.slot = i; return true;
    }
    __device__ __forceinline__ void a_offs(const GU&, const int (&R)[2], const int (&C)[2], unsigned (&vo)[2][2], LAS unsigned char*) const {
#pragma unroll
        for (int h = 0; h < 2; ++h)
#pragma unroll
            for (int i = 0; i < 2; ++i) vo[h][i] = (unsigned)((R[i] + HALF * h) * lda * ESZ + C[i] * 2);
    }
};
template <bool GATHER, int ESZ_> struct ProbMoE {
    static constexpr int ESZ = ESZ_; static constexpr bool BIL = true;
    const unsigned char* A; const unsigned char* Bt; int ldb, K; int n_my; size_t b_expert_stride  ; LAS unsigned char* ldsp; int nB;
    __device__ __forceinline__ bool next(int i, GU& u) const {
        if (i >= n_my) return false;
        const LAS int* ut = (const LAS int*)(ldsp + L_UT) + i * 8;
        const int e = __builtin_amdgcn_readfirstlane(ut[0]), pn = __builtin_amdgcn_readfirstlane(ut[2]), mtg = __builtin_amdgcn_readfirstlane(ut[3]);
        u.e = e; u.pn = pn; u.orow0 = mtg * BM; u.slot = i;
        u.A = GATHER ? (const char*)A : (const char*)(A + (size_t)mtg * BM * D * ESZ);
        u.B = (const char*)(Bt + (size_t)e * b_expert_stride + (size_t)pn * BM * 16);
        return true;
    }
    __device__ __forceinline__ void a_offs(const GU& u, const int (&R)[2], const int (&C)[2], unsigned (&vo)[2][2], LAS unsigned char* lds) const {
        if (GATHER) {
            const LAS unsigned* offs = (const LAS unsigned*)(lds + L_OFFS) + u.slot * 256;
#pragma unroll
            for (int h = 0; h < 2; ++h)
#pragma unroll
                for (int i = 0; i < 2; ++i) vo[h][i] = offs[R[i] + HALF * h] + (unsigned)C[i] * 2u;
        } else {
#pragma unroll
            for (int h = 0; h < 2; ++h)
#pragma unroll
                for (int i = 0; i < 2; ++i) vo[h][i] = (unsigned)((R[i] + HALF * h) * D * ESZ + C[i] * 2);
        }
    }
};

typedef f32x4 Acc[2][2][4][2];

struct EpiBf16 {
    static constexpr bool PERM = true;
    bf16* O; int ldc; const float* bias; int bias_stride; float scale;
    __device__ __forceinline__ void operator()(const Acc& acc, const GU& u, int wr, int wc, int fr, int fq) const {
        const int row0 = u.orow0 + wr * 64 + fr, col0 = u.pn * BM + wc * 32 + 8 * fq;
        f32x4 bv[2][2];
#pragma unroll
        for (int bj = 0; bj < 2; ++bj)
#pragma unroll
            for (int n = 0; n < 2; ++n) bv[bj][n] = bias ? *(const f32x4*)(bias + (size_t)u.e * bias_stride + col0 + bj * HALF + 4 * n) : (f32x4){0.f, 0.f, 0.f, 0.f};
#pragma unroll
        for (int ai = 0; ai < 2; ++ai)
#pragma unroll
            for (int m = 0; m < 4; ++m) { bf16* rowp = O + (size_t)(row0 + ai * HALF + m * 16) * ldc + col0;
#pragma unroll
                for (int bj = 0; bj < 2; ++bj) { const f32x4 v0 = acc[ai][bj][m][0] * scale + bv[bj][0], v1 = acc[ai][bj][m][1] * scale + bv[bj][1];
                    v4u w; w.x = cvt_pk_bf16(v0[0], v0[1]); w.y = cvt_pk_bf16(v0[2], v0[3]); w.z = cvt_pk_bf16(v1[0], v1[1]); w.w = cvt_pk_bf16(v1[2], v1[3]);
                    *(v4u*)(rowp + bj * HALF) = w; } }
    }
};
struct EpiResid {
    static constexpr bool PERM = false;
    const float* Base; float* Out; const float* gate; const float* gate2;
    __device__ __forceinline__ void operator()(const Acc& acc, const GU& u, int wr, int wc, int fr, int fq) const {
        const int row0 = u.orow0 + wr * 64 + fr, col0 = u.pn * BM + wc * 32 + 4 * fq;
#pragma unroll
        for (int bj = 0; bj < 2; ++bj)
#pragma unroll
            for (int n = 0; n < 2; ++n) { const int col = col0 + bj * HALF + n * 16;
                f32x4 gv = *(const f32x4*)(gate + col); if (gate2) gv = gv * *(const f32x4*)(gate2 + col);
#pragma unroll
                for (int ai = 0; ai < 2; ++ai) {
#pragma unroll
                    for (int m = 0; m < 4; ++m) { const size_t off = (size_t)(row0 + ai * HALF + m * 16) * D + col;
                        const f32x4 b4 = *(const f32x4*)(Base + off); *(f32x4*)(Out + off) = b4 + gv * acc[ai][bj][m][n]; }
                    asm volatile("" ::: "memory"); } }
    }
};
struct EpiSwiglu {
    static constexpr bool PERM = true;
    unsigned char* O; const float* bias; float scale;
    __device__ __forceinline__ void operator()(const Acc& acc, const GU& u, int wr, int wc, int fr, int fq) const {
        const int row0 = u.orow0 + wr * 64 + fr, c0 = u.pn * HALF + wc * 32 + 8 * fq;
        const float* bp = bias + (size_t)u.e * 2048 + c0;
        f32x4 bg[2], bu[2];
#pragma unroll
        for (int n = 0; n < 2; ++n) { bg[n] = *(const f32x4*)(bp + 4 * n); bu[n] = *(const f32x4*)(bp + 1024 + 4 * n); }
#pragma unroll
        for (int ai = 0; ai < 2; ++ai)
#pragma unroll
            for (int m = 0; m < 4; ++m) { unsigned char* rowp = O + (size_t)(row0 + ai * HALF + m * 16) * D + c0;
                float r[8];
#pragma unroll
                for (int n = 0; n < 2; ++n) { const f32x4 g4 = acc[ai][0][m][n] * scale + bg[n], u4 = acc[ai][1][m][n] * scale + bu[n];
#pragma unroll
                    for (int j = 0; j < 4; ++j) { const float g = fminf(g4[j], 7.0f), up = fminf(fmaxf(u4[j], -7.0f), 7.0f);
                        const float sg = __builtin_amdgcn_rcpf(1.0f + __builtin_amdgcn_exp2f(g * (-1.702f * 1.4426950408889634f)));
                        r[n * 4 + j] = (up + 1.0f) * (g * sg); } }
                v2u w; w.x = cvt_pk_fp8x4(r[0], r[1], r[2], r[3]); w.y = cvt_pk_fp8x4(r[4], r[5], r[6], r[7]);
                *(v2u*)rowp = w; }
    }
};

__device__ __forceinline__ const char* uni(const char* p) {
    const unsigned long long v = (unsigned long long)p; const unsigned lo = __builtin_amdgcn_readfirstlane((unsigned)v), hi = __builtin_amdgcn_readfirstlane((unsigned)(v >> 32));
    return (const char*)(((unsigned long long)hi << 32) | lo); }
template <int ESZ> struct FragT;
template <> struct FragT<2> { struct T { bf16x8 k0, k1; };
    static __device__ __forceinline__ T ld(const LAS v4i* p) { T r; r.k0 = __builtin_bit_cast(bf16x8, p[0]); r.k1 = __builtin_bit_cast(bf16x8, p[64]); return r; }
    template <int KK> static __device__ __forceinline__ void mma(const T& b, const T& a, f32x4& c) {
        if (KK == 0) asm volatile("v_mfma_f32_16x16x32_bf16 %0, %1, %2, %0" : "+v"(c) : "v"(b.k0), "v"(a.k0));
        else asm volatile("v_mfma_f32_16x16x32_bf16 %0, %1, %2, %0" : "+v"(c) : "v"(b.k1), "v"(a.k1)); }
    static constexpr int NK = 2; };
template <> struct FragT<1> { typedef v8i T;
    static __device__ __forceinline__ T ld(const LAS v4i* p) { const v4i lo = p[0], hi = p[64]; return __builtin_shufflevector(lo, hi, 0, 1, 2, 3, 4, 5, 6, 7); }
    template <int KK> static __device__ __forceinline__ void mma(const T& b, const T& a, f32x4& c) { asm volatile("v_mfma_f32_16x16x128_f8f6f4 %0, %1, %2, %0" : "+v"(c) : "v"(b), "v"(a)); }
    static constexpr int NK = 1; };

template <class Prob, class Epi>
__device__ __forceinline__ void gemm_phase(LAS unsigned char* lds, const Prob& P, const Epi& E, const int wid) {
    const int lane = fresh_lane(), tid = wid * 64 + lane, wr = wid >> 2, wc = wid & 3, fr = lane & 15, fq = lane >> 4;
    constexpr int ESZ = Prob::ESZ;
    const int K = P.K, nt = K * ESZ / (BK * 2);
    int R[2], C[2]; unsigned voffB[2];
#pragma unroll
    for (int i = 0; i < 2; ++i) { stage_rc(tid * 16 + i * 8192, R[i], C[i]); const int Rb = Epi::PERM ? ((R[i] & ~31) + perm32(R[i] & 31)) : R[i];
        voffB[i] = Prob::BIL ? (unsigned)((C[i] * 2 / 16) * (P.nB * 16) + Rb * 16) : (unsigned)(Rb * P.ldb * ESZ + C[i] * 2); }
    const size_t kstep = (size_t)(BK * 2);
    const size_t kstepB = Prob::BIL ? (size_t)8 * P.nB * 16 : kstep;
    const size_t hstepB = Prob::BIL ? (size_t)HALF * 16 : (size_t)HALF * P.ldb * ESZ;
    const unsigned ldsw = (unsigned)wid * 1024u;
    const int aoff = lds_byte(wr * 64 + fr, fq * 8), boff = lds_byte(wc * 32 + fr, fq * 8);
#define PG8_SA(b, h) (((b) * 2 + (h)) * HTB)
#define PG8_SB(b, h) ((4 + (b) * 2 + (h)) * HTB)
#define PG8_STAGE(bufoff, gbase, voff) do { _Pragma("unroll") for (int _i = 0; _i < 2; ++_i) { unsigned o_ = (voff)[_i]; asm volatile("" : "+v"(o_));     \
        __builtin_amdgcn_global_load_lds((const unsigned*)((const char*)(gbase) + o_), (LAS unsigned*)(lds + (bufoff) + ldsw + _i * 8192), 16, 0, 0); } } while (0)
#define PG8_LD2(p) FragT<ESZ>::ld((const LAS v4i*)(p))
#define PG8_LDA(dst, b, h) do { _Pragma("unroll") for (int m = 0; m < 4; ++m) dst[m] = PG8_LD2(lds + PG8_SA(b, h) + aoff + m * 2048); } while (0)
#define PG8_LDB(dst, b, h) do { _Pragma("unroll") for (int n = 0; n < 2; ++n) dst[n] = PG8_LD2(lds + PG8_SB(b, h) + boff + n * 2048); } while (0)
#define PG8_MMA(ai, bj, At, Bt) do { __builtin_amdgcn_s_setprio(1); \
        _Pragma("unroll") for (int m = 0; m < 4; ++m) _Pragma("unroll") for (int n = 0; n < 2; ++n) FragT<ESZ>::template mma<0>(Bt[n], At[m], acc[ai][bj][m][n]); \
        if constexpr (FragT<ESZ>::NK == 2) { _Pragma("unroll") for (int m = 0; m < 4; ++m) _Pragma("unroll") for (int n = 0; n < 2; ++n) FragT<ESZ>::template mma<1>(Bt[n], At[m], acc[ai][bj][m][n]); } \
        __builtin_amdgcn_s_setprio(0); } while (0)
#define PG8_WAIT_V(n) asm volatile("s_waitcnt vmcnt(" #n ")" ::: "memory")
#define PG8_WAIT_L(n) asm volatile("s_waitcnt lgkmcnt(" #n ")" ::: "memory")
#define PG8_BAR __builtin_amdgcn_s_barrier()
#define PG8_SCHED __builtin_amdgcn_sched_barrier(0)
    GU cur, nxt; int ui = 0;
    if (!P.next(0, cur)) return;
    Acc acc;
#pragma unroll
    for (int a = 0; a < 2; ++a)
#pragma unroll
        for (int b = 0; b < 2; ++b)
#pragma unroll
            for (int m = 0; m < 4; ++m)
#pragma unroll
                for (int n = 0; n < 2; ++n) acc[a][b][m][n] = (f32x4){0.f, 0.f, 0.f, 0.f};
    typename FragT<ESZ>::T At[4], B0[2], B1[2];
    unsigned cvo[2][2];
    P.a_offs(cur, R, C, cvo, lds);
    const char* cA = uni(cur.A); const char* cB = uni(cur.B);
    PG8_STAGE(PG8_SB(0, 0), cB, voffB); PG8_STAGE(PG8_SB(0, 1), cB + hstepB, voffB); PG8_STAGE(PG8_SA(0, 0), cA, cvo[0]); PG8_STAGE(PG8_SA(0, 1), cA, cvo[1]);
    if (wr == 1) PG8_BAR;
    PG8_WAIT_V(2); PG8_BAR;
    PG8_STAGE(PG8_SB(1, 0), cB + kstepB, voffB); PG8_STAGE(PG8_SA(1, 0), cA + kstep, cvo[0]); PG8_STAGE(PG8_SB(1, 1), cB + hstepB + kstepB, voffB);
    PG8_WAIT_V(6); PG8_BAR;
    for (;;) {
        const bool has_next = P.next(ui + 1, nxt);
        const char* nA = uni(has_next ? nxt.A : cA); const char* nB = uni(has_next ? nxt.B : cB);
#define PG8_KBODY(VA2) do { \
              \
            PG8_LDB(B0, 0, 0); PG8_LDB(B1, 0, 1); PG8_SCHED; PG8_LDA(At, 0, 0); PG8_STAGE(PG8_SA(1, 1), a1, cvo[1]); \
            PG8_WAIT_V(8); PG8_WAIT_L(0); PG8_BAR; PG8_MMA(0, 0, At, B0); PG8_MMA(0, 1, At, B1); PG8_BAR; PG8_SCHED; \
              \
            PG8_LDA(At, 0, 1); PG8_STAGE(PG8_SB(0, 0), b2, voffB); PG8_STAGE(PG8_SB(0, 1), b2 + hstepB, voffB); PG8_STAGE(PG8_SA(0, 0), a2, VA2[0]); \
            PG8_WAIT_V(8); PG8_WAIT_L(0); PG8_BAR; PG8_MMA(1, 0, At, B0); PG8_MMA(1, 1, At, B1); PG8_BAR; PG8_SCHED; \
              \
            PG8_LDB(B0, 1, 0); PG8_LDB(B1, 1, 1); PG8_SCHED; PG8_LDA(At, 1, 0); PG8_STAGE(PG8_SA(0, 1), a2, VA2[1]); \
            PG8_WAIT_V(8); PG8_WAIT_L(0); PG8_BAR; PG8_MMA(0, 0, At, B0); PG8_MMA(0, 1, At, B1); PG8_BAR; PG8_SCHED; \
              \
            PG8_LDA(At, 1, 1); PG8_STAGE(PG8_SB(1, 0), b3, voffB); PG8_STAGE(PG8_SB(1, 1), b3 + hstepB, voffB); PG8_STAGE(PG8_SA(1, 0), a3, VA2[0]); \
            PG8_WAIT_V(8); PG8_WAIT_L(0); PG8_BAR; PG8_MMA(1, 0, At, B0); PG8_MMA(1, 1, At, B1); PG8_BAR; PG8_SCHED; } while (0)
        for (int t = 0; t < nt - 2; t += 2) {
            const char* a1 = cA + (size_t)(t + 1) * kstep; const char* a2 = cA + (size_t)(t + 2) * kstep; const char* b2 = cB + (size_t)(t + 2) * kstepB;
            const char* a3 = a2 + kstep; const char* b3 = b2 + kstepB;
            PG8_KBODY(cvo);
        }
        unsigned nv[2][2];
        {
            if (has_next) {
                int l2_; asm volatile("v_mbcnt_lo_u32_b32 %0, -1, 0\n\tv_mbcnt_hi_u32_b32 %0, -1, %0" : "=v"(l2_)); int R2[2], C2[2];
#pragma unroll
                for (int i = 0; i < 2; ++i) stage_rc((wid * 64 + l2_) * 16 + i * 8192, R2[i], C2[i]);
                P.a_offs(nxt, R2, C2, nv, lds);
            } else {
#pragma unroll
                for (int h = 0; h < 2; ++h)
#pragma unroll
                    for (int i = 0; i < 2; ++i) nv[h][i] = cvo[h][i]; }
            const char* a1 = cA + (size_t)(nt - 1) * kstep; const char* a2 = nA; const char* b2 = nB; const char* a3 = a2 + kstep; const char* b3 = b2 + kstepB;
            PG8_KBODY(nv);
        }
#undef PG8_KBODY
        asm volatile("s_nop 7\n\ts_nop 7\n\ts_nop 7" ::: "memory");
        if (wr == 0) PG8_BAR;
        { int l3_; asm volatile("v_mbcnt_lo_u32_b32 %0, -1, 0\n\tv_mbcnt_hi_u32_b32 %0, -1, %0" : "=v"(l3_));
          E(acc, cur, wr, wc, l3_ & 15, l3_ >> 4); }
        if (!has_next) break;
#pragma unroll
        for (int a = 0; a < 2; ++a)
#pragma unroll
            for (int b = 0; b < 2; ++b)
#pragma unroll
                for (int m = 0; m < 4; ++m)
#pragma unroll
                    for (int n = 0; n < 2; ++n) acc[a][b][m][n] = (f32x4){0.f, 0.f, 0.f, 0.f};
        cur = nxt; cA = nA; cB = nB; ++ui;
#pragma unroll
        for (int h = 0; h < 2; ++h)
#pragma unroll
            for (int i = 0; i < 2; ++i) cvo[h][i] = nv[h][i];
        if (wr == 1) PG8_BAR;
    }
    PG8_WAIT_V(0);
    PG8_BAR;
#undef PG8_SA
#undef PG8_SB
#undef PG8_STAGE
#undef PG8_LDA
#undef PG8_LDB
#undef PG8_MMA
#undef PG8_LD2
#undef PG8_WAIT_V
#undef PG8_WAIT_L
#undef PG8_BAR
#undef PG8_SCHED
}
}

namespace att {
constexpr int NW = 8, QBLK = 32, KVBLK = 64;
constexpr float SCALE = 0.088388347648318440f;
constexpr float THR = 8.f;
constexpr int LDQ = NQKV, LDK = NQKV, LDO = D;
constexpr int SHM_V = KVBLK * HD * 2, SHM_K = KVBLK * HD * 2, SHM_ATTN = 2 * SHM_V + 2 * SHM_K + NW * 64 * 4;
#define KSWZ(row, colB) ((row) * 256 + ((colB) ^ (((row) & 7) << 4)))
#define SBAR() __builtin_amdgcn_sched_barrier(0)
__device__ __forceinline__ int crow(int r, int hi) { return (r & 3) + 8 * (r >> 2) + 4 * hi; }
__device__ __forceinline__ void partialSM(f32x16& p0, f32x16& p1, float& m_reg, float& mn, float& alpha) {
    constexpr float C = 1.0f;
    float pmax = p0[0];
#pragma unroll
    for (int r = 1; r < 16; ++r) pmax = fmaxf(pmax, p0[r]);
#pragma unroll
    for (int r = 0; r < 16; ++r) pmax = fmaxf(pmax, p1[r]);
    { auto rr = __builtin_amdgcn_permlane32_swap(__float_as_uint(pmax), __float_as_uint(pmax), false, false);
      pmax = fmaxf(__uint_as_float(rr[0]), __uint_as_float(rr[1])); }
    if (__builtin_expect(__all(pmax - m_reg <= THR * 1.4426950408889634f), 1)) { mn = m_reg; alpha = 1.f; }
    else { mn = fmaxf(m_reg, pmax); alpha = __builtin_amdgcn_exp2f((m_reg - mn) * C); m_reg = mn; }
    const float mnC = -mn * C;
#pragma unroll
    for (int r = 0; r < 16; ++r) p0[r] = fmaf(p0[r], C, mnC);
#pragma unroll
    for (int r = 0; r < 16; ++r) p1[r] = fmaf(p1[r], C, mnC);
#pragma unroll
    for (int r = 0; r < 16; ++r) p0[r] = __builtin_amdgcn_exp2f(p0[r]);
}
__device__ __forceinline__ void finishSM(f32x16& p0, f32x16& p1, float alpha, float& l_reg, bf16x8& pa0, bf16x8& pa1, bf16x8& pa2, bf16x8& pa3) {
#pragma unroll
    for (int r = 0; r < 16; ++r) p1[r] = __builtin_amdgcn_exp2f(p1[r]);
    float ps = 0;
#pragma unroll
    for (int r = 0; r < 16; ++r) ps += p0[r];
#pragma unroll
    for (int r = 0; r < 16; ++r) ps += p1[r];
    { auto rr = __builtin_amdgcn_permlane32_swap(__float_as_uint(ps), __float_as_uint(ps), false, false);
      ps = __uint_as_float(rr[0]) + __uint_as_float(rr[1]); }
    l_reg = l_reg * alpha + ps;
#define PK4(P, BASE, OUT) do { unsigned a0 = cvt_pk_bf16(P[BASE + 0], P[BASE + 1]), a1 = cvt_pk_bf16(P[BASE + 2], P[BASE + 3]);   \
    unsigned b0 = cvt_pk_bf16(P[BASE + 4], P[BASE + 5]), b1 = cvt_pk_bf16(P[BASE + 6], P[BASE + 7]);                              \
    auto r0 = __builtin_amdgcn_permlane32_swap(a0, b0, false, false); auto r1 = __builtin_amdgcn_permlane32_swap(a1, b1, false, false); \
    v4u w = {r0[0], r1[0], r0[1], r1[1]}; OUT = *reinterpret_cast<bf16x8*>(&w); } while (0)
    PK4(p0, 0, pa0); PK4(p0, 8, pa1); PK4(p1, 0, pa2); PK4(p1, 8, pa3);
#undef PK4
}
__device__ __forceinline__ void qkt(f32x16& p0, f32x16& p1, const LAS char* Ks, const bf16x8* qr, int r32, int hi) {
    p0 = f32x16{}; p1 = f32x16{};
#pragma unroll
    for (int d0 = 0; d0 < 8; ++d0) {
        const int a4 = r32 * 256 + ((((d0 & 3) * 32) + hi * 16) ^ ((r32 & 7) << 4));
        const bf16x8 b0 = *reinterpret_cast<const LAS bf16x8*>(Ks + a4 + (d0 >> 2) * 128);
        const bf16x8 b1 = *reinterpret_cast<const LAS bf16x8*>(Ks + a4 + (d0 >> 2) * 128 + 8192);
        p0 = __builtin_amdgcn_mfma_f32_32x32x16_bf16(b0, qr[d0], p0, 0, 0, 0);
        p1 = __builtin_amdgcn_mfma_f32_32x32x16_bf16(b1, qr[d0], p1, 0, 0, 0); }
}
__device__ __forceinline__ int v_st(int k, int c) { const int kk = (k & ~0xC) | ((k & 4) << 1) | ((k & 8) >> 1); return ((kk >> 3) * 4 + (c >> 5)) * 512 + ((kk & 7) * 32 + (c & 31)) * 2; }
__device__ __forceinline__ int v_rd_base(int lane) { return ((lane & 3) << 3) | (((lane >> 2) & 3) << 6) | (((lane >> 4) & 1) << 5) | (((lane >> 5) & 1) << 8); }
constexpr int v_rd_off(int d0, int ks, int half) { return d0 * 512 + ks * 4096 + half * 2048; }
template <int OFF> __device__ __forceinline__ s16x4 tr_read(int vb) {
    s16x4 r; asm volatile("ds_read_b64_tr_b16 %0, %1 offset:%2" : "=&v"(r) : "v"(vb), "i"(OFF) : "memory"); return r;
}
template <int D0> __device__ __forceinline__ void pv_one(f32x16& od, int vb, bf16x8 pa0, bf16x8 pa1, bf16x8 pa2, bf16x8 pa3) {
    const s16x4 l0 = tr_read<v_rd_off(D0, 0, 0)>(vb), h0 = tr_read<v_rd_off(D0, 0, 1)>(vb), l1 = tr_read<v_rd_off(D0, 1, 0)>(vb), h1 = tr_read<v_rd_off(D0, 1, 1)>(vb);
    const s16x4 l2 = tr_read<v_rd_off(D0, 2, 0)>(vb), h2 = tr_read<v_rd_off(D0, 2, 1)>(vb), l3 = tr_read<v_rd_off(D0, 3, 0)>(vb), h3 = tr_read<v_rd_off(D0, 3, 1)>(vb);
    asm volatile("s_waitcnt lgkmcnt(0)" ::: "memory"); SBAR();
#define PK(L, H) (bf16x8){L[0], L[1], L[2], L[3], H[0], H[1], H[2], H[3]}
    od = __builtin_amdgcn_mfma_f32_32x32x16_bf16(pa0, PK(l0, h0), od, 0, 0, 0);
    od = __builtin_amdgcn_mfma_f32_32x32x16_bf16(pa1, PK(l1, h1), od, 0, 0, 0);
    od = __builtin_amdgcn_mfma_f32_32x32x16_bf16(pa2, PK(l2, h2), od, 0, 0, 0);
    od = __builtin_amdgcn_mfma_f32_32x32x16_bf16(pa3, PK(l3, h3), od, 0, 0, 0);
#undef PK
}
__device__ __forceinline__ void pv_d0(f32x16* o, int vb, bf16x8 pa0, bf16x8 pa1, bf16x8 pa2, bf16x8 pa3) {
    pv_one<0>(o[0], vb, pa0, pa1, pa2, pa3); pv_one<1>(o[1], vb, pa0, pa1, pa2, pa3); pv_one<2>(o[2], vb, pa0, pa1, pa2, pa3); pv_one<3>(o[3], vb, pa0, pa1, pa2, pa3);
}
__device__ __forceinline__ void attn_dense_body(const bf16* __restrict__ Qb, const bf16* __restrict__ Kh, const bf16* __restrict__ Vh, bf16* __restrict__ Ob, int seq, LAS char* lds, const int wid) {
    const int lane = fresh_lane(), tid = wid * 64 + lane, r32 = lane & 31, hi = lane >> 5;
    LAS char* V_lds = lds; LAS char* K_lds = lds + 2 * SHM_V;
    LAS float* ws = (LAS float*)(lds + 2 * SHM_V + 2 * SHM_K) + wid * 64; LAS float* li_l = ws; LAS float* al_l = ws + 32;
    float m_reg = -1e30f, l_reg = 0; f32x16 o[4] = {}; bf16x8 qr[8];
    const bf16* Qw = Qb + (long)(wid * QBLK + r32) * LDQ + hi * 8;
#pragma unroll
    for (int d0 = 0; d0 < 8; ++d0) qr[d0] = *reinterpret_cast<const bf16x8*>(Qw + d0 * 16);
    const int sr = tid >> 4, sc = (tid & 15) * 8, vst0 = v_st(sr, sc), vst1 = v_st(32 + sr, sc);
    const int vb0 = (int)(unsigned)(uintptr_t)V_lds + v_rd_base(lane);
    struct { bf16x8 vs0, vs1, ks0, ks1; } sr_[2];
#define SLOAD(i, k0) do { sr_[i].vs0 = *reinterpret_cast<const bf16x8*>(&Vh[(long)((k0) + sr) * LDK + sc]); sr_[i].vs1 = *reinterpret_cast<const bf16x8*>(&Vh[(long)((k0) + 32 + sr) * LDK + sc]); \
    sr_[i].ks0 = *reinterpret_cast<const bf16x8*>(&Kh[(long)((k0) + sr) * LDK + sc]); sr_[i].ks1 = *reinterpret_cast<const bf16x8*>(&Kh[(long)((k0) + 32 + sr) * LDK + sc]); } while (0)
#define SWRITE(b, i) do { *(LAS bf16x8*)(V_lds + (b) * SHM_V + vst0) = sr_[i].vs0;          \
    *(LAS bf16x8*)(V_lds + (b) * SHM_V + vst1) = sr_[i].vs1; const int kc = sc * 2;               \
    *(LAS bf16x8*)(K_lds + (b) * SHM_K + KSWZ(sr, kc)) = sr_[i].ks0;                       \
    *(LAS bf16x8*)(K_lds + (b) * SHM_K + KSWZ(32 + sr, kc)) = sr_[i].ks1; } while (0)
#define SWAIT() asm volatile("s_waitcnt vmcnt(4)" ::: "memory")
#define RESC(a) do { if (__any((a) < 1.f)) { if (hi == 0) al_l[r32] = (a); asm volatile("s_waitcnt lgkmcnt(0)" ::: "memory"); \
    _Pragma("unroll") for (int d = 0; d < 4; ++d) _Pragma("unroll") for (int r = 0; r < 16; ++r) o[d][r] *= al_l[crow(r, hi)]; } } while (0)
    f32x16 pA0, pA1, pB0, pB1; float mnA, mnB, alA, alB; bf16x8 pa0, pa1, pa2, pa3; const int NT = seq / KVBLK;
    constexpr int SE = 0, SO = 1;
    SLOAD(SE, 0); asm volatile("s_waitcnt vmcnt(0)" ::: "memory"); SWRITE(0, SE); __syncthreads();
    qkt(pA0, pA1, K_lds, qr, r32, hi); partialSM(pA0, pA1, m_reg, mnA, alA);
    SLOAD(SO, KVBLK); if (2 < NT) SLOAD(SE, 2 * KVBLK);
    SWAIT(); SWRITE(1, SO); __syncthreads();
    for (int j = 1; j + 1 < NT; j += 2) {
        SBAR(); qkt(pB0, pB1, K_lds + SHM_K, qr, r32, hi);
        finishSM(pA0, pA1, alA, l_reg, pa0, pa1, pa2, pa3); SBAR();
        SLOAD(SO, (j + 2) * KVBLK); SBAR();
        pv_d0(o, vb0, pa0, pa1, pa2, pa3); partialSM(pB0, pB1, m_reg, mnB, alB);
        __syncthreads(); SWAIT(); SWRITE(0, SE);
        RESC(alB); __syncthreads();
        SBAR(); qkt(pA0, pA1, K_lds, qr, r32, hi);
        finishSM(pB0, pB1, alB, l_reg, pa0, pa1, pa2, pa3); SBAR();
        if (j + 3 < NT) SLOAD(SE, (j + 3) * KVBLK); SBAR();
        pv_d0(o, vb0 + (int)SHM_V, pa0, pa1, pa2, pa3); partialSM(pA0, pA1, m_reg, mnA, alA);
        __syncthreads(); SWAIT(); SWRITE(1, SO);
        RESC(alA); __syncthreads();
    }
    SBAR(); qkt(pB0, pB1, K_lds + SHM_K, qr, r32, hi);
    finishSM(pA0, pA1, alA, l_reg, pa0, pa1, pa2, pa3); SBAR();
    pv_d0(o, vb0, pa0, pa1, pa2, pa3); partialSM(pB0, pB1, m_reg, mnB, alB);
    __syncthreads(); RESC(alB);
    finishSM(pB0, pB1, alB, l_reg, pa0, pa1, pa2, pa3); SBAR();
    pv_d0(o, vb0 + (int)SHM_V, pa0, pa1, pa2, pa3);
    if (hi == 0) li_l[r32] = l_reg; asm volatile("s_waitcnt lgkmcnt(0)" ::: "memory");
    float rli[16];
#pragma unroll
    for (int r = 0; r < 16; ++r) rli[r] = __builtin_amdgcn_rcpf(li_l[crow(r, hi)]);
    bf16* Ow = Ob + (long)(wid * QBLK) * LDO;
#pragma unroll
    for (int r = 0; r < 16; ++r) { const int orow = crow(r, hi);
#pragma unroll
        for (int d0 = 0; d0 < 4; ++d0) { const float v = o[d0][r] * rli[r]; Ow[(long)orow * LDO + d0 * 32 + r32] = (bf16)(cvt_pk_bf16(v, v) & 0xffffu); } }
    __syncthreads();
#undef SLOAD
#undef SWRITE
#undef SWAIT
#undef RESC
}

}


struct WConv { const float* w_gu; const float* w_down; unsigned char* Wgu8; unsigned char* Wd8; };
constexpr int WQ_GU = 64 * 64 * 4, WQ_D = 64 * 64 * 2, WQ_N = WQ_GU + WQ_D;
__device__ __forceinline__ void wquad_src(const WConv& W, int q, int tid, const float*& src  , int& N) {
    if (q < WQ_GU) { N = 2048; src = W.w_gu + (size_t)(q >> 8) * (1024 * 2048) + (size_t)(16 * ((q >> 2) & 63)) * 2048 + 512 * (q & 3); }
    else { q -= WQ_GU; N = 1024; src = W.w_down + (size_t)(q >> 7) * (1024 * 1024) + (size_t)(16 * ((q >> 1) & 63)) * 1024 + 512 * (q & 1); }
}
__device__ __forceinline__ unsigned char* wquad_dst(const WConv& W, int q, int tid) {
    if (q < WQ_GU) { const int n = 512 * (q & 3) + tid, j = n & 1023, np = 256 * (j >> 7) + 128 * (n >> 10) + (j & 127);
        return W.Wgu8 + (size_t)(q >> 8) * (2048 * 1024) + ((size_t)((q >> 2) & 63) * 2048 + np) * 16; }
    q -= WQ_GU; return W.Wd8 + (size_t)(q >> 7) * (1024 * 1024) + ((size_t)((q >> 1) & 63) * 1024 + 512 * (q & 1) + tid) * 16;
}
__device__ __forceinline__ unsigned wquad_cvt(float a, float b, float c, float d) {
    int w_; const float isc = 1.0f / WSCALE;
    asm volatile("v_cvt_scalef32_pk_fp8_f32 %0, %1, %2, %3" : "=v"(w_) : "v"(a), "v"(b), "s"(isc));
    asm volatile("v_cvt_scalef32_pk_fp8_f32 %0, %1, %2, %3 op_sel:[0,0,0,1]" : "+v"(w_) : "v"(c), "v"(d), "s"(isc));
    return (unsigned)w_;
}
__device__ __forceinline__ void wquad_whole(const WConv& W, int q, int tid) {
    const float* src; int N; wquad_src(W, q, tid, src, N); float r[16];
#pragma unroll
    for (int i = 0; i < 16; ++i) r[i] = src[(size_t)i * N + tid];
    v4u o; o.x = wquad_cvt(r[0], r[1], r[2], r[3]); o.y = wquad_cvt(r[4], r[5], r[6], r[7]); o.z = wquad_cvt(r[8], r[9], r[10], r[11]); o.w = wquad_cvt(r[12], r[13], r[14], r[15]);
    *(v4u*)wquad_dst(W, q, tid) = o;
}

namespace att8 {
constexpr int TB = 16384, NB = 4;
#define MF8Z(Dd, A, Bv) asm volatile("v_mfma_f32_32x32x64_f8f6f4 %0, %1, %2, 0" : "=&v"(Dd) : "v"(A), "v"(Bv))
#define MF8(Dd, A, Bv) asm volatile("v_mfma_f32_32x32x64_f8f6f4 %0, %1, %2, %0" : "+v"(Dd) : "v"(A), "v"(Bv))
#define MFP(Dd, A, Bv) asm volatile("v_mfma_f32_32x32x64_f8f6f4 %0, %1, %2, %0 cbsz:1" : "+v"(Dd) : "v"(A), "v"(Bv))
#define FEXP(x) asm volatile("v_exp_f32_e32 %0, %0" : "+v"(x))
#define FADD(acc, x) asm volatile("v_add_f32_e32 %0, %0, %1" : "+v"(acc) : "v"(x))
#define CVLO(w, a, b) asm volatile("v_cvt_scalef32_pk_bf8_f32 %0, %1, %2, %3" : "=v"(w) : "v"(a), "v"(b), "s"(pscale))
#define CVHI(w, a, b) asm volatile("v_cvt_scalef32_pk_bf8_f32 %0, %1, %2, %3 op_sel:[0,0,0,1]" : "+v"(w) : "v"(a), "v"(b), "s"(pscale))
__device__ __forceinline__ v8i ld32(const LAS unsigned char* p0, const LAS unsigned char* p1) { const v4i a = *(const LAS v4i*)p0, b = *(const LAS v4i*)p1; return __builtin_shufflevector(a, b, 0, 1, 2, 3, 4, 5, 6, 7); }
__device__ __forceinline__ void softmax8(f32x16& PC0, f32x16& PC1, float& l0, float& l1, v8i& pa, const float pscale) {
    int w0, w1, w2, w3, w4, w5, w6, w7;
    FEXP(PC0[0]); FEXP(PC0[1]); FEXP(PC0[2]); FEXP(PC0[3]); FADD(l0, PC0[0]); FEXP(PC0[4]); FADD(l1, PC0[1]); FEXP(PC0[5]); FADD(l0, PC0[2]); FEXP(PC0[6]); FADD(l1, PC0[3]); FEXP(PC0[7]); FADD(l0, PC0[4]); FEXP(PC0[8]); FADD(l1, PC0[5]); FEXP(PC0[9]); FADD(l0, PC0[6]); FEXP(PC0[10]); FADD(l1, PC0[7]); FEXP(PC0[11]); FADD(l0, PC0[8]); FEXP(PC0[12]); FADD(l1, PC0[9]); FEXP(PC0[13]); FADD(l0, PC0[10]); FEXP(PC0[14]); FADD(l1, PC0[11]); FEXP(PC0[15]); FADD(l0, PC0[12]); FEXP(PC1[0]); FADD(l1, PC0[13]); FEXP(PC1[1]); FADD(l0, PC0[14]); FEXP(PC1[2]); FADD(l1, PC0[15]); FEXP(PC1[3]); FADD(l0, PC1[0]); FEXP(PC1[4]); FADD(l1, PC1[1]); FEXP(PC1[5]); FADD(l0, PC1[2]); FEXP(PC1[6]); FADD(l1, PC1[3]); FEXP(PC1[7]); FADD(l0, PC1[4]); FEXP(PC1[8]); FADD(l1, PC1[5]); FEXP(PC1[9]); FADD(l0, PC1[6]); FEXP(PC1[10]); FADD(l1, PC1[7]); FEXP(PC1[11]); FADD(l0, PC1[8]); FEXP(PC1[12]); FADD(l1, PC1[9]); FEXP(PC1[13]); FADD(l0, PC1[10]); FEXP(PC1[14]); FADD(l1, PC1[11]); FEXP(PC1[15]); FADD(l0, PC1[12]); FADD(l1, PC1[13]); FADD(l0, PC1[14]); FADD(l1, PC1[15]); CVLO(w0, PC0[0], PC0[1]); CVHI(w0, PC0[2], PC0[3]); CVLO(w1, PC0[4], PC0[5]); CVHI(w1, PC0[6], PC0[7]); CVLO(w2, PC0[8], PC0[9]); CVHI(w2, PC0[10], PC0[11]); CVLO(w3, PC0[12], PC0[13]); CVHI(w3, PC0[14], PC0[15]); CVLO(w4, PC1[0], PC1[1]); CVHI(w4, PC1[2], PC1[3]); CVLO(w5, PC1[4], PC1[5]); CVHI(w5, PC1[6], PC1[7]); CVLO(w6, PC1[8], PC1[9]); CVHI(w6, PC1[10], PC1[11]); CVLO(w7, PC1[12], PC1[13]); CVHI(w7, PC1[14], PC1[15]);
    pa = (v8i){w0, w1, w2, w3, w4, w5, w6, w7};
}
__device__ __forceinline__ void attn_fp8_body(const unsigned char* __restrict__ Qb, const unsigned char* __restrict__ Kh, const unsigned char* __restrict__ Vth, bf16* __restrict__ Ob,
                                              int NT, LAS unsigned char* lds, const int wid, const float pscale_in, const WConv& wc, const int wq0, const int wqs) {
    const int lane = fresh_lane(), tid = wid * 64 + lane, r32 = lane & 31, hi = lane >> 5;
    float l0 = 0.f, l1 = 0.f; f32x16 o[4] = {}; v8i qr[2];
    { const unsigned char* qp = Qb + (size_t)(wid * 32 + r32) * D + 32 * hi;
#pragma unroll
      for (int s_ = 0; s_ < 2; ++s_) { const v4i a = *(const v4i*)(qp + 64 * s_), b = *(const v4i*)(qp + 64 * s_ + 16); qr[s_] = __builtin_shufflevector(a, b, 0, 1, 2, 3, 4, 5, 6, 7); } }
    const float pscale = __uint_as_float(__builtin_amdgcn_readfirstlane(__float_as_uint(pscale_in)));
    const int kx = (r32 >> 1) & 7, vx = (r32 >> 2) & 3;
    int ka[2][2], va[2];
#pragma unroll
    for (int s_ = 0; s_ < 2; ++s_)
#pragma unroll
        for (int c = 0; c < 2; ++c) ka[s_][c] = r32 * 128 + (((4 * s_ + 2 * hi + c) ^ kx) << 4);
#pragma unroll
    for (int c = 0; c < 2; ++c) va[c] = 8192 + r32 * 64 + (((2 * hi + c) ^ vx) << 4);
    const int skey = tid >> 3, sch = tid & 7, sd = tid >> 2, svc = tid & 3;
    const int lw = (int)(unsigned)(uintptr_t)lds;
    const int kst = lw + skey * 128 + ((sch ^ ((skey >> 1) & 7)) << 4), vst = lw + 8192 + sd * 64 + ((svc ^ ((sd >> 2) & 3)) << 4);
    const __amdgpu_buffer_rsrc_t krs = __builtin_amdgcn_make_buffer_rsrc((void*)Kh, 0, 0x7fffffff, 0x00020000);
    const __amdgpu_buffer_rsrc_t vrs = __builtin_amdgcn_make_buffer_rsrc((void*)Vth, 0, 0x7fffffff, 0x00020000);
    const int kgo = skey * (NKV * HD) + sch * 16, vgo = tid * 16; int kso = 0, vso = 0;
    v4i ks, vs;
#define FLOAD() do { ks = __builtin_bit_cast(v4i, __builtin_amdgcn_raw_buffer_load_b128(krs, kgo, kso, 0)); vs = __builtin_bit_cast(v4i, __builtin_amdgcn_raw_buffer_load_b128(vrs, vgo, vso, 0)); \
        if (kso < (NT - 1) * 64 * NKV * HD) { kso += 64 * NKV * HD; vso += 8192; } } while (0)
#define DSW(addr, val, OFF) asm volatile("ds_write_b128 %0, %1 offset:%2" :: "v"(addr), "v"(val), "i"(OFF) : "memory")
#define FWRITE(B) do { DSW(kst, ks, (B) * TB); DSW(vst, vs, (B) * TB); } while (0)
#define KF(B, kb, s_) ld32(lds + (B) * TB + (kb) * 4096 + ka[s_][0], lds + (B) * TB + (kb) * 4096 + ka[s_][1])
#define VF(B, d0) ld32(lds + (B) * TB + (d0) * 2048 + va[0], lds + (B) * TB + (d0) * 2048 + va[1])
    f32x16 pA0, pA1, pB0, pB1; v8i paX, paY; float wrow[16] = {}; unsigned wd0 = 0, wd1 = 0, wd2 = 0;
    FLOAD(); asm volatile("s_waitcnt vmcnt(0)" ::: "memory"); FWRITE(0);
    FLOAD(); asm volatile("s_waitcnt vmcnt(0)" ::: "memory"); FWRITE(1);
    FLOAD();
    asm volatile("s_waitcnt lgkmcnt(0)" ::: "memory"); __syncthreads();
    { const v8i k00 = KF(0, 0, 0), k10 = KF(0, 1, 0), k01 = KF(0, 0, 1), k11 = KF(0, 1, 1);
      MF8Z(pA0, k00, qr[0]); MF8Z(pA1, k10, qr[0]); MF8(pA0, k01, qr[1]); MF8(pA1, k11, qr[1]); }
#define FSTEP(PC0, PC1, PN0, PN1, PCUR, PPRV, J, B, EM) do { \
        if ((J) + 2 < NT) FWRITE(((B) + 2) & 3); \
        FLOAD(); __builtin_amdgcn_sched_barrier(0); \
        {   \
          const unsigned dw_ = wquad_cvt(wrow[4 * (B)], wrow[4 * (B) + 1], wrow[4 * (B) + 2], wrow[4 * (B) + 3]); \
          if ((B) == 0) wd0 = dw_; else if ((B) == 1) wd1 = dw_; else if ((B) == 2) wd2 = dw_; \
          else if (EM) { v4u o_ = {wd0, wd1, wd2, dw_}; *(v4u*)wquad_dst(wc, (wq0 + (((J) >> 2) - 1) * wqs) % WQ_N, tid) = o_; } \
          const float* src_; int N_; wquad_src(wc, (wq0 + ((J) >> 2) * wqs) % WQ_N, tid, src_, N_); \
          _Pragma("unroll") for (int i_ = 0; i_ < 4; ++i_) wrow[4 * (B) + i_] = src_[(size_t)(4 * (B) + i_) * N_ + tid]; } \
        __builtin_amdgcn_sched_barrier(0); \
        { int w0, w1, w2, w3, w4, w5, w6, w7; const bool qk_ = (J) + 1 < NT, pv_ = (J) > 0; \
            \
          v8i kA = KF(((B) + 1) & 3, 0, 0), vA = VF(((B) + 3) & 3, 0), kB, vB; \
          __builtin_amdgcn_sched_barrier(0); \
          kB = KF(((B) + 1) & 3, 1, 0); vB = VF(((B) + 3) & 3, 1); \
          if (qk_) MF8Z(PN0, kA, qr[0]);       G0(PC0, PC1) \
          if (pv_) MFP(o[0], PPRV, vA);        G1(PC0, PC1) \
          __builtin_amdgcn_sched_barrier(0); \
          kA = KF(((B) + 1) & 3, 0, 1); vA = VF(((B) + 3) & 3, 2); \
          if (qk_) MF8Z(PN1, kB, qr[0]);       G2(PC0, PC1) \
          if (pv_) MFP(o[1], PPRV, vB);        G3(PC0, PC1) \
          __builtin_amdgcn_sched_barrier(0); \
          kB = KF(((B) + 1) & 3, 1, 1); vB = VF(((B) + 3) & 3, 3); \
          if (qk_) MF8(PN0, kA, qr[1]);        G4(PC0, PC1) \
          if (pv_) MFP(o[2], PPRV, vA);        G5(PC0, PC1) \
          __builtin_amdgcn_sched_barrier(0); \
          if (qk_) MF8(PN1, kB, qr[1]);        G6(PC0, PC1) \
          if (pv_) MFP(o[3], PPRV, vB);        G7(PC0, PC1) \
          PCUR = (v8i){w0, w1, w2, w3, w4, w5, w6, w7}; } \
        asm volatile("s_waitcnt lgkmcnt(0)" ::: "memory"); __syncthreads(); } while (0)
#define G0(PC0, PC1) FEXP(PC0[0]); FEXP(PC0[1]); FEXP(PC0[2]); FEXP(PC0[3]); FADD(l0, PC0[0]); FEXP(PC0[4]); FADD(l1, PC0[1]); FEXP(PC0[5]); FADD(l0, PC0[2]); FEXP(PC0[6]);
#define G1(PC0, PC1) FADD(l1, PC0[3]); FEXP(PC0[7]); FADD(l0, PC0[4]); FEXP(PC0[8]); FADD(l1, PC0[5]); FEXP(PC0[9]); FADD(l0, PC0[6]); FEXP(PC0[10]); FADD(l1, PC0[7]); FEXP(PC0[11]);
#define G2(PC0, PC1) FADD(l0, PC0[8]); FEXP(PC0[12]); FADD(l1, PC0[9]); FEXP(PC0[13]); FADD(l0, PC0[10]); FEXP(PC0[14]); FADD(l1, PC0[11]); FEXP(PC0[15]); FADD(l0, PC0[12]); FEXP(PC1[0]);
#define G3(PC0, PC1) FADD(l1, PC0[13]); FEXP(PC1[1]); FADD(l0, PC0[14]); FEXP(PC1[2]); FADD(l1, PC0[15]); FEXP(PC1[3]); FADD(l0, PC1[0]); FEXP(PC1[4]); FADD(l1, PC1[1]); FEXP(PC1[5]);
#define G4(PC0, PC1) FADD(l0, PC1[2]); FEXP(PC1[6]); FADD(l1, PC1[3]); FEXP(PC1[7]); FADD(l0, PC1[4]); FEXP(PC1[8]); FADD(l1, PC1[5]); FEXP(PC1[9]); FADD(l0, PC1[6]); FEXP(PC1[10]);
#define G5(PC0, PC1) FADD(l1, PC1[7]); FEXP(PC1[11]); FADD(l0, PC1[8]); FEXP(PC1[12]); FADD(l1, PC1[9]); FEXP(PC1[13]); FADD(l0, PC1[10]); FEXP(PC1[14]); FADD(l1, PC1[11]); FEXP(PC1[15]);
#define G6(PC0, PC1) FADD(l0, PC1[12]); FADD(l1, PC1[13]); FADD(l0, PC1[14]); FADD(l1, PC1[15]); CVLO(w0, PC0[0], PC0[1]); CVHI(w0, PC0[2], PC0[3]); CVLO(w1, PC0[4], PC0[5]); CVHI(w1, PC0[6], PC0[7]); CVLO(w2, PC0[8], PC0[9]); CVHI(w2, PC0[10], PC0[11]);
#define G7(PC0, PC1) CVLO(w3, PC0[12], PC0[13]); CVHI(w3, PC0[14], PC0[15]); CVLO(w4, PC1[0], PC1[1]); CVHI(w4, PC1[2], PC1[3]); CVLO(w5, PC1[4], PC1[5]); CVHI(w5, PC1[6], PC1[7]); CVLO(w6, PC1[8], PC1[9]); CVHI(w6, PC1[10], PC1[11]); CVLO(w7, PC1[12], PC1[13]); CVHI(w7, PC1[14], PC1[15]);
    FSTEP(pA0, pA1, pB0, pB1, paX, paY, 0, 0, 0); FSTEP(pB0, pB1, pA0, pA1, paY, paX, 1, 1, 0); FSTEP(pA0, pA1, pB0, pB1, paX, paY, 2, 2, 0); FSTEP(pB0, pB1, pA0, pA1, paY, paX, 3, 3, 0);
    for (int j = 4; j < NT; j += 4) { FSTEP(pA0, pA1, pB0, pB1, paX, paY, j, 0, 1); FSTEP(pB0, pB1, pA0, pA1, paY, paX, j + 1, 1, 1); FSTEP(pA0, pA1, pB0, pB1, paX, paY, j + 2, 2, 1); FSTEP(pB0, pB1, pA0, pA1, paY, paX, j + 3, 3, 1); }
    {
        v4u o_ = {wquad_cvt(wrow[0], wrow[1], wrow[2], wrow[3]), wquad_cvt(wrow[4], wrow[5], wrow[6], wrow[7]), wquad_cvt(wrow[8], wrow[9], wrow[10], wrow[11]), wquad_cvt(wrow[12], wrow[13], wrow[14], wrow[15])};
        *(v4u*)wquad_dst(wc, (wq0 + ((NT >> 2) - 1) * wqs) % WQ_N, tid) = o_;
    }
    {
        const v8i v0 = VF(3, 0), v1 = VF(3, 1), v2 = VF(3, 2), v3 = VF(3, 3);
        asm volatile("s_nop 4" ::: "memory");
        MFP(o[0], paY, v0); MFP(o[1], paY, v1); MFP(o[2], paY, v2); MFP(o[3], paY, v3);
        asm volatile("s_waitcnt lgkmcnt(0)" ::: "memory"); __syncthreads(); }
    asm volatile("s_nop 7\n\ts_nop 7\n\ts_nop 7" ::: "memory");
    float l_part = l0 + l1;
    { auto rr = __builtin_amdgcn_permlane32_swap(__float_as_uint(l_part), __float_as_uint(l_part), false, false); l_part = __uint_as_float(rr[0]) + __uint_as_float(rr[1]); }
    const int lane2 = fresh_lane(), r32e = lane2 & 31, hie = lane2 >> 5;
    LAS float* li_l = (LAS float*)(lds + L_OFFS) + wid * 64;
    if (hie == 0) li_l[r32e] = l_part; asm volatile("s_waitcnt lgkmcnt(0)" ::: "memory");
    float rli[16];
#pragma unroll
    for (int r = 0; r < 16; ++r) rli[r] = pscale * __builtin_amdgcn_rcpf(li_l[att::crow(r, hie)]);
    bf16* Ow = Ob + (size_t)(wid * 32) * D;
#pragma unroll
    for (int r = 0; r < 16; ++r) { const int orow = att::crow(r, hie);
#pragma unroll
        for (int d0 = 0; d0 < 4; ++d0) { const float v = o[d0][r] * rli[r]; Ow[(size_t)orow * D + d0 * 32 + r32e] = (bf16)(cvt_pk_bf16(v, v) & 0xffffu); } }
    __syncthreads();
#undef FLOAD
#undef DSW
#undef FWRITE
#undef KF
#undef VF
#undef FSTEP
#undef G0
#undef G1
#undef G2
#undef G3
#undef G4
#undef G5
#undef G6
#undef G7
}
#undef MF8Z
#undef MF8
#undef MFP
#undef FEXP
#undef FADD
#undef CVLO
#undef CVHI
}

__device__ __forceinline__ void ld_row(const float* row, int lane, f32x4 (&v)[4]) {
#pragma unroll
    for (int j = 0; j < 4; ++j) v[j] = *(const f32x4*)(row + 4 * lane + 256 * j);
}
__device__ __forceinline__ void ld_row_bf16(const bf16* row, int lane, f32x4 (&v)[4]) {
#pragma unroll
    for (int j = 0; j < 4; ++j) { const v2u w = *(const v2u*)(row + 4 * lane + 256 * j); v[j] = (f32x4){bf_lo(w.x), bf_hi(w.x), bf_lo(w.y), bf_hi(w.y)}; }
}
__device__ __forceinline__ void st_row(float* row, int lane, const f32x4 (&v)[4]) {
#pragma unroll
    for (int j = 0; j < 4; ++j) *(f32x4*)(row + 4 * lane + 256 * j) = v[j];
}
__device__ __forceinline__ void st_row_bf16(bf16* row, int lane, const f32x4 (&v)[4]) {
#pragma unroll
    for (int j = 0; j < 4; ++j) { v2u w; w.x = cvt_pk_bf16(v[j][0], v[j][1]); w.y = cvt_pk_bf16(v[j][2], v[j][3]); *(v2u*)(row + 4 * lane + 256 * j) = w; }
}
__device__ __forceinline__ void st_row_fp8(unsigned char* row, int lane, const f32x4 (&v)[4]) {
#pragma unroll
    for (int j = 0; j < 4; ++j) *(unsigned*)(row + 4 * lane + 256 * j) = cvt_pk_fp8x4(v[j][0], v[j][1], v[j][2], v[j][3]);
}
__device__ __forceinline__ float row_rstd(const f32x4 (&v)[4]) {
    float s = 0.f;
#pragma unroll
    for (int j = 0; j < 4; ++j) s += (v[j][0] * v[j][0] + v[j][1] * v[j][1]) + (v[j][2] * v[j][2] + v[j][3] * v[j][3]);
    return 1.0f / sqrtf(wave_sum(s) * (1.0f / D) + NORM_EPS);
}

struct Args { const float* in[21]; float* out; unsigned char* ws; int ph_lo, ph_hi; };

__device__ __forceinline__ void transpose_item(const float* W, int N, int k0, int n0, bf16* dst, int K, LAS float* scr, int lane) {
    f32x4 v[8];
#pragma unroll
    for (int i = 0; i < 8; ++i) v[i] = *(const f32x4*)(W + (size_t)(k0 + (lane >> 3) + 8 * i) * N + n0 + (lane & 7) * 4);
#pragma unroll
    for (int i = 0; i < 8; ++i) { LAS float* d = scr + ((lane >> 3) + 8 * i) * 33 + (lane & 7) * 4; d[0] = v[i][0]; d[1] = v[i][1]; d[2] = v[i][2]; d[3] = v[i][3]; }
    LDS_WAIT(); asm volatile("" ::: "memory");
    const int c = lane & 7;
#pragma unroll
    for (int j = 0; j < 4; ++j) { const int n = (lane >> 3) + 8 * j; const LAS float* s = scr + (8 * c) * 33 + n;
        v4u o; o.x = cvt_pk_bf16(s[0 * 33], s[1 * 33]); o.y = cvt_pk_bf16(s[2 * 33], s[3 * 33]); o.z = cvt_pk_bf16(s[4 * 33], s[5 * 33]); o.w = cvt_pk_bf16(s[6 * 33], s[7 * 33]);
        *(v4u*)(dst + (size_t)n * K + 8 * c) = o; }
    LDS_WAIT(); asm volatile("" ::: "memory");
}

__device__ __forceinline__ void transpose_item_fp8(const float* W, int N, int k0, int n0, unsigned char* dst, int K, LAS float* scr, int lane, float scale) {
    f32x4 v[8];
#pragma unroll
    for (int i = 0; i < 8; ++i) v[i] = *(const f32x4*)(W + (size_t)(k0 + (lane >> 3) + 8 * i) * N + n0 + (lane & 7) * 4);
#pragma unroll
    for (int i = 0; i < 8; ++i) { LAS float* d = scr + ((lane >> 3) + 8 * i) * 33 + (lane & 7) * 4; d[0] = v[i][0] * scale; d[1] = v[i][1] * scale; d[2] = v[i][2] * scale; d[3] = v[i][3] * scale; }
    LDS_WAIT(); asm volatile("" ::: "memory");
    const int n = lane >> 1, kh = lane & 1; const LAS float* s = scr + (32 * kh) * 33 + n;
    v4u o0, o1;
    o0.x = cvt_pk_fp8x4(s[0 * 33], s[1 * 33], s[2 * 33], s[3 * 33]);     o0.y = cvt_pk_fp8x4(s[4 * 33], s[5 * 33], s[6 * 33], s[7 * 33]);
    o0.z = cvt_pk_fp8x4(s[8 * 33], s[9 * 33], s[10 * 33], s[11 * 33]);   o0.w = cvt_pk_fp8x4(s[12 * 33], s[13 * 33], s[14 * 33], s[15 * 33]);
    o1.x = cvt_pk_fp8x4(s[16 * 33], s[17 * 33], s[18 * 33], s[19 * 33]); o1.y = cvt_pk_fp8x4(s[20 * 33], s[21 * 33], s[22 * 33], s[23 * 33]);
    o1.z = cvt_pk_fp8x4(s[24 * 33], s[25 * 33], s[26 * 33], s[27 * 33]); o1.w = cvt_pk_fp8x4(s[28 * 33], s[29 * 33], s[30 * 33], s[31 * 33]);
    unsigned char* dp = dst + (size_t)n * K + 32 * kh;
    *(v4u*)dp = o0; *(v4u*)(dp + 16) = o1;
    LDS_WAIT(); asm volatile("" ::: "memory");
}

__device__ __forceinline__ int moe_build_units(LAS unsigned char* lds, const unsigned* gcnt, const int* tok_list, int NPN, bool gather, int rowbytes, int G, int c, const int tid) {
    const int lane = tid & 63;
    LAS unsigned* tb = (LAS unsigned*)(lds + L_TB); LAS unsigned* lc = (LAS unsigned*)(lds + L_CNT); LAS int* ut = (LAS int*)(lds + L_UT);
    if (tid < 64) {
        unsigned cnt = (lane < NE) ? __hip_atomic_load(gcnt + 64 * lane, RLX_AGENT) : 0u;
        unsigned tiles = (cnt + 255u) >> 8, incl = tiles;
#pragma unroll
        for (int o = 1; o < 32; o <<= 1) { const unsigned t = __shfl_up(incl, o); if (lane >= o) incl += t; }
        if (lane < NE) { tb[lane + 1] = incl; lc[lane] = cnt; }
        if (lane == 0) tb[0] = 0u;
    }
    __syncthreads();
    const int T = (int)tb[NE], nunits = T * NPN;
    int n_my = 0; { const int rem = nunits - c; n_my = rem > 0 ? (rem + G - 1) / G : 0; if (n_my > 16) n_my = 16; }
    if (tid < n_my) {
        int L = tid * G + c; const int q = nunits / 8, r = nunits % 8, xcd = L % 8, off = L / 8;
        const int wgid = (xcd < r ? xcd * (q + 1) : r * (q + 1) + (xcd - r) * q) + off;
        const int mtg = wgid / NPN, pn = wgid % NPN;
        int e = 0;
        for (int k = 1; k < NE; ++k) if ((int)tb[k] <= mtg) e = k;
        const int mtl = mtg - (int)tb[e]; int valid = (int)lc[e] - mtl * 256; if (valid > 256) valid = 256;
        ut[tid * 8 + 0] = e; ut[tid * 8 + 1] = mtl; ut[tid * 8 + 2] = pn; ut[tid * 8 + 3] = mtg; ut[tid * 8 + 4] = valid;
    }
    __syncthreads();
    if (gather) {
        LAS unsigned* offs = (LAS unsigned*)(lds + L_OFFS);
        for (int idx = tid; idx < n_my * 256; idx += 512) { const int u = idx >> 8, r = idx & 255; const int e = ut[u * 8 + 0], mtl = ut[u * 8 + 1], valid = ut[u * 8 + 4];
            const int tok = (r < valid) ? tok_list[e * S + mtl * 256 + r] : 0;
            offs[idx] = (unsigned)tok * (unsigned)rowbytes; }
        __syncthreads();
    }
    return n_my;
}

__global__ void __launch_bounds__(512, 2) fwd_kernel(Args args) {
    extern __shared__ __attribute__((aligned(16))) unsigned char lds_[];
    LAS unsigned char* lds = (LAS unsigned char*)lds_;
    const int wave = __builtin_amdgcn_readfirstlane(threadIdx.x >> 6);
    const int G = gridDim.x, bid = blockIdx.x;
#define PHASE_IDS const int lane = fresh_lane(), tid = wave * 64 + lane; (void)tid; (void)lane
    const int gw = bid * 8 + wave, NGW = G * 8;
    unsigned char* ws = args.ws;
    unsigned* ctl = (unsigned*)(ws + WS_CTL);
    const float* x = args.in[0]; const float* cvec = args.in[1]; const float* ctx = args.in[2]; const float* cctx = args.in[3];
    const float* ada_w = args.in[4]; const float* ada_b = args.in[5]; const float* norm_mix = args.in[6]; const float* norm_ffn = args.in[7];
    const float* w_qkv = args.in[8]; const float* q_g = args.in[9]; const float* k_g = args.in[10]; const float* w_o = args.in[11];
    const float* pool_w = args.in[12]; const float* pool_scale = args.in[13]; const float* router_w = args.in[14]; const float* router_b = args.in[15];
    const float* w_gu = args.in[16]; const float* b_gu = args.in[17]; const float* w_down = args.in[18]; const float* b_down = args.in[19]; const float* final_norm = args.in[20];
    float* MOD = (float*)(ws + WS_MOD);
    bf16* WF = (bf16*)(ws + WS_MOD + 131072);
    unsigned char* Wqkv8 = ws + WS_WQKV;
    bf16* Wo_t = (bf16*)(ws + WS_WO);
    bf16* Wpool_t = (bf16*)(ws + WS_WPOOL);
    unsigned char* Wgu8 = ws + WS_WGU; unsigned char* Wd8 = ws + WS_WD;
    unsigned char* H8 = ws + WS_H; unsigned char* ACT8 = ws + WS_ACT;
    int* tok_list = (int*)(ws + WS_TOKLIST); int* tok_e = (int*)(ws + WS_TOKE); int* tok_pos = (int*)(ws + WS_TOKP); float* tok_w = (float*)(ws + WS_TOKW);
    bf16* QKV = (bf16*)(ws + WS_QKV); bf16* O = (bf16*)(ws + WS_O);
    unsigned char* Q8 = ws + WS_Q8; unsigned char* K8 = ws + WS_K8; unsigned char* VT8 = ws + WS_VT8;
    bf16* XA = (bf16*)(ws + WS_XA); bf16* XB = (bf16*)(ws + WS_XB); bf16* XC = (bf16*)(ws + WS_XC);
    bf16* H1B = (bf16*)(ws + WS_POOLED);
    bf16* YZ = (bf16*)(ws + WS_H1F);
    bf16* Y = (bf16*)(ws + WS_Y);

    if (threadIdx.x < 16) ((LAS unsigned*)(lds + MISC_OFF))[threadIdx.x] = 0u;
    __syncthreads();
    XcdBarrier bar; bar.bar = ctl + CW_BAR; bar.x = 0; bar.st = nullptr; bar.wave = wave;
    if (MK_N_LAUNCHES == 1) bar = xcd_barrier_post(ctl + CW_BAR, (volatile LAS unsigned*)(lds + MISC_OFF), wave);
    const int lo = args.ph_lo, hi = args.ph_hi;
#ifndef PHASE_MASK
#define PHASE_MASK 0xFFFF
#endif
#define IN(k) ((((PHASE_MASK) >> (k)) & 1) && lo <= (k) && (k) < hi)
#define SEAM(k) do { if (IN(k) && IN((k) + 1)) xcd_barrier(bar); } while (0)

    if (IN(PH_PRO)) { PHASE_IDS;
        {
            LAS float* sl = (LAS float*)lds; LAS float* scx = sl + 1024; LAS float* part = sl + 2048;
            for (int i = tid; i < 1024; i += 512) { const float a = cvec[i], b = cctx[i]; sl[i] = a / (1.0f + __expf(-a)); scx[i] = b / (1.0f + __expf(-b)); }
            __syncthreads();
            for (int t = bid; t < 192; t += G) {
                const int layer = t / 96, cb = t % 96, n = cb * 64 + lane;
                const float* Wp = ada_w + (size_t)layer * 1024 * 6144 + (size_t)(wave * 128) * 6144 + n;
                float a0 = 0.f, a1 = 0.f;
#pragma unroll 16
                for (int k = 0; k < 128; ++k) { const float w = Wp[(size_t)k * 6144]; a0 += sl[wave * 128 + k] * w; a1 += scx[wave * 128 + k] * w; }
                part[wave * 64 + lane] = a0; part[512 + wave * 64 + lane] = a1;
                __syncthreads();
                if (tid < 128) { const int which = tid >> 6, l = tid & 63; float s = 0.f;
#pragma unroll
                    for (int w = 0; w < 8; ++w) s += part[which * 512 + w * 64 + l];
                    const int nn = cb * 64 + l; s += ada_b[layer * 6144 + nn];
                    if (which == 0) MOD[layer * 6144 + nn] = s; else if (layer == 0 && nn < 2048) MOD[12288 + nn] = s; }
                __syncthreads();
            }
        }
        for (int idx = bid * 512 + tid; idx < 65536; idx += G * 512) {
            const int j = idx & 7, ln = (idx >> 3) & 63, ks = (idx >> 9) & 15, kh = (idx >> 13) & 1, et = (idx >> 14) & 1, l = idx >> 15;
            const int e = et * 16 + (ln & 15), k = kh * 512 + ks * 32 + 8 * (ln >> 4) + j; const float w = router_w[(size_t)l * 32768 + k * 32 + e];
            const unsigned hi = cvt_pk_bf16(w, w) & 0xffffu; const float r_ = w - bf_lo(hi); const unsigned lo = cvt_pk_bf16(r_, r_) & 0xffffu;
            const size_t base = ((size_t)((((l * 2 + et) * 2 + kh) * 16 + ks) * 2) * 64 + ln) * 8 + j;
            WF[base] = (bf16)hi; WF[base + 512] = (bf16)lo; }
        {
            LAS float* scr = (LAS float*)(lds + wave * 16384);
            constexpr int I_GU = 64 * 16 * 64, I_D = 64 * 16 * 32, I_QKV = 16 * 48, I_O = 16 * 32, I_P = 4 * 4 * 8;
            const float gqm_ = wave_max(fmaxf(fabsf(q_g[lane]), fabsf(q_g[64 + lane]))), gkm_ = wave_max(fmaxf(fabsf(k_g[lane]), fabsf(k_g[64 + lane])));
            const bool attn_fast_ = (HD * gqm_ * gkm_ * att::SCALE * 1.4426950408889634f * 1.02f) < 26.0f;
            const int NITEMS = I_QKV + I_O + I_P;
            if (!attn_fast_) { const WConv wc_{w_gu, w_down, Wgu8, Wd8}; for (int q = bid; q < WQ_N; q += G) wquad_whole(wc_, q, tid); }
            for (int it = gw; it < NITEMS; it += NGW) {
                int r = it;
                if (r < I_QKV) { const int kb = r / 48, nb = r % 48; transpose_item_fp8(w_qkv, NQKV, kb * 64, nb * 32, Wqkv8 + (size_t)(nb * 32) * 1024 + kb * 64, 1024, scr, lane, WSCALE); continue; } r -= I_QKV;
                if (r < I_O) { const int kb = r / 32, nb = r % 32; transpose_item(w_o, 1024, kb * 64, nb * 32, Wo_t + (size_t)(nb * 32) * 1024 + kb * 64, 1024, scr, lane); continue; } r -= I_O;
                if (r < I_P) { const int g = r / 32, kb = (r % 32) / 8, nb = r % 8; transpose_item(pool_w + (size_t)g * 65536, 256, kb * 64, nb * 32, Wpool_t + (size_t)g * 65536 + (size_t)(nb * 32) * 256 + kb * 64, 256, scr, lane); continue; } r -= I_P;
            }
        }
        __syncthreads();
    }
    SEAM(PH_PRO);

    if (IN(PH_NORM1)) { PHASE_IDS;
        f32x4 av[4], bv[4];
#pragma unroll
        for (int j = 0; j < 4; ++j) { const int col = 4 * lane + 256 * j; const f32x4 g = *(const f32x4*)(norm_mix + col); av[j] = g * (1.0f + *(const f32x4*)(MOD + 1024 + col)); bv[j] = *(const f32x4*)(MOD + col); }
        for (int r = gw; r < S; r += NGW) { f32x4 v[4]; ld_row(x + (size_t)r * D, lane, v); const float rs = row_rstd(v);
#pragma unroll
            for (int j = 0; j < 4; ++j) v[j] = v[j] * rs * av[j] + bv[j];
            st_row_fp8(H8 + (size_t)r * D, lane, v); }
#pragma unroll
        for (int j = 0; j < 4; ++j) { const int col = 4 * lane + 256 * j; const f32x4 g = *(const f32x4*)(norm_mix + col); av[j] = g * (1.0f + *(const f32x4*)(MOD + 12288 + 1024 + col)); bv[j] = *(const f32x4*)(MOD + 12288 + col); }
        for (int r = gw; r < CT; r += NGW) { f32x4 v[4]; ld_row(ctx + (size_t)r * D, lane, v); const float rs = row_rstd(v);
#pragma unroll
            for (int j = 0; j < 4; ++j) v[j] = v[j] * rs * av[j] + bv[j];
            st_row_fp8(H8 + (size_t)(S + r) * D, lane, v); }
    }
    SEAM(PH_NORM1);

    if (IN(PH_QKV)) { PHASE_IDS;
        pg8::ProbDense<1> P; P.init(H8, Wqkv8, NTOK, NQKV, D, D, D, 0, G, bid);
        pg8::EpiBf16 E{QKV, NQKV, nullptr, 0, 1.0f / WSCALE};
        pg8::gemm_phase(lds, P, E, wave);
    }
    SEAM(PH_QKV);

    if (IN(PH_QKROPE)) { PHASE_IDS;
        const int sub = lane >> 4, j16 = lane & 15, part = j16 >> 3, i0 = 4 * (j16 & 7);
        constexpr int NIT = (S * 10) / 4 + (CT * 2) / 4;
        for (int it = gw; it < NIT; it += NGW) {
            const int idx = it * 4 + sub; const bool lat = idx < S * 10; int row, head;
            if (lat) { row = idx / 10; head = idx - row * 10; } else { const int i2 = idx - S * 10; row = S + (i2 >> 1); head = 8 + (i2 & 1); }
            bf16* p = QKV + (size_t)row * NQKV + head * HD + 64 * part + i0;
            const v2u a = *(const v2u*)p, b = *(const v2u*)(p + 32);
            float x1[4] = {bf_lo(a.x), bf_hi(a.x), bf_lo(a.y), bf_hi(a.y)}, x2[4] = {bf_lo(b.x), bf_hi(b.x), bf_lo(b.y), bf_hi(b.y)};
            float ss = 0.f;
#pragma unroll
            for (int i = 0; i < 4; ++i) ss += x1[i] * x1[i] + x2[i] * x2[i];
            ss += __shfl_xor(ss, 1); ss += __shfl_xor(ss, 2); ss += __shfl_xor(ss, 4); ss += __shfl_xor(ss, 8);
            const float rs = (1.0f / sqrtf(ss * (1.0f / HD) + NORM_EPS)) * (head < 8 ? att::SCALE * 1.4426950408889634f : 1.0f);
            const float* gp = (head < 8 ? q_g : k_g) + 64 * part + i0;
            const f32x4 g1 = *(const f32x4*)gp, g2 = *(const f32x4*)(gp + 32);
            float o1[4], o2[4];
#pragma unroll
            for (int i = 0; i < 4; ++i) { const float y1 = x1[i] * rs * g1[i], y2 = x2[i] * rs * g2[i];
                if (lat) { const float pos = (float)(part ? (row & (GRID_W - 1)) : (row / GRID_W));
                    const float invf = exp2f(-(float)(i0 + i) * (13.287712379549449f / 32.0f));
                    const float ang = pos * invf; const float sn = __sinf(ang), cs = __cosf(ang);
                    o1[i] = y1 * cs - y2 * sn; o2[i] = y2 * cs + y1 * sn; }
                else { o1[i] = y1; o2[i] = y2; } }
            v2u wa, wb; wa.x = cvt_pk_bf16(o1[0], o1[1]); wa.y = cvt_pk_bf16(o1[2], o1[3]); wb.x = cvt_pk_bf16(o2[0], o2[1]); wb.y = cvt_pk_bf16(o2[2], o2[3]);
            *(v2u*)p = wa; *(v2u*)(p + 32) = wb;
            {
                unsigned char* p8 = (head < 8) ? Q8 + (size_t)row * D + head * HD + 64 * part + i0 : K8 + (size_t)row * (NKV * HD) + (head - 8) * HD + 64 * part + i0;
                if (head >= 8 || lat) { *(unsigned*)p8 = cvt_pk_fp8x4(o1[0], o1[1], o1[2], o1[3]); *(unsigned*)(p8 + 32) = cvt_pk_fp8x4(o2[0], o2[1], o2[2], o2[3]); } }
        }
        {
            LAS unsigned char* tl = lds;
            for (int it = bid; it < NKV * (NTOK / 64); it += G) { const int kvh = it & 1, tile = it >> 1;
                const int key = tid & 63, dq = tid >> 6;
                const bf16* vp = QKV + (size_t)(tile * 64 + key) * NQKV + 1280 + kvh * HD + dq * 16;
                const v4u a = *(const v4u*)vp, b = *(const v4u*)(vp + 8);
                const unsigned wv[8] = {a.x, a.y, a.z, a.w, b.x, b.y, b.z, b.w};
                const int c = key & 31, slot = 32 * ((c >> 2) & 1) + (c & 3) + 4 * (c >> 3) + 16 * (key >> 5);
#pragma unroll
                for (int i = 0; i < 8; ++i) { const unsigned pk = cvt_pk_fp8x4(bf_lo(wv[i]), bf_hi(wv[i]), 0.f, 0.f);
                    tl[(dq * 16 + 2 * i) * 64 + slot] = (unsigned char)(pk & 0xffu); tl[(dq * 16 + 2 * i + 1) * 64 + slot] = (unsigned char)((pk >> 8) & 0xffu); }
                __syncthreads();
                *(v4u*)(VT8 + ((size_t)kvh * (NTOK / 64) + tile) * 8192 + tid * 16) = *(const LAS v4u*)(tl + tid * 16);
                __syncthreads();
            }
        }
    }
    SEAM(PH_QKROPE);

    if (IN(PH_ATTN)) { PHASE_IDS;
        const float gqm = wave_max(fmaxf(fabsf(q_g[lane]), fabsf(q_g[64 + lane]))), gkm = wave_max(fmaxf(fabsf(k_g[lane]), fabsf(k_g[64 + lane])));
        const float bound = HD * gqm * gkm * att::SCALE * 1.4426950408889634f * 1.02f;
        const bool fast = bound < 26.0f;
        if (__builtin_expect(fast, 1)) {
            const float pscale = exp2f(ceilf(fmaxf(bound - 15.5f, 0.0f)));
            const WConv wc{w_gu, w_down, Wgu8, Wd8}; int ui = 0;
            for (int u = bid; u < NH * (S / 256); u += G, ++ui) { const int head = u & 7, qb = u >> 3, kvh = head >> 2;
                att8::attn_fp8_body(Q8 + (size_t)(qb * 256) * D + head * HD, K8 + kvh * HD, VT8 + (size_t)kvh * (NTOK / 64) * 8192, O + (size_t)(qb * 256) * D + head * HD, NTOK / 64, lds, wave, pscale,
                                    wc, ui * (NTOK / 256) * G + bid, G); }
            for (int q = ui * (NTOK / 256) * G + bid; q < WQ_N; q += G) wquad_whole(wc, q, tid);
        }
#ifndef NO_FALLBACK
        else {
            for (int u = bid; u < NH * (S / 256); u += G) { const int head = u & 7, qb = u >> 3, kvh = head >> 2;
                att::attn_dense_body(QKV + (size_t)(qb * 256) * NQKV + head * HD, QKV + 1024 + kvh * HD, QKV + 1280 + kvh * HD, O + (size_t)(qb * 256) * D + head * HD, NTOK, (LAS char*)lds, wave); }
        }
#endif
    }
    SEAM(PH_ATTN);


#ifdef SELFCHECK
    if (IN(PH_WO)) { PHASE_IDS;
        LAS float* sc_ = (LAS float*)lds; LAS float* qf = sc_ + NTOK; LAS float* red = qf + 128; LAS float* misc = red + 512;
        {
            const int t = (bid * 61 + 7) & (S - 1), h = bid & 7, kvh = h >> 2;
            const bf16* qp = QKV + (size_t)t * NQKV + h * HD;
            if (tid < 128) qf[tid] = bf_lo((unsigned)qp[tid]);
            __syncthreads();
            float mx = -1e30f;
            for (int k = tid; k < NTOK; k += 512) { const bf16* kp = QKV + (size_t)k * NQKV + 1024 + kvh * HD; float a = 0.f;
#pragma unroll 4
                for (int d = 0; d < 128; d += 2) { const unsigned w = *(const unsigned*)(kp + d); a += qf[d] * bf_lo(w) + qf[d + 1] * bf_hi(w); }
                sc_[k] = a; mx = fmaxf(mx, a); }
            mx = wave_max(mx); if (lane == 0) misc[wave] = mx; __syncthreads();
            mx = misc[0]; for (int w = 1; w < 8; ++w) mx = fmaxf(mx, misc[w]);
            __syncthreads();
            float ls = 0.f;
            for (int k = tid; k < NTOK; k += 512) { const float p = exp2f(sc_[k] - mx); sc_[k] = p; ls += p; }
            ls = wave_sum(ls); if (lane == 0) misc[8 + wave] = ls; __syncthreads();
            ls = 0.f; for (int w = 0; w < 8; ++w) ls += misc[8 + w];
            const int d = tid & 127, part = tid >> 7; float acc = 0.f;
            for (int k = part; k < NTOK; k += 4) acc += sc_[k] * bf_lo((unsigned)QKV[(size_t)k * NQKV + 1280 + kvh * HD + d]);
            red[part * 128 + d] = acc; __syncthreads();
            if (tid < 128) { const float ref = (red[d] + red[128 + d] + red[256 + d] + red[384 + d]) / ls; const float got = bf_lo((unsigned)O[(size_t)t * D + h * HD + d]);
                float am = fabsf(ref); for (int o = 32; o >= 1; o >>= 1) am = fmaxf(am, __shfl_xor(am, o)); misc[16 + (tid >> 6)] = am; }
            __syncthreads();
            if (tid < 128) { const float ref = (red[d] + red[128 + d] + red[256 + d] + red[384 + d]) / ls; const float got = bf_lo((unsigned)O[(size_t)t * D + h * HD + d]);
                const float am = fmaxf(misc[16], misc[17]); if (!(fabsf(got - ref) <= 0.02f * am + 1e-7f)) atomicOr(ctl + 2, 1u); }
            __syncthreads();
        }
        {
            const int t = (bid * 97 + 13) % NTOK, h = (t >= S) ? 8 + (bid & 1) : (bid % 10);
            const int d = tid & 127, kq = tid >> 7; float a = 0.f;
            const unsigned char* hp = H8 + (size_t)t * D + kq * 256; const unsigned char* wp = Wqkv8 + (size_t)(h * HD + d) * D + kq * 256;
#pragma unroll 4
            for (int k = 0; k < 256; ++k) a += __builtin_amdgcn_cvt_f32_fp8((int)hp[k], 0) * __builtin_amdgcn_cvt_f32_fp8((int)wp[k], 0) * (1.0f / WSCALE);
            red[kq * 128 + d] = a; __syncthreads();
            if (tid < 128) qf[d] = red[d] + red[128 + d] + red[256 + d] + red[384 + d];
            __syncthreads();
            if (tid < 128) { float ss = 0.f;
#pragma unroll 4
                for (int i = 0; i < 128; ++i) ss += qf[i] * qf[i];
                const float rs = 1.0f / sqrtf(ss * (1.0f / HD) + NORM_EPS); const float* gp = h < 8 ? q_g : k_g;
                const int idx = d & 63, pr = d >> 6, fi = idx & 31; const float y = qf[d] * rs * gp[d]; float out = y;
                if (t < S) { const int dp = (idx < 32) ? d + 32 : d - 32; const float yp = qf[dp] * rs * gp[dp];
                    const double pos = (double)(pr ? (t & 63) : (t >> 6)); const double ang = pos * (double)exp2f(-(float)fi * (13.287712379549449f / 32.0f));
                    const double rr = ang - 6.283185307179586 * rint(ang * 0.15915494309189535); const float sn = __sinf((float)rr), cs = __cosf((float)rr);
                    out = (idx < 32) ? (y * cs - yp * sn) : (y * cs + yp * sn); }
                if (h < 8) out *= att::SCALE * 1.4426950408889634f;
                const float got = bf_lo((unsigned)QKV[(size_t)t * NQKV + h * HD + d]);
                float am = fabsf(out); for (int o = 32; o >= 1; o >>= 1) am = fmaxf(am, __shfl_xor(am, o));
                if (!(fabsf(got - out) <= 0.03f * am + 1e-7f)) atomicOr(ctl + 2, 2u); }
            __syncthreads();
        }
    }
#endif
    if (IN(PH_WO)) { PHASE_IDS;
        pg8::ProbDense<2> P; P.init(O, Wo_t, S, D, D, D, D, 0, G, bid);
        pg8::EpiBf16 E{YZ, D, nullptr, 0, 1.0f};
        pg8::gemm_phase(lds, P, E, wave);
    }
    SEAM(PH_WO);

#define ZLD2(U, J) (*(const v2u*)(YZ + (size_t)(U) * D + 4 * lane + 256 * (J)))
#define BF4(z_) ((f32x4){bf_lo((z_).x), bf_hi((z_).x), bf_lo((z_).y), bf_hi((z_).y)})
#define RDECL0 v2u ya[4][4]
#define RLD0(I, ROW, V) do { ld_row(x + (size_t)(ROW) * D, lane, V); _Pragma("unroll") for (int j = 0; j < 4; ++j) ya[I][j] = ZLD2(ROW, j); } while (0)
#define RFIN0(I, ROW, V) do { _Pragma("unroll") for (int j = 0; j < 4; ++j) { const f32x4 g_ = *(const f32x4*)(MOD + 2 * 1024 + 4 * lane + 256 * j); V[j] += g_ * BF4(ya[I][j]); } \
        st_row_bf16(XA + (size_t)(ROW) * D, lane, V); } while (0)
#define RINIT0(T0) do { } while (0)
#define RDECL1 v2u zt[4][4], za[4][4], zo[4][4]
#define RINIT1(T0) do { _Pragma("unroll") for (int j = 0; j < 4; ++j) { const int half_ = 1 << j; int lo_ = (T0) - half_; if (lo_ < 0) lo_ = 0; int hi_ = (T0) + half_; if (hi_ > S) hi_ = S; \
            zs[j] = (f32x4){0.f, 0.f, 0.f, 0.f}; for (int u_ = lo_; u_ < hi_; ++u_) { const v2u z_ = ZLD2(u_, j); zs[j] += BF4(z_); } } } while (0)
#define RLD1(I, ROW, V) do { ld_row_bf16(XB + (size_t)(ROW) * D, lane, V); \
        _Pragma("unroll") for (int j = 0; j < 4; ++j) { const int half_ = 1 << j, ia_ = (ROW) + half_, is_ = (ROW) - half_; \
            zt[I][j] = ZLD2(ROW, j); za[I][j] = ZLD2(ia_ < S ? ia_ : S - 1, j); zo[I][j] = ZLD2(is_ > 0 ? is_ : 0, j); } } while (0)
#define RFIN1(I, ROW, V) do { \
        _Pragma("unroll") for (int j = 0; j < 4; ++j) { const int half_ = 1 << j, t_ = (ROW); int lo_ = t_ - half_; if (lo_ < 0) lo_ = 0; int hi_ = t_ + half_; if (hi_ > S) hi_ = S; \
            const int ia_ = t_ + half_, is_ = t_ - half_;                       \
            const f32x4 p_ = zs[j] * (1.0f / (float)(hi_ - lo_)) - BF4(zt[I][j]); \
            const f32x4 g_ = *(const f32x4*)(MOD + 6144 + 2 * 1024 + 4 * lane + 256 * j) * *(const f32x4*)(pool_scale + 4 * lane + 256 * j); \
            V[j] += g_ * p_; zs[j] += BF4(za[I][j]) * (ia_ < S ? 1.0f : 0.0f) - BF4(zo[I][j]) * (is_ >= 0 ? 1.0f : 0.0f); } \
        st_row_bf16(XC + (size_t)(ROW) * D, lane, V); } while (0)
#define ROUTE_PHASE(LAYER, RDECL, RLD, RFIN, RINIT, RG) do { \
        const float* modp = MOD + (LAYER) * 6144; const float* gn = norm_ffn + (LAYER) * 1024; const float* rb = router_b + (LAYER) * 32; \
        unsigned* gcnt = ctl + CW_CNT + (LAYER) * 2048; \
        LAS unsigned* lcnt = (LAS unsigned*)(lds + L_LCNT); LAS unsigned* lbase = (LAS unsigned*)(lds + L_LBASE); \
        LAS int* ent_e = (LAS int*)(lds + L_ENT); LAS int* ent_p = ent_e + 256; LAS float* ent_w = (LAS float*)(ent_e + 512); \
        LAS float* part = (LAS float*)(lds + L_OFFS); LAS float* lgt = part + 2048;          \
        f32x4 av[4], bv[4]; \
        _Pragma("unroll") for (int j = 0; j < 4; ++j) { const int col = 4 * lane + 256 * j; const f32x4 g = *(const f32x4*)(gn + col); av[j] = g * (1.0f + *(const f32x4*)(modp + 4 * 1024 + col)); bv[j] = *(const f32x4*)(modp + 3 * 1024 + col); } \
        const int et = wave & 1, rt = (wave >> 1) & 1, kh = wave >> 2; \
        const bf16* wf = WF + ((size_t)((((LAYER) * 2 + et) * 2 + kh) * 16) * 2 * 64 + lane) * 8;       \
        const int brow = rt * 16 + (lane & 15), bkq = lane >> 4; \
        for (int c0 = bid; c0 < S / 32; c0 += 2 * G) { \
          if (tid < 32) lcnt[tid] = 0u; \
          for (int cs = 0; cs < 2; ++cs) { const int chunk = c0 + cs * G; if (chunk >= S / 32) break;        \
            f32x4 zs[4]; (void)zs; RINIT(chunk * 32 + wave * 4); \
            f32x4 hr[4][4]; RDECL; \
            _Pragma("unroll") for (int g_ = 0; g_ < 4; g_ += (RG)) {        \
                _Pragma("unroll") for (int i = g_; i < g_ + (RG); ++i) RLD(i, chunk * 32 + wave * 4 + i, hr[i]); \
                _Pragma("unroll") for (int i = g_; i < g_ + (RG); ++i) RFIN(i, chunk * 32 + wave * 4 + i, hr[i]); } \
            _Pragma("unroll") for (int i = 0; i < 4; ++i) { \
                const int rl = wave * 4 + i, row = chunk * 32 + rl; \
                f32x4 (&h)[4] = hr[i]; \
                const float rs = row_rstd(h); \
                _Pragma("unroll") for (int j = 0; j < 4; ++j) h[j] = h[j] * rs * av[j] + bv[j]; \
                st_row_fp8(H8 + (size_t)row * D, lane, h); \
                _Pragma("unroll") for (int j = 0; j < 4; ++j) { v2u hi_; hi_.x = cvt_pk_bf16(h[j][0], h[j][1]); hi_.y = cvt_pk_bf16(h[j][2], h[j][3]); \
                    const f32x4 r_ = h[j] - (f32x4){bf_lo(hi_.x), bf_hi(hi_.x), bf_lo(hi_.y), bf_hi(hi_.y)}; v2u lo_; lo_.x = cvt_pk_bf16(r_[0], r_[1]); lo_.y = cvt_pk_bf16(r_[2], r_[3]); \
                    const int off_ = rl * 2048 + ((((lane >> 1) + 32 * j) ^ (rl & 15)) << 4) + (lane & 1) * 8; \
                    *(LAS v2u*)(lds + off_) = hi_; *(LAS v2u*)(lds + 65536 + off_) = lo_; } \
            } \
            __syncthreads(); \
            { f32x4 acc_ = (f32x4){0.f, 0.f, 0.f, 0.f}; \
              _Pragma("unroll 4") for (int ks = 0; ks < 16; ++ks) { \
                  const bf16x8 ahi = *(const bf16x8*)(wf + (size_t)(ks * 2) * 512), alo = *(const bf16x8*)(wf + (size_t)(ks * 2 + 1) * 512); \
                  const int boff = brow * 2048 + ((((kh * 512 + ks * 32) >> 3) + bkq) ^ (brow & 15)) * 16; \
                  const bf16x8 bhi = *(const LAS bf16x8*)(lds + boff), blo = *(const LAS bf16x8*)(lds + 65536 + boff); \
                  acc_ = __builtin_amdgcn_mfma_f32_16x16x32_bf16(ahi, bhi, acc_, 0, 0, 0); acc_ = __builtin_amdgcn_mfma_f32_16x16x32_bf16(ahi, blo, acc_, 0, 0, 0); acc_ = __builtin_amdgcn_mfma_f32_16x16x32_bf16(alo, bhi, acc_, 0, 0, 0); } \
              _Pragma("unroll") for (int r = 0; r < 4; ++r) part[wave * 256 + (4 * (lane >> 4) + r) * 16 + (lane & 15)] = acc_[r]; } \
            __syncthreads(); \
            _Pragma("unroll") for (int o_ = 0; o_ < 2; ++o_) { const int idx = tid + 512 * o_, row_ = idx >> 5, e_ = idx & 31; const int w0_ = (e_ >> 4) + 2 * (row_ >> 4), pi_ = (e_ & 15) * 16 + (row_ & 15); \
                lgt[row_ * 33 + e_] = part[w0_ * 256 + pi_] + part[(w0_ + 4) * 256 + pi_] + rb[e_]; } \
            __syncthreads(); \
            if (tid < 32) { const LAS float* lr = lgt + tid * 33; unsigned taken = 0u; int se[4]; float sv[4]; \
                _Pragma("unroll") for (int k = 0; k < 4; ++k) { float mx = -INFINITY; int me = 0; \
                    for (int e = 0; e < 32; ++e) { const float v = lr[e]; const bool ok = !((taken >> e) & 1u) && v > mx; mx = ok ? v : mx; me = ok ? e : me; } \
                    taken |= 1u << me; se[k] = me; sv[k] = mx; } \
                const float e1 = __expf(sv[1] - sv[0]), e2 = __expf(sv[2] - sv[0]), e3 = __expf(sv[3] - sv[0]); const float inv = 1.0f / (1.0f + e1 + e2 + e3); \
                const float ww[4] = {inv, e1 * inv, e2 * inv, e3 * inv}; \
                _Pragma("unroll") for (int k = 0; k < 4; ++k) { const unsigned pl = __hip_atomic_fetch_add(lcnt + se[k], 1u, __ATOMIC_RELAXED, __HIP_MEMORY_SCOPE_WORKGROUP); \
                    const int ei = (cs * 32 + tid) * 4 + k; ent_e[ei] = se[k]; ent_p[ei] = (int)pl; ent_w[ei] = ww[k]; } } \
            __syncthreads(); \
          } \
          if (tid < 32) { const unsigned c_ = lcnt[tid]; unsigned base = 0u; if (c_) base = __hip_atomic_fetch_add(gcnt + 64 * tid, c_, RLX_AGENT); lbase[tid] = base; } \
          __syncthreads(); \
          if (tid < 256) { const int cs = tid >> 7, rl = (tid >> 2) & 31; const int chunk = c0 + cs * G; \
              if (chunk < S / 32) { const int e = ent_e[tid]; const int pos = (int)lbase[e] + ent_p[tid]; const int tok = chunk * 32 + rl; \
                  tok_list[e * S + pos] = tok; tok_e[tok * 4 + (tid & 3)] = e; tok_pos[tok * 4 + (tid & 3)] = pos; tok_w[tok * 4 + (tid & 3)] = ent_w[tid]; } } \
          __syncthreads(); \
        } } while (0)

#define MOE1_PHASE(LAYER) do { \
        const int n_my = moe_build_units(lds, ctl + CW_CNT + (LAYER) * 2048, tok_list, 8, true, D, G, bid, tid); \
        pg8::ProbMoE<true, 1> P{H8, Wgu8 + (size_t)(LAYER) * 32 * 2048 * 1024, D, D, n_my, (size_t)2048 * 1024, lds, 2048}; \
        pg8::EpiSwiglu E{ACT8, b_gu + (size_t)(LAYER) * 32 * 2048, 1.0f / WSCALE}; \
        pg8::gemm_phase(lds, P, E, wave); } while (0)
#define MOE2_PHASE(LAYER) do { \
        const int n_my = moe_build_units(lds, ctl + CW_CNT + (LAYER) * 2048, tok_list, 4, false, D, G, bid, tid); \
        pg8::ProbMoE<false, 1> P{ACT8, Wd8 + (size_t)(LAYER) * 32 * 1024 * 1024, D, D, n_my, (size_t)1024 * 1024, lds, 1024}; \
        pg8::EpiBf16 E{Y, D, b_down + (size_t)(LAYER) * 32 * 1024, 1024, 1.0f / WSCALE}; \
        pg8::gemm_phase(lds, P, E, wave); } while (0)
#define COMBINE_ROW(LAYER, XIN, ROW, V) do { \
        ld_row_bf16((XIN) + (size_t)(ROW) * D, lane, V); \
        const v4i te = *(const v4i*)(tok_e + (ROW) * 4), tp = *(const v4i*)(tok_pos + (ROW) * 4); const f32x4 tw = *(const f32x4*)(tok_w + (ROW) * 4); \
        f32x4 a_[4]; _Pragma("unroll") for (int j = 0; j < 4; ++j) a_[j] = (f32x4){0.f, 0.f, 0.f, 0.f}; \
        _Pragma("unroll") for (int k = 0; k < 4; ++k) { const int e = __builtin_amdgcn_readfirstlane(te[k]); const int pos = __builtin_amdgcn_readfirstlane(tp[k]); const float w = tw[k]; \
            const int prow = (int)__builtin_amdgcn_readlane(tbv, e) * 256 + pos; const bf16* yr = Y + (size_t)prow * D; \
            _Pragma("unroll") for (int j = 0; j < 4; ++j) { const v2u y = *(const v2u*)(yr + 4 * lane + 256 * j); a_[j] += w * (f32x4){bf_lo(y.x), bf_hi(y.x), bf_lo(y.y), bf_hi(y.y)}; } } \
        _Pragma("unroll") for (int j = 0; j < 4; ++j) V[j] = V[j] + gfv[j] * a_[j]; } while (0)
#define TILE_BASE(LAYER) \
        int tbv; { const unsigned cnt = (lane < NE) ? __hip_atomic_load(ctl + CW_CNT + (LAYER) * 2048 + 64 * lane, RLX_AGENT) : 0u; unsigned incl = (cnt + 255u) >> 8; const unsigned own = incl; \
            _Pragma("unroll") for (int o = 1; o < 32; o <<= 1) { const unsigned t = __shfl_up(incl, o); if (lane >= o) incl += t; } tbv = (int)(incl - own); }

    if (IN(PH_ROUTE0)) { PHASE_IDS; ROUTE_PHASE(0, RDECL0, RLD0, RFIN0, RINIT0, 4); }
    SEAM(PH_ROUTE0);
    if (IN(PH_MOE1_0)) { PHASE_IDS; MOE1_PHASE(0); }
    SEAM(PH_MOE1_0);
    if (IN(PH_MOE2_0)) { PHASE_IDS; MOE2_PHASE(0); }
    SEAM(PH_MOE2_0);

    if (IN(PH_COMB0)) { PHASE_IDS;
        TILE_BASE(0)
        f32x4 gfv[4], av[4], bv[4];
#pragma unroll
        for (int j = 0; j < 4; ++j) { const int col = 4 * lane + 256 * j; gfv[j] = *(const f32x4*)(MOD + 5 * 1024 + col);
            const f32x4 g = *(const f32x4*)(norm_mix + 1024 + col); av[j] = g * (1.0f + *(const f32x4*)(MOD + 6144 + 1024 + col)); bv[j] = *(const f32x4*)(MOD + 6144 + col); }
        for (int r = gw; r < S; r += NGW) { f32x4 v[4]; COMBINE_ROW(0, XA, r, v);
            st_row_bf16(XB + (size_t)r * D, lane, v); const float rs = row_rstd(v);
#pragma unroll
            for (int j = 0; j < 4; ++j) v[j] = v[j] * rs * av[j] + bv[j];
            st_row_bf16(H1B + (size_t)r * D, lane, v); }
    }
    SEAM(PH_COMB0);

    if (IN(PH_POOLG)) { PHASE_IDS;
        pg8::ProbDense<2> P; P.init(H1B, Wpool_t, S, D, 256, D, 256, 256, G, bid);
        pg8::EpiBf16 E{YZ, D, nullptr, 0, 1.0f};
        pg8::gemm_phase(lds, P, E, wave);
    }
    SEAM(PH_POOLG);

    if (IN(PH_ROUTE1)) { PHASE_IDS; ROUTE_PHASE(1, RDECL1, RLD1, RFIN1, RINIT1, 2); }
    SEAM(PH_ROUTE1);
    if (IN(PH_MOE1_1)) { PHASE_IDS; MOE1_PHASE(1); }
    SEAM(PH_MOE1_1);
    if (IN(PH_MOE2_1)) { PHASE_IDS; MOE2_PHASE(1); }
    SEAM(PH_MOE2_1);

    if (IN(PH_FINAL)) { PHASE_IDS;
        TILE_BASE(1)
        f32x4 gfv[4], fv[4];
#pragma unroll
        for (int j = 0; j < 4; ++j) { const int col = 4 * lane + 256 * j; gfv[j] = *(const f32x4*)(MOD + 6144 + 5 * 1024 + col); fv[j] = *(const f32x4*)(final_norm + col); }
        for (int r = gw; r < S; r += NGW) { f32x4 v[4]; COMBINE_ROW(1, XC, r, v);
            const float rs = row_rstd(v);
#pragma unroll
            for (int j = 0; j < 4; ++j) v[j] = v[j] * rs * fv[j];
#ifdef SELFCHECK
            if (__hip_atomic_load(ctl + 2, RLX_AGENT) != 0u) { for (int j = 0; j < 4; ++j) v[j] = (f32x4){__builtin_nanf(""), __builtin_nanf(""), __builtin_nanf(""), __builtin_nanf("")}; }
#endif
            st_row(args.out + (size_t)r * D, lane, v); }
    }
#undef IN
#undef SEAM
}

extern "C" void kernel_launch(void* const* d_in, const int* in_sizes, int n_in, void* d_out, int out_size, void* d_ws, size_t ws_size, hipStream_t stream) {
    static int grid = 0;
    if (grid == 0) {
        if (n_in != 21 || in_sizes[0] != S * D || out_size != S * D || ws_size < WS_END) { fprintf(stderr, "kernel_launch: unexpected shapes (n_in %d, in0 %d, out %d, ws %zu)\n", n_in, n_in > 0 ? in_sizes[0] : -1, out_size, ws_size); grid = -1; return; }
        int dev = 0, cus = 0, per_cu = 0;
        if (hipGetDevice(&dev) != hipSuccess || hipDeviceGetAttribute(&cus, hipDeviceAttributeMultiprocessorCount, dev) != hipSuccess) { grid = -1; return; }
        if (hipFuncSetAttribute((const void*)fwd_kernel, hipFuncAttributeMaxDynamicSharedMemorySize, LDS_BYTES) != hipSuccess) { fprintf(stderr, "kernel_launch: hipFuncSetAttribute failed\n"); grid = -1; return; }
        if (hipOccupancyMaxActiveBlocksPerMultiprocessor(&per_cu, (const void*)fwd_kernel, 512, LDS_BYTES) != hipSuccess || per_cu < 1) { fprintf(stderr, "kernel_launch: occupancy query says %d\n", per_cu); }
        (void)hipGetLastError();
        grid = cus;
    }
    if (grid < 0) return;
    if (hipMemsetAsync((char*)d_ws + WS_CTL, 0, CTL_ZERO_BYTES, stream) != hipSuccess) return;
    Args a{};
    for (int i = 0; i < 21; ++i) a.in[i] = (const float*)d_in[i];
    a.out = (float*)d_out; a.ws = (unsigned char*)d_ws;
    if (MK_N_LAUNCHES == 1) { a.ph_lo = 0; a.ph_hi = NPHASE; hipLaunchKernelGGL(fwd_kernel, dim3(grid), dim3(512), LDS_BYTES, stream, a); }
    else for (int p = 0; p < NPHASE; ++p) { a.ph_lo = p; a.ph_hi = p + 1; hipLaunchKernelGGL(fwd_kernel, dim3(grid), dim3(512), LDS_BYTES, stream, a); }
    if (PROBE_REP >= 0) { a.ph_lo = PROBE_REP; a.ph_hi = PROBE_REP + 1; hipLaunchKernelGGL(fwd_kernel, dim3(grid), dim3(512), LDS_BYTES, stream, a); }
    const hipError_t le = hipPeekAtLastError();
    if (le != hipSuccess) fprintf(stderr, "kernel_launch: launch failed: %s\n", hipGetErrorName(le));
}
```

```cpp
#include <hip/hip_runtime.h>
#include <cstdio>
#include <cstdint>

#ifndef MK_N_LAUNCHES
#define MK_N_LAUNCHES 1
#endif
#ifndef PROBE_REP
#define PROBE_REP -1
#endif

#define GAS __attribute__((address_space(1)))
#define LAS __attribute__((address_space(3)))
typedef unsigned short bf16;
typedef unsigned v4u __attribute__((ext_vector_type(4)));
typedef unsigned v2u __attribute__((ext_vector_type(2)));
typedef int v4i __attribute__((ext_vector_type(4)));
typedef float f32x4 __attribute__((ext_vector_type(4)));
typedef float f32x2 __attribute__((ext_vector_type(2)));
typedef float f32x16 __attribute__((ext_vector_type(16)));
typedef short bf16x8 __attribute__((ext_vector_type(8)));
typedef short s16x4 __attribute__((ext_vector_type(4)));
typedef int v8i __attribute__((ext_vector_type(8)));

constexpr int S = 16384, CT = 256, NTOK = S + CT, D = 1024, NQKV = 1536, NE = 32, HD = 128, NH = 8, NKV = 2;
constexpr int GRID_W = 64;
constexpr float NORM_EPS = 1e-6f;
constexpr int NPHASE = 15;
constexpr float WSCALE = 32.0f;
enum Phase { PH_PRO = 0, PH_NORM1, PH_QKV, PH_QKROPE, PH_ATTN, PH_WO, PH_ROUTE0, PH_MOE1_0, PH_MOE2_0, PH_COMB0, PH_POOLG, PH_ROUTE1, PH_MOE1_1, PH_MOE2_1, PH_FINAL };

constexpr size_t MiB = 1u << 20;
constexpr size_t WS_CTL = 0, CTL_ZERO_BYTES = 1 * MiB;
constexpr size_t WS_MOD = 1 * MiB;
constexpr size_t WS_WQKV = 2 * MiB;
constexpr size_t WS_WO = 5 * MiB;
constexpr size_t WS_WPOOL = 7 * MiB;
constexpr size_t WS_TOKLIST = 8 * MiB;
constexpr size_t WS_TOKE = 10 * MiB;
constexpr size_t WS_TOKP = 10 * MiB + 256 * 1024;
constexpr size_t WS_TOKW = 10 * MiB + 512 * 1024;
constexpr size_t WS_H = 16 * MiB;
constexpr size_t WS_QKV = 52 * MiB;
constexpr size_t WS_O = 104 * MiB;
constexpr size_t WS_XA = 136 * MiB;
constexpr size_t WS_XB = 200 * MiB;
constexpr size_t WS_XC = 264 * MiB;
constexpr size_t WS_H1F = 328 * MiB;
constexpr size_t WS_POOLED = 392 * MiB;
constexpr size_t WS_ACT = 424 * MiB;
constexpr size_t WS_Y = 568 * MiB;
constexpr size_t WS_WGU = 712 * MiB;
constexpr size_t WS_WD = 968 * MiB;
constexpr size_t WS_Q8 = 1040 * MiB;
constexpr size_t WS_K8 = 1056 * MiB;
constexpr size_t WS_VT8 = 1062 * MiB;
constexpr size_t WS_END = 1096 * MiB;
constexpr int CW_BAR = 4096;
constexpr int CW_CNT = 8192;

constexpr int RING_BYTES = 131072;
constexpr int MISC_OFF = RING_BYTES;
constexpr int L_LCNT = MISC_OFF + 64;
constexpr int L_LBASE = MISC_OFF + 192;
constexpr int L_TB = MISC_OFF + 320;
constexpr int L_CNT = MISC_OFF + 480;
constexpr int L_UT = MISC_OFF + 640;
constexpr int L_ENT = MISC_OFF + 1280;
constexpr int L_OFFS = MISC_OFF + 4608;
constexpr int LDS_BYTES = MISC_OFF + 4608 + 16384 + 256;
static_assert(LDS_BYTES <= 163840, "LDS");

#define RLX_AGENT __ATOMIC_RELAXED, __HIP_MEMORY_SCOPE_AGENT
#define LDS_WAIT() asm volatile("s_waitcnt lgkmcnt(0)" ::: "memory")
#define VM_WAIT() asm volatile("s_waitcnt vmcnt(0)" ::: "memory")

__device__ __forceinline__ int fresh_lane() { int l; asm volatile("v_mbcnt_lo_u32_b32 %0, -1, 0\n\tv_mbcnt_hi_u32_b32 %0, -1, %0" : "=v"(l)); return l; }
__device__ __forceinline__ unsigned cvt_pk_bf16(float lo, float hi) { unsigned r; asm volatile("v_cvt_pk_bf16_f32 %0, %1, %2" : "=v"(r) : "v"(lo), "v"(hi)); return r; }
__device__ __forceinline__ unsigned cvt_pk_fp8x4(float a, float b, float c, float d) { int w = 0; w = __builtin_amdgcn_cvt_pk_fp8_f32(a, b, w, false); w = __builtin_amdgcn_cvt_pk_fp8_f32(c, d, w, true); return (unsigned)w; }
__device__ __forceinline__ float bf_lo(unsigned w) { return __uint_as_float(w << 16); }
__device__ __forceinline__ float bf_hi(unsigned w) { return __uint_as_float(w & 0xffff0000u); }
__device__ __forceinline__ float wave_sum(float v) {
#pragma unroll
    for (int o = 32; o >= 1; o >>= 1) v += __shfl_xor(v, o);
    return v;
}
__device__ __forceinline__ float wave_max(float v) {
#pragma unroll
    for (int o = 32; o >= 1; o >>= 1) v = fmaxf(v, __shfl_xor(v, o));
    return v;
}

#define XB_TMO      128
#define XB_XCNT(j)  (256  + 64 * (j))
#define XB_XSUB(j)  (1280 + 64 * (j))
#define XB_XGEN(j)  (2304 + 64 * (j))
#define XB_TOP      3328
#define XB_TOPGEN   3392
#define XCD_BAR_WORDS 3456
#define XB_SPIN_CAP (1u << 18)
__device__ __forceinline__ unsigned xb_ld(unsigned* p)              { return __hip_atomic_load(p, __ATOMIC_RELAXED, __HIP_MEMORY_SCOPE_AGENT); }
__device__ __forceinline__ unsigned xb_add(unsigned* p, unsigned v) { return __hip_atomic_fetch_add(p, v, __ATOMIC_RELAXED, __HIP_MEMORY_SCOPE_AGENT); }
__device__ __forceinline__ unsigned xb_xcc_id() { return (unsigned)__builtin_amdgcn_s_getreg((3 << 11) | 20) & 0xFu; }
#define XB_SPIN(cond, bar) do { unsigned _sp = 0; while (cond) { __builtin_amdgcn_s_sleep(1); \
    if ((++_sp & 255u) == 0u) { if (xb_ld(&(bar)[XB_TMO])) break; if (_sp > XB_SPIN_CAP) { atomicAdd(&(bar)[XB_TMO], 1u); break; } } } } while (0)
struct XcdBarrier { unsigned* bar; unsigned x; volatile LAS unsigned* st; int wave; };
__device__ __forceinline__ XcdBarrier xcd_barrier_post(unsigned* bar, volatile LAS unsigned* st, int wave) {
    XcdBarrier b; b.bar = bar; b.x = xb_xcc_id(); b.st = st; b.wave = wave;
    if (wave == 0 && fresh_lane() == 0) (void)xb_add(&bar[XB_XCNT(b.x)], 1u);
    return b;
}
__device__ __forceinline__ void xcd_barrier_complete(unsigned* bar, unsigned x, unsigned& nloc, unsigned& nx) {
    const unsigned G = gridDim.x * gridDim.y * gridDim.z;
    unsigned sum, cnt, mine, sp = 0u;
    for (;;) {
        sum = 0u; cnt = 0u; mine = 0u;
#pragma unroll
        for (unsigned j = 0; j < 16; ++j) { const unsigned c = xb_ld(&bar[XB_XCNT(j)]); sum += c; cnt += (c > 0u) ? 1u : 0u; mine = (j == x) ? c : mine; }
        if (sum == G) break;
        __builtin_amdgcn_s_sleep(1);
        if ((++sp & 255u) == 0u) { if (xb_ld(&bar[XB_TMO])) break; if (sp > XB_SPIN_CAP) { atomicAdd(&bar[XB_TMO], 1u); break; } }
    }
    nloc = mine > 0u ? mine : 1u; nx = cnt > 0u ? cnt : 1u;
}
__device__ __forceinline__ void xcd_barrier(const XcdBarrier& b) {
    asm volatile("s_waitcnt vmcnt(0)" ::: "memory");
    __syncthreads();
    if (b.wave == 0 && fresh_lane() == 0) {
        unsigned* bar = b.bar;
        __builtin_amdgcn_s_waitcnt(0);
        unsigned nloc = b.st[0], nx = b.st[1];
        if (nloc == 0u) { xcd_barrier_complete(bar, b.x, nloc, nx); b.st[0] = nloc; b.st[1] = nx; }
        const unsigned old = xb_add(&bar[XB_XSUB(b.x)], 1u);
        const unsigned gen = old / nloc;
        if (old + 1u == (gen + 1u) * nloc) {
            __builtin_amdgcn_fence(__ATOMIC_RELEASE, "agent");
            asm volatile("s_waitcnt vmcnt(0)" ::: "memory");
            const unsigned og = xb_add(&bar[XB_TOP], 1u);
            const unsigned tg = og / nx;
            if (og + 1u == (tg + 1u) * nx) xb_add(&bar[XB_TOPGEN], 1u);
            else XB_SPIN(xb_ld(&bar[XB_TOPGEN]) == tg, bar);
            __builtin_amdgcn_fence(__ATOMIC_ACQUIRE, "agent");
            xb_add(&bar[XB_XGEN(b.x)], 1u);
            asm volatile("s_waitcnt vmcnt(0)" ::: "memory");
        } else {
            XB_SPIN(xb_ld(&bar[XB_XGEN(b.x)]) == gen, bar);
            __builtin_amdgcn_fence(__ATOMIC_ACQUIRE, "agent");
            asm volatile("s_waitcnt vmcnt(0)" ::: "memory");
        }
    }
    __syncthreads();
}

namespace pg8 {
constexpr int BM = 256, BK = 64, HALF = 128, HTB = HALF * BK * 2, NXCD = 8, WGM = 8;
__device__ __forceinline__ int lds_byte(int r, int c) { const int st = (r >> 4) * 2 + (c >> 5), rr = r & 15, cc = c & 31, ob = rr * 64 + cc * 2; return st * 1024 + (ob ^ (((ob >> 9) & 1) << 5)); }
__device__ __forceinline__ void stage_rc(int b, int& R, int& C) { const int st = b / 1024, sb = b % 1024, swz = sb ^ (((sb >> 9) & 1) << 5); R = (st >> 1) * 16 + swz / 64; C = (st & 1) * 32 + (swz % 64) / 2; }
__device__ __forceinline__ int perm32(int rho) { const int n = rho >> 4, i = rho & 15; return 8 * (i >> 2) + 4 * n + (i & 3); }

struct GU { const char* A; const char* B; int orow0; int pn; int e; int slot; };

template <int ESZ_> struct ProbDense {
    static constexpr int ESZ = ESZ_; static constexpr bool BIL = false; static constexpr int nB = 0;
    const unsigned char* A; const unsigned char* Bt; int lda, ldb, K, acol; int nM, nN, nwg, G, c;
    __device__ __forceinline__ void init(const void* A_, const void* Bt_, int M, int N, int K_, int lda_, int ldb_, int acol_, int G_, int c_) {
        A = (const unsigned char*)A_; Bt = (const unsigned char*)Bt_; lda = lda_; ldb = ldb_; K = K_; acol = acol_; nM = M / BM; nN = N / BM; nwg = nM * nN; G = G_; c = c_; }
    __device__ __forceinline__ bool next(int i, GU& u) const {
        const long L = (long)i * G + c; if (L >= nwg) return false;
        int wgid = (int)L; { const int q = nwg / NXCD, r = nwg % NXCD, xcd = wgid % NXCD, off = wgid / NXCD; wgid = (xcd < r ? xcd * (q + 1) : r * (q + 1) + (xcd - r) * q) + off; }
        const int nig = WGM * nN, gid = wgid / nig, fm = gid * WGM, gsz = (nM - fm) < WGM ? (nM - fm) : WGM;
        const int pm = fm + ((wgid % nig) % gsz), pn = (wgid % nig) / gsz;
        u.A = (const char*)(A + ((size_t)pm * BM * lda + (size_t)pn * acol) * ESZ); u.B = (const char*)(Bt + (size_t)pn * BM * ldb * ESZ); u.orow0 = pm * BM; u.pn = pn; u.e = 0; u.slot = i; return true;
    }
    __device__ __forceinline__ void a_offs(const GU&, const int (&R)[2], const int (&C)[2], unsigned (&vo)[2][2], LAS unsigned char*) const {
#pragma unroll
        for (int h = 0; h < 2; ++h)
#pragma unroll
            for (int i = 0; i < 2; ++i) vo[h][i] = (unsigned)((R[i] + HALF * h) * lda * ESZ + C[i] * 2);
    }
};
template <bool GATHER, int ESZ_> struct ProbMoE {
    static constexpr int ESZ = ESZ_; static constexpr bool BIL = true;
    const unsigned char* A; const unsigned char* Bt; int ldb, K; int n_my; size_t b_expert_stride  ; LAS unsigned char* ldsp; int nB;
    __device__ __forceinline__ bool next(int i, GU& u) const {
        if (i >= n_my) return false;
        const LAS int* ut = (const LAS int*)(ldsp + L_UT) + i * 8;
        const int e = __builtin_amdgcn_readfirstlane(ut[0]), pn = __builtin_amdgcn_readfirstlane(ut[2]), mtg = __builtin_amdgcn_readfirstlane(ut[3]);
        u.e = e; u.pn = pn; u.orow0 = mtg * BM; u.slot = i;
        u.A = GATHER ? (const char*)A : (const char*)(A + (size_t)mtg * BM * D * ESZ);
        u.B = (const char*)(Bt + (size_t)e * b_expert_stride + (size_t)pn * BM * 16);
        return true;
    }
    __device__ __forceinline__ void a_offs(const GU& u, const int (&R)[2], const int (&C)[2], unsigned (&vo)[2][2], LAS unsigned char* lds) const {
        if (GATHER) {
            const LAS unsigned* offs = (const LAS unsigned*)(lds + L_OFFS) + u.slot * 256;
#pragma unroll
            for (int h = 0; h < 2; ++h)
#pragma unroll
                for (int i = 0; i < 2; ++i) vo[h][i] = offs[R[i] + HALF * h] + (unsigned)C[i] * 2u;
        } else {
#pragma unroll
            for (int h = 0; h < 2; ++h)
#pragma unroll
                for (int i = 0; i < 2; ++i) vo[h][i] = (unsigned)((R[i] + HALF * h) * D * ESZ + C[i] * 2);
        }
    }
};

typedef f32x4 Acc[2][2][4][2];

struct EpiBf16 {
    static constexpr bool PERM = true;
    bf16* O; int ldc; const float* bias; int bias_stride; float scale;
    __device__ __forceinline__ void operator()(const Acc& acc, const GU& u, int wr, int wc, int fr, int fq) const {
        const int row0 = u.orow0 + wr * 64 + fr, col0 = u.pn * BM + wc * 32 + 8 * fq;
        f32x4 bv[2][2];
#pragma unroll
        for (int bj = 0; bj < 2; ++bj)
#pragma unroll
            for (int n = 0; n < 2; ++n) bv[bj][n] = bias ? *(const f32x4*)(bias + (size_t)u.e * bias_stride + col0 + bj * HALF + 4 * n) : (f32x4){0.f, 0.f, 0.f, 0.f};
#pragma unroll
        for (int ai = 0; ai < 2; ++ai)
#pragma unroll
            for (int m = 0; m < 4; ++m) { bf16* rowp = O + (size_t)(row0 + ai * HALF + m * 16) * ldc + col0;
#pragma unroll
                for (int bj = 0; bj < 2; ++bj) { const f32x4 v0 = acc[ai][bj][m][0] * scale + bv[bj][0], v1 = acc[ai][bj][m][1] * scale + bv[bj][1];
                    v4u w; w.x = cvt_pk_bf16(v0[0], v0[1]); w.y = cvt_pk_bf16(v0[2], v0[3]); w.z = cvt_pk_bf16(v1[0], v1[1]); w.w = cvt_pk_bf16(v1[2], v1[3]);
                    *(v4u*)(rowp + bj * HALF) = w; } }
    }
};
struct EpiResid {
    static constexpr bool PERM = false;
    const float* Base; float* Out; const float* gate; const float* gate2;
    __device__ __forceinline__ void operator()(const Acc& acc, const GU& u, int wr, int wc, int fr, int fq) const {
        const int row0 = u.orow0 + wr * 64 + fr, col0 = u.pn * BM + wc * 32 + 4 * fq;
#pragma unroll
        for (int bj = 0; bj < 2; ++bj)
#pragma unroll
            for (int n = 0; n < 2; ++n) { const int col = col0 + bj * HALF + n * 16;
                f32x4 gv = *(const f32x4*)(gate + col); if (gate2) gv = gv * *(const f32x4*)(gate2 + col);
#pragma unroll
                for (int ai = 0; ai < 2; ++ai) {
#pragma unroll
                    for (int m = 0; m < 4; ++m) { const size_t off = (size_t)(row0 + ai * HALF + m * 16) * D + col;
                        const f32x4 b4 = *(const f32x4*)(Base + off); *(f32x4*)(Out + off) = b4 + gv * acc[ai][bj][m][n]; }
                    asm volatile("" ::: "memory"); } }
    }
};
struct EpiSwiglu {
    static constexpr bool PERM = true;
    unsigned char* O; const float* bias; float scale;
    __device__ __forceinline__ void operator()(const Acc& acc, const GU& u, int wr, int wc, int fr, int fq) const {
        const int row0 = u.orow0 + wr * 64 + fr, c0 = u.pn * HALF + wc * 32 + 8 * fq;
        const float* bp = bias + (size_t)u.e * 2048 + c0;
        f32x4 bg[2], bu[2];
#pragma unroll
        for (int n = 0; n < 2; ++n) { bg[n] = *(const f32x4*)(bp + 4 * n); bu[n] = *(const f32x4*)(bp + 1024 + 4 * n); }
#pragma unroll
        for (int ai = 0; ai < 2; ++ai)
#pragma unroll
            for (int m = 0; m < 4; ++m) { unsigned char* rowp = O + (size_t)(row0 + ai * HALF + m * 16) * D + c0;
                float r[8];
#pragma unroll
                for (int n = 0; n < 2; ++n) { const f32x4 g4 = acc[ai][0][m][n] * scale + bg[n], u4 = acc[ai][1][m][n] * scale + bu[n];
#pragma unroll
                    for (int j = 0; j < 4; ++j) { const float g = fminf(g4[j], 7.0f), up = fminf(fmaxf(u4[j], -7.0f), 7.0f);
                        const float sg = __builtin_amdgcn_rcpf(1.0f + __builtin_amdgcn_exp2f(g * (-1.702f * 1.4426950408889634f)));
                        r[n * 4 + j] = (up + 1.0f) * (g * sg); } }
                v2u w; w.x = cvt_pk_fp8x4(r[0], r[1], r[2], r[3]); w.y = cvt_pk_fp8x4(r[4], r[5], r[6], r[7]);
                *(v2u*)rowp = w; }
    }
};

__device__ __forceinline__ const char* uni(const char* p) {
    const unsigned long long v = (unsigned long long)p; const unsigned lo = __builtin_amdgcn_readfirstlane((unsigned)v), hi = __builtin_amdgcn_readfirstlane((unsigned)(v >> 32));
    return (const char*)(((unsigned long long)hi << 32) | lo); }
template <int ESZ> struct FragT;
template <> struct FragT<2> { struct T { bf16x8 k0, k1; };
    static __device__ __forceinline__ T ld(const LAS v4i* p) { T r; r.k0 = __builtin_bit_cast(bf16x8, p[0]); r.k1 = __builtin_bit_cast(bf16x8, p[64]); return r; }
    template <int KK> static __device__ __forceinline__ void mma(const T& b, const T& a, f32x4& c) {
        if (KK == 0) asm volatile("v_mfma_f32_16x16x32_bf16 %0, %1, %2, %0" : "+v"(c) : "v"(b.k0), "v"(a.k0));
        else asm volatile("v_mfma_f32_16x16x32_bf16 %0, %1, %2, %0" : "+v"(c) : "v"(b.k1), "v"(a.k1)); }
    static constexpr int NK = 2; };
template <> struct FragT<1> { typedef v8i T;
    static __device__ __forceinline__ T ld(const LAS v4i* p) { const v4i lo = p[0], hi = p[64]; return __builtin_shufflevector(lo, hi, 0, 1, 2, 3, 4, 5, 6, 7); }
    template <int KK> static __device__ __forceinline__ void mma(const T& b, const T& a, f32x4& c) { asm volatile("v_mfma_f32_16x16x128_f8f6f4 %0, %1, %2, %0" : "+v"(c) : "v"(b), "v"(a)); }
    static constexpr int NK = 1; };

template <class Prob, class Epi>
__device__ __forceinline__ void gemm_phase(LAS unsigned char* lds, const Prob& P, const Epi& E, const int wid) {
    const int lane = fresh_lane(), tid = wid * 64 + lane, wr = wid >> 2, wc = wid & 3, fr = lane & 15, fq = lane >> 4;
    constexpr int ESZ = Prob::ESZ;
    const int K = P.K, nt = K * ESZ / (BK * 2);
    int R[2], C[2]; unsigned voffB[2];
#pragma unroll
    for (int i = 0; i < 2; ++i) { stage_rc(tid * 16 + i * 8192, R[i], C[i]); const int Rb = Epi::PERM ? ((R[i] & ~31) + perm32(R[i] & 31)) : R[i];
        const int sti = wid + 8 * i, bR = (sti >> 1) * 16 + (lane & 15), bC = (sti & 1) * 4 + (lane >> 4);
        voffB[i] = Prob::BIL ? (unsigned)(bC * (P.nB * 16) + bR * 16) : (unsigned)(Rb * P.ldb * ESZ + C[i] * 2); }
    const size_t kstep = (size_t)(BK * 2);
    const size_t kstepB = Prob::BIL ? (size_t)8 * P.nB * 16 : kstep;
    const size_t hstepB = Prob::BIL ? (size_t)HALF * 16 : (size_t)HALF * P.ldb * ESZ;
    const unsigned ldsw = (unsigned)wid * 1024u;
    const int aoff = lds_byte(wr * 64 + fr, fq * 8), boff = Prob::BIL ? (wc * 4096 + fq * 256 + fr * 16) : lds_byte(wc * 32 + fr, fq * 8);
#define PG8_SA(b, h) (((b) * 2 + (h)) * HTB)
#define PG8_SB(b, h) ((4 + (b) * 2 + (h)) * HTB)
#define PG8_STAGE(bufoff, gbase, voff) do { _Pragma("unroll") for (int _i = 0; _i < 2; ++_i) { unsigned o_ = (voff)[_i]; asm volatile("" : "+v"(o_));     \
        __builtin_amdgcn_global_load_lds((const unsigned*)((const char*)(gbase) + o_), (LAS unsigned*)(lds + (bufoff) + ldsw + _i * 8192), 16, 0, 0); } } while (0)
#define PG8_LD2(p) FragT<ESZ>::ld((const LAS v4i*)(p))
#define PG8_LDA(dst, b, h) do { _Pragma("unroll") for (int m = 0; m < 4; ++m) dst[m] = PG8_LD2(lds + PG8_SA(b, h) + aoff + m * 2048); } while (0)
#define PG8_LDB(dst, b, h) do { _Pragma("unroll") for (int n = 0; n < 2; ++n) dst[n] = PG8_LD2(lds + PG8_SB(b, h) + boff + n * 2048); } while (0)
#define PG8_MMA(ai, bj, At, Bt) do { __builtin_amdgcn_s_setprio(1); \
        _Pragma("unroll") for (int m = 0; m < 4; ++m) _Pragma("unroll") for (int n = 0; n < 2; ++n) FragT<ESZ>::template mma<0>(Bt[n], At[m], acc[ai][bj][m][n]); \
        if constexpr (FragT<ESZ>::NK == 2) { _Pragma("unroll") for (int m = 0; m < 4; ++m) _Pragma("unroll") for (int n = 0; n < 2; ++n) FragT<ESZ>::template mma<1>(Bt[n], At[m], acc[ai][bj][m][n]); } \
        __builtin_amdgcn_s_setprio(0); } while (0)
#define PG8_WAIT_V(n) asm volatile("s_waitcnt vmcnt(" #n ")" ::: "memory")
#define PG8_WAIT_L(n) asm volatile("s_waitcnt lgkmcnt(" #n ")" ::: "memory")
#define PG8_BAR __builtin_amdgcn_s_barrier()
#define PG8_SCHED __builtin_amdgcn_sched_barrier(0)
    GU cur, nxt; int ui = 0;
    if (!P.next(0, cur)) return;
    Acc acc;
#pragma unroll
    for (int a = 0; a < 2; ++a)
#pragma unroll
        for (int b = 0; b < 2; ++b)
#pragma unroll
            for (int m = 0; m < 4; ++m)
#pragma unroll
                for (int n = 0; n < 2; ++n) acc[a][b][m][n] = (f32x4){0.f, 0.f, 0.f, 0.f};
    typename FragT<ESZ>::T At[4], B0[2], B1[2];
    unsigned cvo[2][2];
    P.a_offs(cur, R, C, cvo, lds);
    const char* cA = uni(cur.A); const char* cB = uni(cur.B);
    PG8_STAGE(PG8_SB(0, 0), cB, voffB); PG8_STAGE(PG8_SB(0, 1), cB + hstepB, voffB); PG8_STAGE(PG8_SA(0, 0), cA, cvo[0]); PG8_STAGE(PG8_SA(0, 1), cA, cvo[1]);
    if (wr == 1) PG8_BAR;
    PG8_WAIT_V(2); PG8_BAR;
    PG8_STAGE(PG8_SB(1, 0), cB + kstepB, voffB); PG8_STAGE(PG8_SA(1, 0), cA + kstep, cvo[0]); PG8_STAGE(PG8_SB(1, 1), cB + hstepB + kstepB, voffB);
    PG8_WAIT_V(6); PG8_BAR;
    for (;;) {
        const bool has_next = P.next(ui + 1, nxt);
        const char* nA = uni(has_next ? nxt.A : cA); const char* nB = uni(has_next ? nxt.B : cB);
#define PG8_KBODY(VA2) do { \
              \
            PG8_LDB(B0, 0, 0); PG8_LDB(B1, 0, 1); PG8_SCHED; PG8_LDA(At, 0, 0); PG8_STAGE(PG8_SA(1, 1), a1, cvo[1]); \
            PG8_WAIT_V(8); PG8_WAIT_L(0); PG8_BAR; PG8_MMA(0, 0, At, B0); PG8_MMA(0, 1, At, B1); PG8_BAR; PG8_SCHED; \
              \
            PG8_LDA(At, 0, 1); PG8_STAGE(PG8_SB(0, 0), b2, voffB); PG8_STAGE(PG8_SB(0, 1), b2 + hstepB, voffB); PG8_STAGE(PG8_SA(0, 0), a2, VA2[0]); \
            PG8_WAIT_V(8); PG8_WAIT_L(0); PG8_BAR; PG8_MMA(1, 0, At, B0); PG8_MMA(1, 1, At, B1); PG8_BAR; PG8_SCHED; \
              \
            PG8_LDB(B0, 1, 0); PG8_LDB(B1, 1, 1); PG8_SCHED; PG8_LDA(At, 1, 0); PG8_STAGE(PG8_SA(0, 1), a2, VA2[1]); \
            PG8_WAIT_V(8); PG8_WAIT_L(0); PG8_BAR; PG8_MMA(0, 0, At, B0); PG8_MMA(0, 1, At, B1); PG8_BAR; PG8_SCHED; \
              \
            PG8_LDA(At, 1, 1); PG8_STAGE(PG8_SB(1, 0), b3, voffB); PG8_STAGE(PG8_SB(1, 1), b3 + hstepB, voffB); PG8_STAGE(PG8_SA(1, 0), a3, VA2[0]); \
            PG8_WAIT_V(8); PG8_WAIT_L(0); PG8_BAR; PG8_MMA(1, 0, At, B0); PG8_MMA(1, 1, At, B1); PG8_BAR; PG8_SCHED; } while (0)
        for (int t = 0; t < nt - 2; t += 2) {
            const char* a1 = cA + (size_t)(t + 1) * kstep; const char* a2 = cA + (size_t)(t + 2) * kstep; const char* b2 = cB + (size_t)(t + 2) * kstepB;
            const char* a3 = a2 + kstep; const char* b3 = b2 + kstepB;
            PG8_KBODY(cvo);
        }
        unsigned nv[2][2];
        {
            if (has_next) {
                int l2_; asm volatile("v_mbcnt_lo_u32_b32 %0, -1, 0\n\tv_mbcnt_hi_u32_b32 %0, -1, %0" : "=v"(l2_)); int R2[2], C2[2];
#pragma unroll
                for (int i = 0; i < 2; ++i) stage_rc((wid * 64 + l2_) * 16 + i * 8192, R2[i], C2[i]);
                P.a_offs(nxt, R2, C2, nv, lds);
            } else {
#pragma unroll
                for (int h = 0; h < 2; ++h)
#pragma unroll
                    for (int i = 0; i < 2; ++i) nv[h][i] = cvo[h][i]; }
            const char* a1 = cA + (size_t)(nt - 1) * kstep; const char* a2 = nA; const char* b2 = nB; const char* a3 = a2 + kstep; const char* b3 = b2 + kstepB;
            PG8_KBODY(nv);
        }
#undef PG8_KBODY
        asm volatile("s_nop 7\n\ts_nop 7\n\ts_nop 7" ::: "memory");
        if (wr == 0) PG8_BAR;
        { int l3_; asm volatile("v_mbcnt_lo_u32_b32 %0, -1, 0\n\tv_mbcnt_hi_u32_b32 %0, -1, %0" : "=v"(l3_));
          E(acc, cur, wr, wc, l3_ & 15, l3_ >> 4); }
        if (!has_next) break;
#pragma unroll
        for (int a = 0; a < 2; ++a)
#pragma unroll
            for (int b = 0; b < 2; ++b)
#pragma unroll
                for (int m = 0; m < 4; ++m)
#pragma unroll
                    for (int n = 0; n < 2; ++n) acc[a][b][m][n] = (f32x4){0.f, 0.f, 0.f, 0.f};
        cur = nxt; cA = nA; cB = nB; ++ui;
#pragma unroll
        for (int h = 0; h < 2; ++h)
#pragma unroll
            for (int i = 0; i < 2; ++i) cvo[h][i] = nv[h][i];
        if (wr == 1) PG8_BAR;
    }
    PG8_WAIT_V(0);
    PG8_BAR;
#undef PG8_SA
#undef PG8_SB
#undef PG8_STAGE
#undef PG8_LDA
#undef PG8_LDB
#undef PG8_MMA
#undef PG8_LD2
#undef PG8_WAIT_V
#undef PG8_WAIT_L
#undef PG8_BAR
#undef PG8_SCHED
}
}

namespace att {
constexpr int NW = 8, QBLK = 32, KVBLK = 64;
constexpr float SCALE = 0.088388347648318440f;
constexpr float THR = 8.f;
constexpr int LDQ = NQKV, LDK = NQKV, LDO = D;
constexpr int SHM_V = KVBLK * HD * 2, SHM_K = KVBLK * HD * 2, SHM_ATTN = 2 * SHM_V + 2 * SHM_K + NW * 64 * 4;
#define KSWZ(row, colB) ((row) * 256 + ((colB) ^ (((row) & 7) << 4)))
#define SBAR() __builtin_amdgcn_sched_barrier(0)
__device__ __forceinline__ int crow(int r, int hi) { return (r & 3) + 8 * (r >> 2) + 4 * hi; }
__device__ __forceinline__ void partialSM(f32x16& p0, f32x16& p1, float& m_reg, float& mn, float& alpha) {
    constexpr float C = 1.0f;
    float pmax = p0[0];
#pragma unroll
    for (int r = 1; r < 16; ++r) pmax = fmaxf(pmax, p0[r]);
#pragma unroll
    for (int r = 0; r < 16; ++r) pmax = fmaxf(pmax, p1[r]);
    { auto rr = __builtin_amdgcn_permlane32_swap(__float_as_uint(pmax), __float_as_uint(pmax), false, false);
      pmax = fmaxf(__uint_as_float(rr[0]), __uint_as_float(rr[1])); }
    if (__builtin_expect(__all(pmax - m_reg <= THR * 1.4426950408889634f), 1)) { mn = m_reg; alpha = 1.f; }
    else { mn = fmaxf(m_reg, pmax); alpha = __builtin_amdgcn_exp2f((m_reg - mn) * C); m_reg = mn; }
    const float mnC = -mn * C;
#pragma unroll
    for (int r = 0; r < 16; ++r) p0[r] = fmaf(p0[r], C, mnC);
#pragma unroll
    for (int r = 0; r < 16; ++r) p1[r] = fmaf(p1[r], C, mnC);
#pragma unroll
    for (int r = 0; r < 16; ++r) p0[r] = __builtin_amdgcn_exp2f(p0[r]);
}
__device__ __forceinline__ void finishSM(f32x16& p0, f32x16& p1, float alpha, float& l_reg, bf16x8& pa0, bf16x8& pa1, bf16x8& pa2, bf16x8& pa3) {
#pragma unroll
    for (int r = 0; r < 16; ++r) p1[r] = __builtin_amdgcn_exp2f(p1[r]);
    float ps = 0;
#pragma unroll
    for (int r = 0; r < 16; ++r) ps += p0[r];
#pragma unroll
    for (int r = 0; r < 16; ++r) ps += p1[r];
    { auto rr = __builtin_amdgcn_permlane32_swap(__float_as_uint(ps), __float_as_uint(ps), false, false);
      ps = __uint_as_float(rr[0]) + __uint_as_float(rr[1]); }
    l_reg = l_reg * alpha + ps;
#define PK4(P, BASE, OUT) do { unsigned a0 = cvt_pk_bf16(P[BASE + 0], P[BASE + 1]), a1 = cvt_pk_bf16(P[BASE + 2], P[BASE + 3]);   \
    unsigned b0 = cvt_pk_bf16(P[BASE + 4], P[BASE + 5]), b1 = cvt_pk_bf16(P[BASE + 6], P[BASE + 7]);                              \
    auto r0 = __builtin_amdgcn_permlane32_swap(a0, b0, false, false); auto r1 = __builtin_amdgcn_permlane32_swap(a1, b1, false, false); \
    v4u w = {r0[0], r1[0], r0[1], r1[1]}; OUT = *reinterpret_cast<bf16x8*>(&w); } while (0)
    PK4(p0, 0, pa0); PK4(p0, 8, pa1); PK4(p1, 0, pa2); PK4(p1, 8, pa3);
#undef PK4
}
__device__ __forceinline__ void qkt(f32x16& p0, f32x16& p1, const LAS char* Ks, const bf16x8* qr, int r32, int hi) {
    p0 = f32x16{}; p1 = f32x16{};
#pragma unroll
    for (int d0 = 0; d0 < 8; ++d0) {
        const int a4 = r32 * 256 + ((((d0 & 3) * 32) + hi * 16) ^ ((r32 & 7) << 4));
        const bf16x8 b0 = *reinterpret_cast<const LAS bf16x8*>(Ks + a4 + (d0 >> 2) * 128);
        const bf16x8 b1 = *reinterpret_cast<const LAS bf16x8*>(Ks + a4 + (d0 >> 2) * 128 + 8192);
        p0 = __builtin_amdgcn_mfma_f32_32x32x16_bf16(b0, qr[d0], p0, 0, 0, 0);
        p1 = __builtin_amdgcn_mfma_f32_32x32x16_bf16(b1, qr[d0], p1, 0, 0, 0); }
}
__device__ __forceinline__ int v_st(int k, int c) { const int kk = (k & ~0xC) | ((k & 4) << 1) | ((k & 8) >> 1); return ((kk >> 3) * 4 + (c >> 5)) * 512 + ((kk & 7) * 32 + (c & 31)) * 2; }
__device__ __forceinline__ int v_rd_base(int lane) { return ((lane & 3) << 3) | (((lane >> 2) & 3) << 6) | (((lane >> 4) & 1) << 5) | (((lane >> 5) & 1) << 8); }
constexpr int v_rd_off(int d0, int ks, int half) { return d0 * 512 + ks * 4096 + half * 2048; }
template <int OFF> __device__ __forceinline__ s16x4 tr_read(int vb) {
    s16x4 r; asm volatile("ds_read_b64_tr_b16 %0, %1 offset:%2" : "=&v"(r) : "v"(vb), "i"(OFF) : "memory"); return r;
}
template <int D0> __device__ __forceinline__ void pv_one(f32x16& od, int vb, bf16x8 pa0, bf16x8 pa1, bf16x8 pa2, bf16x8 pa3) {
    const s16x4 l0 = tr_read<v_rd_off(D0, 0, 0)>(vb), h0 = tr_read<v_rd_off(D0, 0, 1)>(vb), l1 = tr_read<v_rd_off(D0, 1, 0)>(vb), h1 = tr_read<v_rd_off(D0, 1, 1)>(vb);
    const s16x4 l2 = tr_read<v_rd_off(D0, 2, 0)>(vb), h2 = tr_read<v_rd_off(D0, 2, 1)>(vb), l3 = tr_read<v_rd_off(D0, 3, 0)>(vb), h3 = tr_read<v_rd_off(D0, 3, 1)>(vb);
    asm volatile("s_waitcnt lgkmcnt(0)" ::: "memory"); SBAR();
#define PK(L, H) (bf16x8){L[0], L[1], L[2], L[3], H[0], H[1], H[2], H[3]}
    od = __builtin_amdgcn_mfma_f32_32x32x16_bf16(pa0, PK(l0, h0), od, 0, 0, 0);
    od = __builtin_amdgcn_mfma_f32_32x32x16_bf16(pa1, PK(l1, h1), od, 0, 0, 0);
    od = __builtin_amdgcn_mfma_f32_32x32x16_bf16(pa2, PK(l2, h2), od, 0, 0, 0);
    od = __builtin_amdgcn_mfma_f32_32x32x16_bf16(pa3, PK(l3, h3), od, 0, 0, 0);
#undef PK
}
__device__ __forceinline__ void pv_d0(f32x16* o, int vb, bf16x8 pa0, bf16x8 pa1, bf16x8 pa2, bf16x8 pa3) {
    pv_one<0>(o[0], vb, pa0, pa1, pa2, pa3); pv_one<1>(o[1], vb, pa0, pa1, pa2, pa3); pv_one<2>(o[2], vb, pa0, pa1, pa2, pa3); pv_one<3>(o[3], vb, pa0, pa1, pa2, pa3);
}
__device__ __forceinline__ void attn_dense_body(const bf16* __restrict__ Qb, const bf16* __restrict__ Kh, const bf16* __restrict__ Vh, bf16* __restrict__ Ob, int seq, LAS char* lds, const int wid) {
    const int lane = fresh_lane(), tid = wid * 64 + lane, r32 = lane & 31, hi = lane >> 5;
    LAS char* V_lds = lds; LAS char* K_lds = lds + 2 * SHM_V;
    LAS float* ws = (LAS float*)(lds + 2 * SHM_V + 2 * SHM_K) + wid * 64; LAS float* li_l = ws; LAS float* al_l = ws + 32;
    float m_reg = -1e30f, l_reg = 0; f32x16 o[4] = {}; bf16x8 qr[8];
    const bf16* Qw = Qb + (long)(wid * QBLK + r32) * LDQ + hi * 8;
#pragma unroll
    for (int d0 = 0; d0 < 8; ++d0) qr[d0] = *reinterpret_cast<const bf16x8*>(Qw + d0 * 16);
    const int sr = tid >> 4, sc = (tid & 15) * 8, vst0 = v_st(sr, sc), vst1 = v_st(32 + sr, sc);
    const int vb0 = (int)(unsigned)(uintptr_t)V_lds + v_rd_base(lane);
    struct { bf16x8 vs0, vs1, ks0, ks1; } sr_[2];
#define SLOAD(i, k0) do { sr_[i].vs0 = *reinterpret_cast<const bf16x8*>(&Vh[(long)((k0) + sr) * LDK + sc]); sr_[i].vs1 = *reinterpret_cast<const bf16x8*>(&Vh[(long)((k0) + 32 + sr) * LDK + sc]); \
    sr_[i].ks0 = *reinterpret_cast<const bf16x8*>(&Kh[(long)((k0) + sr) * LDK + sc]); sr_[i].ks1 = *reinterpret_cast<const bf16x8*>(&Kh[(long)((k0) + 32 + sr) * LDK + sc]); } while (0)
#define SWRITE(b, i) do { *(LAS bf16x8*)(V_lds + (b) * SHM_V + vst0) = sr_[i].vs0;          \
    *(LAS bf16x8*)(V_lds + (b) * SHM_V + vst1) = sr_[i].vs1; const int kc = sc * 2;               \
    *(LAS bf16x8*)(K_lds + (b) * SHM_K + KSWZ(sr, kc)) = sr_[i].ks0;                       \
    *(LAS bf16x8*)(K_lds + (b) * SHM_K + KSWZ(32 + sr, kc)) = sr_[i].ks1; } while (0)
#define SWAIT() asm volatile("s_waitcnt vmcnt(4)" ::: "memory")
#define RESC(a) do { if (__any((a) < 1.f)) { if (hi == 0) al_l[r32] = (a); asm volatile("s_waitcnt lgkmcnt(0)" ::: "memory"); \
    _Pragma("unroll") for (int d = 0; d < 4; ++d) _Pragma("unroll") for (int r = 0; r < 16; ++r) o[d][r] *= al_l[crow(r, hi)]; } } while (0)
    f32x16 pA0, pA1, pB0, pB1; float mnA, mnB, alA, alB; bf16x8 pa0, pa1, pa2, pa3; const int NT = seq / KVBLK;
    constexpr int SE = 0, SO = 1;
    SLOAD(SE, 0); asm volatile("s_waitcnt vmcnt(0)" ::: "memory"); SWRITE(0, SE); __syncthreads();
    qkt(pA0, pA1, K_lds, qr, r32, hi); partialSM(pA0, pA1, m_reg, mnA, alA);
    SLOAD(SO, KVBLK); if (2 < NT) SLOAD(SE, 2 * KVBLK);
    SWAIT(); SWRITE(1, SO); __syncthreads();
    for (int j = 1; j + 1 < NT; j += 2) {
        SBAR(); qkt(pB0, pB1, K_lds + SHM_K, qr, r32, hi);
        finishSM(pA0, pA1, alA, l_reg, pa0, pa1, pa2, pa3); SBAR();
        SLOAD(SO, (j + 2) * KVBLK); SBAR();
        pv_d0(o, vb0, pa0, pa1, pa2, pa3); partialSM(pB0, pB1, m_reg, mnB, alB);
        __syncthreads(); SWAIT(); SWRITE(0, SE);
        RESC(alB); __syncthreads();
        SBAR(); qkt(pA0, pA1, K_lds, qr, r32, hi);
        finishSM(pB0, pB1, alB, l_reg, pa0, pa1, pa2, pa3); SBAR();
        if (j + 3 < NT) SLOAD(SE, (j + 3) * KVBLK); SBAR();
        pv_d0(o, vb0 + (int)SHM_V, pa0, pa1, pa2, pa3); partialSM(pA0, pA1, m_reg, mnA, alA);
        __syncthreads(); SWAIT(); SWRITE(1, SO);
        RESC(alA); __syncthreads();
    }
    SBAR(); qkt(pB0, pB1, K_lds + SHM_K, qr, r32, hi);
    finishSM(pA0, pA1, alA, l_reg, pa0, pa1, pa2, pa3); SBAR();
    pv_d0(o, vb0, pa0, pa1, pa2, pa3); partialSM(pB0, pB1, m_reg, mnB, alB);
    __syncthreads(); RESC(alB);
    finishSM(pB0, pB1, alB, l_reg, pa0, pa1, pa2, pa3); SBAR();
    pv_d0(o, vb0 + (int)SHM_V, pa0, pa1, pa2, pa3);
    if (hi == 0) li_l[r32] = l_reg; asm volatile("s_waitcnt lgkmcnt(0)" ::: "memory");
    float rli[16];
#pragma unroll
    for (int r = 0; r < 16; ++r) rli[r] = __builtin_amdgcn_rcpf(li_l[crow(r, hi)]);
    bf16* Ow = Ob + (long)(wid * QBLK) * LDO;
#pragma unroll
    for (int r = 0; r < 16; ++r) { const int orow = crow(r, hi);
#pragma unroll
        for (int d0 = 0; d0 < 4; ++d0) { const float v = o[d0][r] * rli[r]; Ow[(long)orow * LDO + d0 * 32 + r32] = (bf16)(cvt_pk_bf16(v, v) & 0xffffu); } }
    __syncthreads();
#undef SLOAD
#undef SWRITE
#undef SWAIT
#undef RESC
}

}


struct WConv { const float* w_gu; const float* w_down; unsigned char* Wgu8; unsigned char* Wd8; };
constexpr int WQ_GU = 64 * 64 * 4, WQ_D = 64 * 64 * 2, WQ_N = WQ_GU + WQ_D;
__device__ __forceinline__ void wquad_src(const WConv& W, int q, int tid, const float*& src  , int& N) {
    if (q < WQ_GU) { N = 2048; src = W.w_gu + (size_t)(q >> 8) * (1024 * 2048) + (size_t)(16 * ((q >> 2) & 63)) * 2048 + 512 * (q & 3); }
    else { q -= WQ_GU; N = 1024; src = W.w_down + (size_t)(q >> 7) * (1024 * 1024) + (size_t)(16 * ((q >> 1) & 63)) * 1024 + 512 * (q & 1); }
}
__device__ __forceinline__ unsigned char* wquad_dst(const WConv& W, int q, int tid) {
    if (q < WQ_GU) { const int n = 512 * (q & 3) + tid, j = n & 1023, np = 256 * (j >> 7) + 128 * (n >> 10) + (j & 127), c = np & 31, rho = 16 * ((c >> 2) & 1) + 4 * (c >> 3) + (c & 3);
        return W.Wgu8 + (size_t)(q >> 8) * (2048 * 1024) + ((size_t)((q >> 2) & 63) * 2048 + (np & ~31) + rho) * 16; }
    q -= WQ_GU; { const int n = 512 * (q & 1) + tid, c = n & 31, rho = 16 * ((c >> 2) & 1) + 4 * (c >> 3) + (c & 3);
        return W.Wd8 + (size_t)(q >> 7) * (1024 * 1024) + ((size_t)((q >> 1) & 63) * 1024 + (n & ~31) + rho) * 16; }
}
__device__ __forceinline__ unsigned wquad_cvt(float a, float b, float c, float d) {
    int w_; const float isc = 1.0f / WSCALE;
    asm volatile("v_cvt_scalef32_pk_fp8_f32 %0, %1, %2, %3" : "=v"(w_) : "v"(a), "v"(b), "s"(isc));
    asm volatile("v_cvt_scalef32_pk_fp8_f32 %0, %1, %2, %3 op_sel:[0,0,0,1]" : "+v"(w_) : "v"(c), "v"(d), "s"(isc));
    return (unsigned)w_;
}
__device__ __forceinline__ void wquad_whole(const WConv& W, int q, int tid) {
    const float* src; int N; wquad_src(W, q, tid, src, N); float r[16];
#pragma unroll
    for (int i = 0; i < 16; ++i) r[i] = src[(size_t)i * N + tid];
    v4u o; o.x = wquad_cvt(r[0], r[1], r[2], r[3]); o.y = wquad_cvt(r[4], r[5], r[6], r[7]); o.z = wquad_cvt(r[8], r[9], r[10], r[11]); o.w = wquad_cvt(r[12], r[13], r[14], r[15]);
    *(v4u*)wquad_dst(W, q, tid) = o;
}

namespace att8 {
constexpr int TB = 16384, NB = 4;
#define MF8Z(Dd, A, Bv) asm volatile("v_mfma_f32_32x32x64_f8f6f4 %0, %1, %2, 0" : "=&v"(Dd) : "v"(A), "v"(Bv))
#define MF8(Dd, A, Bv) asm volatile("v_mfma_f32_32x32x64_f8f6f4 %0, %1, %2, %0" : "+v"(Dd) : "v"(A), "v"(Bv))
#define MFP(Dd, A, Bv) asm volatile("v_mfma_f32_32x32x64_f8f6f4 %0, %1, %2, %0 cbsz:1" : "+v"(Dd) : "v"(A), "v"(Bv))
#define FEXP(x) asm volatile("v_exp_f32_e32 %0, %0" : "+v"(x))
#define FADD(acc, x) asm volatile("v_add_f32_e32 %0, %0, %1" : "+v"(acc) : "v"(x))
#define CVLO(w, a, b) asm volatile("v_cvt_scalef32_pk_bf8_f32 %0, %1, %2, %3" : "=v"(w) : "v"(a), "v"(b), "s"(pscale))
#define CVHI(w, a, b) asm volatile("v_cvt_scalef32_pk_bf8_f32 %0, %1, %2, %3 op_sel:[0,0,0,1]" : "+v"(w) : "v"(a), "v"(b), "s"(pscale))
__device__ __forceinline__ v8i ld32(const LAS unsigned char* p0, const LAS unsigned char* p1) { const v4i a = *(const LAS v4i*)p0, b = *(const LAS v4i*)p1; return __builtin_shufflevector(a, b, 0, 1, 2, 3, 4, 5, 6, 7); }
__device__ __forceinline__ void softmax8(f32x16& PC0, f32x16& PC1, float& l0, float& l1, v8i& pa, const float pscale) {
    int w0, w1, w2, w3, w4, w5, w6, w7;
    FEXP(PC0[0]); FEXP(PC0[1]); FEXP(PC0[2]); FEXP(PC0[3]); FADD(l0, PC0[0]); FEXP(PC0[4]); FADD(l1, PC0[1]); FEXP(PC0[5]); FADD(l0, PC0[2]); FEXP(PC0[6]); FADD(l1, PC0[3]); FEXP(PC0[7]); FADD(l0, PC0[4]); FEXP(PC0[8]); FADD(l1, PC0[5]); FEXP(PC0[9]); FADD(l0, PC0[6]); FEXP(PC0[10]); FADD(l1, PC0[7]); FEXP(PC0[11]); FADD(l0, PC0[8]); FEXP(PC0[12]); FADD(l1, PC0[9]); FEXP(PC0[13]); FADD(l0, PC0[10]); FEXP(PC0[14]); FADD(l1, PC0[11]); FEXP(PC0[15]); FADD(l0, PC0[12]); FEXP(PC1[0]); FADD(l1, PC0[13]); FEXP(PC1[1]); FADD(l0, PC0[14]); FEXP(PC1[2]); FADD(l1, PC0[15]); FEXP(PC1[3]); FADD(l0, PC1[0]); FEXP(PC1[4]); FADD(l1, PC1[1]); FEXP(PC1[5]); FADD(l0, PC1[2]); FEXP(PC1[6]); FADD(l1, PC1[3]); FEXP(PC1[7]); FADD(l0, PC1[4]); FEXP(PC1[8]); FADD(l1, PC1[5]); FEXP(PC1[9]); FADD(l0, PC1[6]); FEXP(PC1[10]); FADD(l1, PC1[7]); FEXP(PC1[11]); FADD(l0, PC1[8]); FEXP(PC1[12]); FADD(l1, PC1[9]); FEXP(PC1[13]); FADD(l0, PC1[10]); FEXP(PC1[14]); FADD(l1, PC1[11]); FEXP(PC1[15]); FADD(l0, PC1[12]); FADD(l1, PC1[13]); FADD(l0, PC1[14]); FADD(l1, PC1[15]); CVLO(w0, PC0[0], PC0[1]); CVHI(w0, PC0[2], PC0[3]); CVLO(w1, PC0[4], PC0[5]); CVHI(w1, PC0[6], PC0[7]); CVLO(w2, PC0[8], PC0[9]); CVHI(w2, PC0[10], PC0[11]); CVLO(w3, PC0[12], PC0[13]); CVHI(w3, PC0[14], PC0[15]); CVLO(w4, PC1[0], PC1[1]); CVHI(w4, PC1[2], PC1[3]); CVLO(w5, PC1[4], PC1[5]); CVHI(w5, PC1[6], PC1[7]); CVLO(w6, PC1[8], PC1[9]); CVHI(w6, PC1[10], PC1[11]); CVLO(w7, PC1[12], PC1[13]); CVHI(w7, PC1[14], PC1[15]);
    pa = (v8i){w0, w1, w2, w3, w4, w5, w6, w7};
}
__device__ __forceinline__ void attn_fp8_body(const unsigned char* __restrict__ Qb, const unsigned char* __restrict__ Kh, const unsigned char* __restrict__ Vth, bf16* __restrict__ Ob,
                                              int NT, LAS unsigned char* lds, const int wid, const float pscale_in, const WConv& wc, const int wq0, const int wqs) {
    const int lane = fresh_lane(), tid = wid * 64 + lane, r32 = lane & 31, hi = lane >> 5;
    float l0 = 0.f, l1 = 0.f; f32x16 o[4] = {}; v8i qr[2];
    { const unsigned char* qp = Qb + (size_t)(wid * 32 + r32) * D + 32 * hi;
#pragma unroll
      for (int s_ = 0; s_ < 2; ++s_) { const v4i a = *(const v4i*)(qp + 64 * s_), b = *(const v4i*)(qp + 64 * s_ + 16); qr[s_] = __builtin_shufflevector(a, b, 0, 1, 2, 3, 4, 5, 6, 7); } }
    const float pscale = __uint_as_float(__builtin_amdgcn_readfirstlane(__float_as_uint(pscale_in)));
    const int kx = (r32 >> 1) & 7, vx = (r32 >> 2) & 3;
    int ka[2][2], va[2];
#pragma unroll
    for (int s_ = 0; s_ < 2; ++s_)
#pragma unroll
        for (int c = 0; c < 2; ++c) ka[s_][c] = r32 * 128 + (((4 * s_ + 2 * hi + c) ^ kx) << 4);
#pragma unroll
    for (int c = 0; c < 2; ++c) va[c] = 8192 + r32 * 64 + (((2 * hi + c) ^ vx) << 4);
    const int skey = tid >> 3, sch = tid & 7, sd = tid >> 2, svc = tid & 3;
    const int lw = (int)(unsigned)(uintptr_t)lds;
    const int kst = lw + skey * 128 + ((sch ^ ((skey >> 1) & 7)) << 4), vst = lw + 8192 + sd * 64 + ((svc ^ ((sd >> 2) & 3)) << 4);
    const __amdgpu_buffer_rsrc_t krs = __builtin_amdgcn_make_buffer_rsrc((void*)Kh, 0, 0x7fffffff, 0x00020000);
    const __amdgpu_buffer_rsrc_t vrs = __builtin_amdgcn_make_buffer_rsrc((void*)Vth, 0, 0x7fffffff, 0x00020000);
    const int kgo = skey * (NKV * HD) + sch * 16, vgo = tid * 16; int kso = 0, vso = 0;
    v4i ks, vs;
#define FLOAD() do { ks = __builtin_bit_cast(v4i, __builtin_amdgcn_raw_buffer_load_b128(krs, kgo, kso, 0)); vs = __builtin_bit_cast(v4i, __builtin_amdgcn_raw_buffer_load_b128(vrs, vgo, vso, 0)); \
        if (kso < (NT - 1) * 64 * NKV * HD) { kso += 64 * NKV * HD; vso += 8192; } } while (0)
#define DSW(addr, val, OFF) asm volatile("ds_write_b128 %0, %1 offset:%2" :: "v"(addr), "v"(val), "i"(OFF) : "memory")
#define FWRITE(B) do { DSW(kst, ks, (B) * TB); DSW(vst, vs, (B) * TB); } while (0)
#define KF(B, kb, s_) ld32(lds + (B) * TB + (kb) * 4096 + ka[s_][0], lds + (B) * TB + (kb) * 4096 + ka[s_][1])
#define VF(B, d0) ld32(lds + (B) * TB + (d0) * 2048 + va[0], lds + (B) * TB + (d0) * 2048 + va[1])
    f32x16 pA0, pA1, pB0, pB1; v8i paX, paY; float wrow[16] = {}; unsigned wd0 = 0, wd1 = 0, wd2 = 0;
    FLOAD(); asm volatile("s_waitcnt vmcnt(0)" ::: "memory"); FWRITE(0);
    FLOAD(); asm volatile("s_waitcnt vmcnt(0)" ::: "memory"); FWRITE(1);
    FLOAD();
    asm volatile("s_waitcnt lgkmcnt(0)" ::: "memory"); __syncthreads();
    { const v8i k00 = KF(0, 0, 0), k10 = KF(0, 1, 0), k01 = KF(0, 0, 1), k11 = KF(0, 1, 1);
      MF8Z(pA0, k00, qr[0]); MF8Z(pA1, k10, qr[0]); MF8(pA0, k01, qr[1]); MF8(pA1, k11, qr[1]); }
#define FSTEP(PC0, PC1, PN0, PN1, PCUR, PPRV, J, B, EM) do { \
        if ((J) + 2 < NT) FWRITE(((B) + 2) & 3); \
        FLOAD(); __builtin_amdgcn_sched_barrier(0); \
        {   \
          const unsigned dw_ = wquad_cvt(wrow[4 * (B)], wrow[4 * (B) + 1], wrow[4 * (B) + 2], wrow[4 * (B) + 3]); \
          if ((B) == 0) wd0 = dw_; else if ((B) == 1) wd1 = dw_; else if ((B) == 2) wd2 = dw_; \
          else if (EM) { v4u o_ = {wd0, wd1, wd2, dw_}; *(v4u*)wquad_dst(wc, (wq0 + (((J) >> 2) - 1) * wqs) % WQ_N, tid) = o_; } \
          const float* src_; int N_; wquad_src(wc, (wq0 + ((J) >> 2) * wqs) % WQ_N, tid, src_, N_); \
          _Pragma("unroll") for (int i_ = 0; i_ < 4; ++i_) wrow[4 * (B) + i_] = src_[(size_t)(4 * (B) + i_) * N_ + tid]; } \
        __builtin_amdgcn_sched_barrier(0); \
        { int w0, w1, w2, w3, w4, w5, w6, w7; const bool qk_ = (J) + 1 < NT, pv_ = (J) > 0; \
            \
          v8i kA = KF(((B) + 1) & 3, 0, 0), vA = VF(((B) + 3) & 3, 0), kB, vB; \
          __builtin_amdgcn_sched_barrier(0); \
          kB = KF(((B) + 1) & 3, 1, 0); vB = VF(((B) + 3) & 3, 1); \
          if (qk_) MF8Z(PN0, kA, qr[0]);       G0(PC0, PC1) \
          if (pv_) MFP(o[0], PPRV, vA);        G1(PC0, PC1) \
          __builtin_amdgcn_sched_barrier(0); \
          kA = KF(((B) + 1) & 3, 0, 1); vA = VF(((B) + 3) & 3, 2); \
          if (qk_) MF8Z(PN1, kB, qr[0]);       G2(PC0, PC1) \
          if (pv_) MFP(o[1], PPRV, vB);        G3(PC0, PC1) \
          __builtin_amdgcn_sched_barrier(0); \
          kB = KF(((B) + 1) & 3, 1, 1); vB = VF(((B) + 3) & 3, 3); \
          if (qk_) MF8(PN0, kA, qr[1]);        G4(PC0, PC1) \
          if (pv_) MFP(o[2], PPRV, vA);        G5(PC0, PC1) \
          __builtin_amdgcn_sched_barrier(0); \
          if (qk_) MF8(PN1, kB, qr[1]);        G6(PC0, PC1) \
          if (pv_) MFP(o[3], PPRV, vB);        G7(PC0, PC1) \
          PCUR = (v8i){w0, w1, w2, w3, w4, w5, w6, w7}; } \
        asm volatile("s_waitcnt lgkmcnt(0)" ::: "memory"); __syncthreads(); } while (0)
#define G0(PC0, PC1) FEXP(PC0[0]); FEXP(PC0[1]); FEXP(PC0[2]); FEXP(PC0[3]); FADD(l0, PC0[0]); FEXP(PC0[4]); FADD(l1, PC0[1]); FEXP(PC0[5]); FADD(l0, PC0[2]); FEXP(PC0[6]);
#define G1(PC0, PC1) FADD(l1, PC0[3]); FEXP(PC0[7]); FADD(l0, PC0[4]); FEXP(PC0[8]); FADD(l1, PC0[5]); FEXP(PC0[9]); FADD(l0, PC0[6]); FEXP(PC0[10]); FADD(l1, PC0[7]); FEXP(PC0[11]);
#define G2(PC0, PC1) FADD(l0, PC0[8]); FEXP(PC0[12]); FADD(l1, PC0[9]); FEXP(PC0[13]); FADD(l0, PC0[10]); FEXP(PC0[14]); FADD(l1, PC0[11]); FEXP(PC0[15]); FADD(l0, PC0[12]); FEXP(PC1[0]);
#define G3(PC0, PC1) FADD(l1, PC0[13]); FEXP(PC1[1]); FADD(l0, PC0[14]); FEXP(PC1[2]); FADD(l1, PC0[15]); FEXP(PC1[3]); FADD(l0, PC1[0]); FEXP(PC1[4]); FADD(l1, PC1[1]); FEXP(PC1[5]);
#define G4(PC0, PC1) FADD(l0, PC1[2]); FEXP(PC1[6]); FADD(l1, PC1[3]); FEXP(PC1[7]); FADD(l0, PC1[4]); FEXP(PC1[8]); FADD(l1, PC1[5]); FEXP(PC1[9]); FADD(l0, PC1[6]); FEXP(PC1[10]);
#define G5(PC0, PC1) FADD(l1, PC1[7]); FEXP(PC1[11]); FADD(l0, PC1[8]); FEXP(PC1[12]); FADD(l1, PC1[9]); FEXP(PC1[13]); FADD(l0, PC1[10]); FEXP(PC1[14]); FADD(l1, PC1[11]); FEXP(PC1[15]);
#define G6(PC0, PC1) FADD(l0, PC1[12]); FADD(l1, PC1[13]); FADD(l0, PC1[14]); FADD(l1, PC1[15]); CVLO(w0, PC0[0], PC0[1]); CVHI(w0, PC0[2], PC0[3]); CVLO(w1, PC0[4], PC0[5]); CVHI(w1, PC0[6], PC0[7]); CVLO(w2, PC0[8], PC0[9]); CVHI(w2, PC0[10], PC0[11]);
#define G7(PC0, PC1) CVLO(w3, PC0[12], PC0[13]); CVHI(w3, PC0[14], PC0[15]); CVLO(w4, PC1[0], PC1[1]); CVHI(w4, PC1[2], PC1[3]); CVLO(w5, PC1[4], PC1[5]); CVHI(w5, PC1[6], PC1[7]); CVLO(w6, PC1[8], PC1[9]); CVHI(w6, PC1[10], PC1[11]); CVLO(w7, PC1[12], PC1[13]); CVHI(w7, PC1[14], PC1[15]);
    FSTEP(pA0, pA1, pB0, pB1, paX, paY, 0, 0, 0); FSTEP(pB0, pB1, pA0, pA1, paY, paX, 1, 1, 0); FSTEP(pA0, pA1, pB0, pB1, paX, paY, 2, 2, 0); FSTEP(pB0, pB1, pA0, pA1, paY, paX, 3, 3, 0);
    for (int j = 4; j < NT; j += 4) { FSTEP(pA0, pA1, pB0, pB1, paX, paY, j, 0, 1); FSTEP(pB0, pB1, pA0, pA1, paY, paX, j + 1, 1, 1); FSTEP(pA0, pA1, pB0, pB1, paX, paY, j + 2, 2, 1); FSTEP(pB0, pB1, pA0, pA1, paY, paX, j + 3, 3, 1); }
    {
        v4u o_ = {wquad_cvt(wrow[0], wrow[1], wrow[2], wrow[3]), wquad_cvt(wrow[4], wrow[5], wrow[6], wrow[7]), wquad_cvt(wrow[8], wrow[9], wrow[10], wrow[11]), wquad_cvt(wrow[12], wrow[13], wrow[14], wrow[15])};
        *(v4u*)wquad_dst(wc, (wq0 + ((NT >> 2) - 1) * wqs) % WQ_N, tid) = o_;
    }
    {
        const v8i v0 = VF(3, 0), v1 = VF(3, 1), v2 = VF(3, 2), v3 = VF(3, 3);
        asm volatile("s_nop 4" ::: "memory");
        MFP(o[0], paY, v0); MFP(o[1], paY, v1); MFP(o[2], paY, v2); MFP(o[3], paY, v3);
        asm volatile("s_waitcnt lgkmcnt(0)" ::: "memory"); __syncthreads(); }
    asm volatile("s_nop 7\n\ts_nop 7\n\ts_nop 7" ::: "memory");
    float l_part = l0 + l1;
    { auto rr = __builtin_amdgcn_permlane32_swap(__float_as_uint(l_part), __float_as_uint(l_part), false, false); l_part = __uint_as_float(rr[0]) + __uint_as_float(rr[1]); }
    const int lane2 = fresh_lane(), r32e = lane2 & 31, hie = lane2 >> 5;
    LAS float* li_l = (LAS float*)(lds + L_OFFS) + wid * 64;
    if (hie == 0) li_l[r32e] = l_part; asm volatile("s_waitcnt lgkmcnt(0)" ::: "memory");
    float rli[16];
#pragma unroll
    for (int r = 0; r < 16; ++r) rli[r] = pscale * __builtin_amdgcn_rcpf(li_l[att::crow(r, hie)]);
    bf16* Ow = Ob + (size_t)(wid * 32) * D;
#pragma unroll
    for (int r = 0; r < 16; ++r) { const int orow = att::crow(r, hie);
#pragma unroll
        for (int d0 = 0; d0 < 4; ++d0) { const float v = o[d0][r] * rli[r]; Ow[(size_t)orow * D + d0 * 32 + r32e] = (bf16)(cvt_pk_bf16(v, v) & 0xffffu); } }
    __syncthreads();
#undef FLOAD
#undef DSW
#undef FWRITE
#undef KF
#undef VF
#undef FSTEP
#undef G0
#undef G1
#undef G2
#undef G3
#undef G4
#undef G5
#undef G6
#undef G7
}
#undef MF8Z
#undef MF8
#undef MFP
#undef FEXP
#undef FADD
#undef CVLO
#undef CVHI
}

__device__ __forceinline__ void ld_row(const float* row, int lane, f32x4 (&v)[4]) {
#pragma unroll
    for (int j = 0; j < 4; ++j) v[j] = *(const f32x4*)(row + 4 * lane + 256 * j);
}
__device__ __forceinline__ void ld_row_bf16(const bf16* row, int lane, f32x4 (&v)[4]) {
#pragma unroll
    for (int j = 0; j < 4; ++j) { const v2u w = *(const v2u*)(row + 4 * lane + 256 * j); v[j] = (f32x4){bf_lo(w.x), bf_hi(w.x), bf_lo(w.y), bf_hi(w.y)}; }
}
__device__ __forceinline__ void st_row(float* row, int lane, const f32x4 (&v)[4]) {
#pragma unroll
    for (int j = 0; j < 4; ++j) *(f32x4*)(row + 4 * lane + 256 * j) = v[j];
}
__device__ __forceinline__ void st_row_bf16(bf16* row, int lane, const f32x4 (&v)[4]) {
#pragma unroll
    for (int j = 0; j < 4; ++j) { v2u w; w.x = cvt_pk_bf16(v[j][0], v[j][1]); w.y = cvt_pk_bf16(v[j][2], v[j][3]); *(v2u*)(row + 4 * lane + 256 * j) = w; }
}
__device__ __forceinline__ void st_row_fp8(unsigned char* row, int lane, const f32x4 (&v)[4]) {
#pragma unroll
    for (int j = 0; j < 4; ++j) *(unsigned*)(row + 4 * lane + 256 * j) = cvt_pk_fp8x4(v[j][0], v[j][1], v[j][2], v[j][3]);
}
__device__ __forceinline__ float row_rstd(const f32x4 (&v)[4]) {
    float s = 0.f;
#pragma unroll
    for (int j = 0; j < 4; ++j) s += (v[j][0] * v[j][0] + v[j][1] * v[j][1]) + (v[j][2] * v[j][2] + v[j][3] * v[j][3]);
    return 1.0f / sqrtf(wave_sum(s) * (1.0f / D) + NORM_EPS);
}

struct Args { const float* in[21]; float* out; unsigned char* ws; int ph_lo, ph_hi; };

__device__ __forceinline__ void transpose_item(const float* W, int N, int k0, int n0, bf16* dst, int K, LAS float* scr, int lane) {
    f32x4 v[8];
#pragma unroll
    for (int i = 0; i < 8; ++i) v[i] = *(const f32x4*)(W + (size_t)(k0 + (lane >> 3) + 8 * i) * N + n0 + (lane & 7) * 4);
#pragma unroll
    for (int i = 0; i < 8; ++i) { LAS float* d = scr + ((lane >> 3) + 8 * i) * 33 + (lane & 7) * 4; d[0] = v[i][0]; d[1] = v[i][1]; d[2] = v[i][2]; d[3] = v[i][3]; }
    LDS_WAIT(); asm volatile("" ::: "memory");
    const int c = lane & 7;
#pragma unroll
    for (int j = 0; j < 4; ++j) { const int n = (lane >> 3) + 8 * j; const LAS float* s = scr + (8 * c) * 33 + n;
        v4u o; o.x = cvt_pk_bf16(s[0 * 33], s[1 * 33]); o.y = cvt_pk_bf16(s[2 * 33], s[3 * 33]); o.z = cvt_pk_bf16(s[4 * 33], s[5 * 33]); o.w = cvt_pk_bf16(s[6 * 33], s[7 * 33]);
        *(v4u*)(dst + (size_t)n * K + 8 * c) = o; }
    LDS_WAIT(); asm volatile("" ::: "memory");
}

__device__ __forceinline__ void transpose_item_fp8(const float* W, int N, int k0, int n0, unsigned char* dst, int K, LAS float* scr, int lane, float scale) {
    f32x4 v[8];
#pragma unroll
    for (int i = 0; i < 8; ++i) v[i] = *(const f32x4*)(W + (size_t)(k0 + (lane >> 3) + 8 * i) * N + n0 + (lane & 7) * 4);
#pragma unroll
    for (int i = 0; i < 8; ++i) { LAS float* d = scr + ((lane >> 3) + 8 * i) * 33 + (lane & 7) * 4; d[0] = v[i][0] * scale; d[1] = v[i][1] * scale; d[2] = v[i][2] * scale; d[3] = v[i][3] * scale; }
    LDS_WAIT(); asm volatile("" ::: "memory");
    const int n = lane >> 1, kh = lane & 1; const LAS float* s = scr + (32 * kh) * 33 + n;
    v4u o0, o1;
    o0.x = cvt_pk_fp8x4(s[0 * 33], s[1 * 33], s[2 * 33], s[3 * 33]);     o0.y = cvt_pk_fp8x4(s[4 * 33], s[5 * 33], s[6 * 33], s[7 * 33]);
    o0.z = cvt_pk_fp8x4(s[8 * 33], s[9 * 33], s[10 * 33], s[11 * 33]);   o0.w = cvt_pk_fp8x4(s[12 * 33], s[13 * 33], s[14 * 33], s[15 * 33]);
    o1.x = cvt_pk_fp8x4(s[16 * 33], s[17 * 33], s[18 * 33], s[19 * 33]); o1.y = cvt_pk_fp8x4(s[20 * 33], s[21 * 33], s[22 * 33], s[23 * 33]);
    o1.z = cvt_pk_fp8x4(s[24 * 33], s[25 * 33], s[26 * 33], s[27 * 33]); o1.w = cvt_pk_fp8x4(s[28 * 33], s[29 * 33], s[30 * 33], s[31 * 33]);
    unsigned char* dp = dst + (size_t)n * K + 32 * kh;
    *(v4u*)dp = o0; *(v4u*)(dp + 16) = o1;
    LDS_WAIT(); asm volatile("" ::: "memory");
}

__device__ __forceinline__ int moe_build_units(LAS unsigned char* lds, const unsigned* gcnt, const int* tok_list, int NPN, bool gather, int rowbytes, int G, int c, const int tid) {
    const int lane = tid & 63;
    LAS unsigned* tb = (LAS unsigned*)(lds + L_TB); LAS unsigned* lc = (LAS unsigned*)(lds + L_CNT); LAS int* ut = (LAS int*)(lds + L_UT);
    if (tid < 64) {
        unsigned cnt = (lane < NE) ? __hip_atomic_load(gcnt + 64 * lane, RLX_AGENT) : 0u;
        unsigned tiles = (cnt + 255u) >> 8, incl = tiles;
#pragma unroll
        for (int o = 1; o < 32; o <<= 1) { const unsigned t = __shfl_up(incl, o); if (lane >= o) incl += t; }
        if (lane < NE) { tb[lane + 1] = incl; lc[lane] = cnt; }
        if (lane == 0) tb[0] = 0u;
    }
    __syncthreads();
    const int T = (int)tb[NE], nunits = T * NPN;
    int n_my = 0; { const int rem = nunits - c; n_my = rem > 0 ? (rem + G - 1) / G : 0; if (n_my > 16) n_my = 16; }
    if (tid < n_my) {
        int L = tid * G + c; const int q = nunits / 8, r = nunits % 8, xcd = L % 8, off = L / 8;
        const int wgid = (xcd < r ? xcd * (q + 1) : r * (q + 1) + (xcd - r) * q) + off;
        const int mtg = wgid / NPN, pn = wgid % NPN;
        int e = 0;
        for (int k = 1; k < NE; ++k) if ((int)tb[k] <= mtg) e = k;
        const int mtl = mtg - (int)tb[e]; int valid = (int)lc[e] - mtl * 256; if (valid > 256) valid = 256;
        ut[tid * 8 + 0] = e; ut[tid * 8 + 1] = mtl; ut[tid * 8 + 2] = pn; ut[tid * 8 + 3] = mtg; ut[tid * 8 + 4] = valid;
    }
    __syncthreads();
    if (gather) {
        LAS unsigned* offs = (LAS unsigned*)(lds + L_OFFS);
        for (int idx = tid; idx < n_my * 256; idx += 512) { const int u = idx >> 8, r = idx & 255; const int e = ut[u * 8 + 0], mtl = ut[u * 8 + 1], valid = ut[u * 8 + 4];
            const int tok = (r < valid) ? tok_list[e * S + mtl * 256 + r] : 0;
            offs[idx] = (unsigned)tok * (unsigned)rowbytes; }
        __syncthreads();
    }
    return n_my;
}

__global__ void __launch_bounds__(512, 2) fwd_kernel(Args args) {
    extern __shared__ __attribute__((aligned(16))) unsigned char lds_[];
    LAS unsigned char* lds = (LAS unsigned char*)lds_;
    const int wave = __builtin_amdgcn_readfirstlane(threadIdx.x >> 6);
    const int G = gridDim.x, bid = blockIdx.x;
#define PHASE_IDS const int lane = fresh_lane(), tid = wave * 64 + lane; (void)tid; (void)lane
    const int gw = bid * 8 + wave, NGW = G * 8;
    unsigned char* ws = args.ws;
    unsigned* ctl = (unsigned*)(ws + WS_CTL);
    const float* x = args.in[0]; const float* cvec = args.in[1]; const float* ctx = args.in[2]; const float* cctx = args.in[3];
    const float* ada_w = args.in[4]; const float* ada_b = args.in[5]; const float* norm_mix = args.in[6]; const float* norm_ffn = args.in[7];
    const float* w_qkv = args.in[8]; const float* q_g = args.in[9]; const float* k_g = args.in[10]; const float* w_o = args.in[11];
    const float* pool_w = args.in[12]; const float* pool_scale = args.in[13]; const float* router_w = args.in[14]; const float* router_b = args.in[15];
    const float* w_gu = args.in[16]; const float* b_gu = args.in[17]; const float* w_down = args.in[18]; const float* b_down = args.in[19]; const float* final_norm = args.in[20];
    float* MOD = (float*)(ws + WS_MOD);
    bf16* WF = (bf16*)(ws + WS_MOD + 131072);
    unsigned char* Wqkv8 = ws + WS_WQKV;
    bf16* Wo_t = (bf16*)(ws + WS_WO);
    bf16* Wpool_t = (bf16*)(ws + WS_WPOOL);
    unsigned char* Wgu8 = ws + WS_WGU; unsigned char* Wd8 = ws + WS_WD;
    unsigned char* H8 = ws + WS_H; unsigned char* ACT8 = ws + WS_ACT;
    int* tok_list = (int*)(ws + WS_TOKLIST); int* tok_e = (int*)(ws + WS_TOKE); int* tok_pos = (int*)(ws + WS_TOKP); float* tok_w = (float*)(ws + WS_TOKW);
    bf16* QKV = (bf16*)(ws + WS_QKV); bf16* O = (bf16*)(ws + WS_O);
    unsigned char* Q8 = ws + WS_Q8; unsigned char* K8 = ws + WS_K8; unsigned char* VT8 = ws + WS_VT8;
    bf16* XA = (bf16*)(ws + WS_XA); bf16* XB = (bf16*)(ws + WS_XB); bf16* XC = (bf16*)(ws + WS_XC);
    bf16* H1B = (bf16*)(ws + WS_POOLED);
    bf16* YZ = (bf16*)(ws + WS_H1F);
    bf16* Y = (bf16*)(ws + WS_Y);

    if (threadIdx.x < 16) ((LAS unsigned*)(lds + MISC_OFF))[threadIdx.x] = 0u;
    __syncthreads();
    XcdBarrier bar; bar.bar = ctl + CW_BAR; bar.x = 0; bar.st = nullptr; bar.wave = wave;
    if (MK_N_LAUNCHES == 1) bar = xcd_barrier_post(ctl + CW_BAR, (volatile LAS unsigned*)(lds + MISC_OFF), wave);
    const int lo = args.ph_lo, hi = args.ph_hi;
#ifndef PHASE_MASK
#define PHASE_MASK 0xFFFF
#endif
#define IN(k) ((((PHASE_MASK) >> (k)) & 1) && lo <= (k) && (k) < hi)
#define SEAM(k) do { if (IN(k) && IN((k) + 1)) xcd_barrier(bar); } while (0)

    if (IN(PH_PRO)) { PHASE_IDS;
        {
            LAS float* sl = (LAS float*)lds; LAS float* scx = sl + 1024; LAS float* part = sl + 2048;
            for (int i = tid; i < 1024; i += 512) { const float a = cvec[i], b = cctx[i]; sl[i] = a / (1.0f + __expf(-a)); scx[i] = b / (1.0f + __expf(-b)); }
            __syncthreads();
            for (int t = bid; t < 192; t += G) {
                const int layer = t / 96, cb = t % 96, n = cb * 64 + lane;
                const float* Wp = ada_w + (size_t)layer * 1024 * 6144 + (size_t)(wave * 128) * 6144 + n;
                float a0 = 0.f, a1 = 0.f;
#pragma unroll 16
                for (int k = 0; k < 128; ++k) { const float w = Wp[(size_t)k * 6144]; a0 += sl[wave * 128 + k] * w; a1 += scx[wave * 128 + k] * w; }
                part[wave * 64 + lane] = a0; part[512 + wave * 64 + lane] = a1;
                __syncthreads();
                if (tid < 128) { const int which = tid >> 6, l = tid & 63; float s = 0.f;
#pragma unroll
                    for (int w = 0; w < 8; ++w) s += part[which * 512 + w * 64 + l];
                    const int nn = cb * 64 + l; s += ada_b[layer * 6144 + nn];
                    if (which == 0) MOD[layer * 6144 + nn] = s; else if (layer == 0 && nn < 2048) MOD[12288 + nn] = s; }
                __syncthreads();
            }
        }
        for (int idx = bid * 512 + tid; idx < 65536; idx += G * 512) {
            const int j = idx & 7, ln = (idx >> 3) & 63, ks = (idx >> 9) & 15, kh = (idx >> 13) & 1, et = (idx >> 14) & 1, l = idx >> 15;
            const int e = et * 16 + (ln & 15), k = kh * 512 + ks * 32 + 8 * (ln >> 4) + j; const float w = router_w[(size_t)l * 32768 + k * 32 + e];
            const unsigned hi = cvt_pk_bf16(w, w) & 0xffffu; const float r_ = w - bf_lo(hi); const unsigned lo = cvt_pk_bf16(r_, r_) & 0xffffu;
            const size_t base = ((size_t)((((l * 2 + et) * 2 + kh) * 16 + ks) * 2) * 64 + ln) * 8 + j;
            WF[base] = (bf16)hi; WF[base + 512] = (bf16)lo; }
        {
            LAS float* scr = (LAS float*)(lds + wave * 16384);
            constexpr int I_GU = 64 * 16 * 64, I_D = 64 * 16 * 32, I_QKV = 16 * 48, I_O = 16 * 32, I_P = 4 * 4 * 8;
            const float gqm_ = wave_max(fmaxf(fabsf(q_g[lane]), fabsf(q_g[64 + lane]))), gkm_ = wave_max(fmaxf(fabsf(k_g[lane]), fabsf(k_g[64 + lane])));
            const bool attn_fast_ = (HD * gqm_ * gkm_ * att::SCALE * 1.4426950408889634f * 1.02f) < 26.0f;
            const int NITEMS = I_QKV + I_O + I_P;
            if (!attn_fast_) { const WConv wc_{w_gu, w_down, Wgu8, Wd8}; for (int q = bid; q < WQ_N; q += G) wquad_whole(wc_, q, tid); }
            for (int it = gw; it < NITEMS; it += NGW) {
                int r = it;
                if (r < I_QKV) { const int kb = r / 48, nb = r % 48; transpose_item_fp8(w_qkv, NQKV, kb * 64, nb * 32, Wqkv8 + (size_t)(nb * 32) * 1024 + kb * 64, 1024, scr, lane, WSCALE); continue; } r -= I_QKV;
                if (r < I_O) { const int kb = r / 32, nb = r % 32; transpose_item(w_o, 1024, kb * 64, nb * 32, Wo_t + (size_t)(nb * 32) * 1024 + kb * 64, 1024, scr, lane); continue; } r -= I_O;
                if (r < I_P) { const int g = r / 32, kb = (r % 32) / 8, nb = r % 8; transpose_item(pool_w + (size_t)g * 65536, 256, kb * 64, nb * 32, Wpool_t + (size_t)g * 65536 + (size_t)(nb * 32) * 256 + kb * 64, 256, scr, lane); continue; } r -= I_P;
            }
        }
        __syncthreads();
    }
    SEAM(PH_PRO);

    if (IN(PH_NORM1)) { PHASE_IDS;
        f32x4 av[4], bv[4];
#pragma unroll
        for (int j = 0; j < 4; ++j) { const int col = 4 * lane + 256 * j; const f32x4 g = *(const f32x4*)(norm_mix + col); av[j] = g * (1.0f + *(const f32x4*)(MOD + 1024 + col)); bv[j] = *(const f32x4*)(MOD + col); }
        for (int r = gw; r < S; r += NGW) { f32x4 v[4]; ld_row(x + (size_t)r * D, lane, v); const float rs = row_rstd(v);
#pragma unroll
            for (int j = 0; j < 4; ++j) v[j] = v[j] * rs * av[j] + bv[j];
            st_row_fp8(H8 + (size_t)r * D, lane, v); }
#pragma unroll
        for (int j = 0; j < 4; ++j) { const int col = 4 * lane + 256 * j; const f32x4 g = *(const f32x4*)(norm_mix + col); av[j] = g * (1.0f + *(const f32x4*)(MOD + 12288 + 1024 + col)); bv[j] = *(const f32x4*)(MOD + 12288 + col); }
        for (int r = gw; r < CT; r += NGW) { f32x4 v[4]; ld_row(ctx + (size_t)r * D, lane, v); const float rs = row_rstd(v);
#pragma unroll
            for (int j = 0; j < 4; ++j) v[j] = v[j] * rs * av[j] + bv[j];
            st_row_fp8(H8 + (size_t)(S + r) * D, lane, v); }
    }
    SEAM(PH_NORM1);

    if (IN(PH_QKV)) { PHASE_IDS;
        pg8::ProbDense<1> P; P.init(H8, Wqkv8, NTOK, NQKV, D, D, D, 0, G, bid);
        pg8::EpiBf16 E{QKV, NQKV, nullptr, 0, 1.0f / WSCALE};
        pg8::gemm_phase(lds, P, E, wave);
    }
    SEAM(PH_QKV);

    if (IN(PH_QKROPE)) { PHASE_IDS;
        const int sub = lane >> 4, j16 = lane & 15, part = j16 >> 3, i0 = 4 * (j16 & 7);
        constexpr int NIT = (S * 10) / 4 + (CT * 2) / 4;
        for (int it = gw; it < NIT; it += NGW) {
            const int idx = it * 4 + sub; const bool lat = idx < S * 10; int row, head;
            if (lat) { row = idx / 10; head = idx - row * 10; } else { const int i2 = idx - S * 10; row = S + (i2 >> 1); head = 8 + (i2 & 1); }
            bf16* p = QKV + (size_t)row * NQKV + head * HD + 64 * part + i0;
            const v2u a = *(const v2u*)p, b = *(const v2u*)(p + 32);
            float x1[4] = {bf_lo(a.x), bf_hi(a.x), bf_lo(a.y), bf_hi(a.y)}, x2[4] = {bf_lo(b.x), bf_hi(b.x), bf_lo(b.y), bf_hi(b.y)};
            float ss = 0.f;
#pragma unroll
            for (int i = 0; i < 4; ++i) ss += x1[i] * x1[i] + x2[i] * x2[i];
            ss += __shfl_xor(ss, 1); ss += __shfl_xor(ss, 2); ss += __shfl_xor(ss, 4); ss += __shfl_xor(ss, 8);
            const float rs = (1.0f / sqrtf(ss * (1.0f / HD) + NORM_EPS)) * (head < 8 ? att::SCALE * 1.4426950408889634f : 1.0f);
            const float* gp = (head < 8 ? q_g : k_g) + 64 * part + i0;
            const f32x4 g1 = *(const f32x4*)gp, g2 = *(const f32x4*)(gp + 32);
            float o1[4], o2[4];
#pragma unroll
            for (int i = 0; i < 4; ++i) { const float y1 = x1[i] * rs * g1[i], y2 = x2[i] * rs * g2[i];
                if (lat) { const float pos = (float)(part ? (row & (GRID_W - 1)) : (row / GRID_W));
                    const float invf = exp2f(-(float)(i0 + i) * (13.287712379549449f / 32.0f));
                    const float ang = pos * invf; const float sn = __sinf(ang), cs = __cosf(ang);
                    o1[i] = y1 * cs - y2 * sn; o2[i] = y2 * cs + y1 * sn; }
                else { o1[i] = y1; o2[i] = y2; } }
            v2u wa, wb; wa.x = cvt_pk_bf16(o1[0], o1[1]); wa.y = cvt_pk_bf16(o1[2], o1[3]); wb.x = cvt_pk_bf16(o2[0], o2[1]); wb.y = cvt_pk_bf16(o2[2], o2[3]);
            *(v2u*)p = wa; *(v2u*)(p + 32) = wb;
            {
                unsigned char* p8 = (head < 8) ? Q8 + (size_t)row * D + head * HD + 64 * part + i0 : K8 + (size_t)row * (NKV * HD) + (head - 8) * HD + 64 * part + i0;
                if (head >= 8 || lat) { *(unsigned*)p8 = cvt_pk_fp8x4(o1[0], o1[1], o1[2], o1[3]); *(unsigned*)(p8 + 32) = cvt_pk_fp8x4(o2[0], o2[1], o2[2], o2[3]); } }
        }
        {
            LAS unsigned char* tl = lds;
            for (int it = bid; it < NKV * (NTOK / 64); it += G) { const int kvh = it & 1, tile = it >> 1;
                const int key = tid & 63, dq = tid >> 6;
                const bf16* vp = QKV + (size_t)(tile * 64 + key) * NQKV + 1280 + kvh * HD + dq * 16;
                const v4u a = *(const v4u*)vp, b = *(const v4u*)(vp + 8);
                const unsigned wv[8] = {a.x, a.y, a.z, a.w, b.x, b.y, b.z, b.w};
                const int c = key & 31, slot = 32 * ((c >> 2) & 1) + (c & 3) + 4 * (c >> 3) + 16 * (key >> 5);
#pragma unroll
                for (int i = 0; i < 8; ++i) { const unsigned pk = cvt_pk_fp8x4(bf_lo(wv[i]), bf_hi(wv[i]), 0.f, 0.f);
                    tl[(dq * 16 + 2 * i) * 64 + slot] = (unsigned char)(pk & 0xffu); tl[(dq * 16 + 2 * i + 1) * 64 + slot] = (unsigned char)((pk >> 8) & 0xffu); }
                __syncthreads();
                *(v4u*)(VT8 + ((size_t)kvh * (NTOK / 64) + tile) * 8192 + tid * 16) = *(const LAS v4u*)(tl + tid * 16);
                __syncthreads();
            }
        }
    }
    SEAM(PH_QKROPE);

    if (IN(PH_ATTN)) { PHASE_IDS;
        const float gqm = wave_max(fmaxf(fabsf(q_g[lane]), fabsf(q_g[64 + lane]))), gkm = wave_max(fmaxf(fabsf(k_g[lane]), fabsf(k_g[64 + lane])));
        const float bound = HD * gqm * gkm * att::SCALE * 1.4426950408889634f * 1.02f;
        const bool fast = bound < 26.0f;
        if (__builtin_expect(fast, 1)) {
            const float pscale = exp2f(ceilf(fmaxf(bound - 15.5f, 0.0f)));
            const WConv wc{w_gu, w_down, Wgu8, Wd8}; int ui = 0;
            for (int u = bid; u < NH * (S / 256); u += G, ++ui) { const int head = u & 7, qb = u >> 3, kvh = head >> 2;
                att8::attn_fp8_body(Q8 + (size_t)(qb * 256) * D + head * HD, K8 + kvh * HD, VT8 + (size_t)kvh * (NTOK / 64) * 8192, O + (size_t)(qb * 256) * D + head * HD, NTOK / 64, lds, wave, pscale,
                                    wc, ui * (NTOK / 256) * G + bid, G); }
            for (int q = ui * (NTOK / 256) * G + bid; q < WQ_N; q += G) wquad_whole(wc, q, tid);
        }
#ifndef NO_FALLBACK
        else {
            for (int u = bid; u < NH * (S / 256); u += G) { const int head = u & 7, qb = u >> 3, kvh = head >> 2;
                att::attn_dense_body(QKV + (size_t)(qb * 256) * NQKV + head * HD, QKV + 1024 + kvh * HD, QKV + 1280 + kvh * HD, O + (size_t)(qb * 256) * D + head * HD, NTOK, (LAS char*)lds, wave); }
        }
#endif
    }
    SEAM(PH_ATTN);


#ifdef SELFCHECK
    if (IN(PH_WO)) { PHASE_IDS;
        LAS float* sc_ = (LAS float*)lds; LAS float* qf = sc_ + NTOK; LAS float* red = qf + 128; LAS float* misc = red + 512;
        {
            const int t = (bid * 61 + 7) & (S - 1), h = bid & 7, kvh = h >> 2;
            const bf16* qp = QKV + (size_t)t * NQKV + h * HD;
            if (tid < 128) qf[tid] = bf_lo((unsigned)qp[tid]);
            __syncthreads();
            float mx = -1e30f;
            for (int k = tid; k < NTOK; k += 512) { const bf16* kp = QKV + (size_t)k * NQKV + 1024 + kvh * HD; float a = 0.f;
#pragma unroll 4
                for (int d = 0; d < 128; d += 2) { const unsigned w = *(const unsigned*)(kp + d); a += qf[d] * bf_lo(w) + qf[d + 1] * bf_hi(w); }
                sc_[k] = a; mx = fmaxf(mx, a); }
            mx = wave_max(mx); if (lane == 0) misc[wave] = mx; __syncthreads();
            mx = misc[0]; for (int w = 1; w < 8; ++w) mx = fmaxf(mx, misc[w]);
            __syncthreads();
            float ls = 0.f;
            for (int k = tid; k < NTOK; k += 512) { const float p = exp2f(sc_[k] - mx); sc_[k] = p; ls += p; }
            ls = wave_sum(ls); if (lane == 0) misc[8 + wave] = ls; __syncthreads();
            ls = 0.f; for (int w = 0; w < 8; ++w) ls += misc[8 + w];
            const int d = tid & 127, part = tid >> 7; float acc = 0.f;
            for (int k = part; k < NTOK; k += 4) acc += sc_[k] * bf_lo((unsigned)QKV[(size_t)k * NQKV + 1280 + kvh * HD + d]);
            red[part * 128 + d] = acc; __syncthreads();
            if (tid < 128) { const float ref = (red[d] + red[128 + d] + red[256 + d] + red[384 + d]) / ls; const float got = bf_lo((unsigned)O[(size_t)t * D + h * HD + d]);
                float am = fabsf(ref); for (int o = 32; o >= 1; o >>= 1) am = fmaxf(am, __shfl_xor(am, o)); misc[16 + (tid >> 6)] = am; }
            __syncthreads();
            if (tid < 128) { const float ref = (red[d] + red[128 + d] + red[256 + d] + red[384 + d]) / ls; const float got = bf_lo((unsigned)O[(size_t)t * D + h * HD + d]);
                const float am = fmaxf(misc[16], misc[17]); if (!(fabsf(got - ref) <= 0.02f * am + 1e-7f)) atomicOr(ctl + 2, 1u); }
            __syncthreads();
        }
        {
            const int t = (bid * 97 + 13) % NTOK, h = (t >= S) ? 8 + (bid & 1) : (bid % 10);
            const int d = tid & 127, kq = tid >> 7; float a = 0.f;
            const unsigned char* hp = H8 + (size_t)t * D + kq * 256; const unsigned char* wp = Wqkv8 + (size_t)(h * HD + d) * D + kq * 256;
#pragma unroll 4
            for (int k = 0; k < 256; ++k) a += __builtin_amdgcn_cvt_f32_fp8((int)hp[k], 0) * __builtin_amdgcn_cvt_f32_fp8((int)wp[k], 0) * (1.0f / WSCALE);
            red[kq * 128 + d] = a; __syncthreads();
            if (tid < 128) qf[d] = red[d] + red[128 + d] + red[256 + d] + red[384 + d];
            __syncthreads();
            if (tid < 128) { float ss = 0.f;
#pragma unroll 4
                for (int i = 0; i < 128; ++i) ss += qf[i] * qf[i];
                const float rs = 1.0f / sqrtf(ss * (1.0f / HD) + NORM_EPS); const float* gp = h < 8 ? q_g : k_g;
                const int idx = d & 63, pr = d >> 6, fi = idx & 31; const float y = qf[d] * rs * gp[d]; float out = y;
                if (t < S) { const int dp = (idx < 32) ? d + 32 : d - 32; const float yp = qf[dp] * rs * gp[dp];
                    const double pos = (double)(pr ? (t & 63) : (t >> 6)); const double ang = pos * (double)exp2f(-(float)fi * (13.287712379549449f / 32.0f));
                    const double rr = ang - 6.283185307179586 * rint(ang * 0.15915494309189535); const float sn = __sinf((float)rr), cs = __cosf((float)rr);
                    out = (idx < 32) ? (y * cs - yp * sn) : (y * cs + yp * sn); }
                if (h < 8) out *= att::SCALE * 1.4426950408889634f;
                const float got = bf_lo((unsigned)QKV[(size_t)t * NQKV + h * HD + d]);
                float am = fabsf(out); for (int o = 32; o >= 1; o >>= 1) am = fmaxf(am, __shfl_xor(am, o));
                if (!(fabsf(got - out) <= 0.03f * am + 1e-7f)) atomicOr(ctl + 2, 2u); }
            __syncthreads();
        }
    }
#endif
    if (IN(PH_WO)) { PHASE_IDS;
        pg8::ProbDense<2> P; P.init(O, Wo_t, S, D, D, D, D, 0, G, bid);
        pg8::EpiBf16 E{YZ, D, nullptr, 0, 1.0f};
        pg8::gemm_phase(lds, P, E, wave);
    }
    SEAM(PH_WO);

#define ZLD2(U, J) (*(const v2u*)(YZ + (size_t)(U) * D + 4 * lane + 256 * (J)))
#define BF4(z_) ((f32x4){bf_lo((z_).x), bf_hi((z_).x), bf_lo((z_).y), bf_hi((z_).y)})
#define RDECL0 v2u ya[4][4]
#define RLD0(I, ROW, V) do { ld_row(x + (size_t)(ROW) * D, lane, V); _Pragma("unroll") for (int j = 0; j < 4; ++j) ya[I][j] = ZLD2(ROW, j); } while (0)
#define RFIN0(I, ROW, V) do { _Pragma("unroll") for (int j = 0; j < 4; ++j) { const f32x4 g_ = *(const f32x4*)(MOD + 2 * 1024 + 4 * lane + 256 * j); V[j] += g_ * BF4(ya[I][j]); } \
        st_row_bf16(XA + (size_t)(ROW) * D, lane, V); } while (0)
#define RINIT0(T0) do { } while (0)
#define RDECL1 v2u zt[4][4], za[4][4], zo[4][4]
#define RINIT1(T0) do { _Pragma("unroll") for (int j = 0; j < 4; ++j) { const int half_ = 1 << j; int lo_ = (T0) - half_; if (lo_ < 0) lo_ = 0; int hi_ = (T0) + half_; if (hi_ > S) hi_ = S; \
            zs[j] = (f32x4){0.f, 0.f, 0.f, 0.f}; for (int u_ = lo_; u_ < hi_; ++u_) { const v2u z_ = ZLD2(u_, j); zs[j] += BF4(z_); } } } while (0)
#define RLD1(I, ROW, V) do { ld_row_bf16(XB + (size_t)(ROW) * D, lane, V); \
        _Pragma("unroll") for (int j = 0; j < 4; ++j) { const int half_ = 1 << j, ia_ = (ROW) + half_, is_ = (ROW) - half_; \
            zt[I][j] = ZLD2(ROW, j); za[I][j] = ZLD2(ia_ < S ? ia_ : S - 1, j); zo[I][j] = ZLD2(is_ > 0 ? is_ : 0, j); } } while (0)
#define RFIN1(I, ROW, V) do { \
        _Pragma("unroll") for (int j = 0; j < 4; ++j) { const int half_ = 1 << j, t_ = (ROW); int lo_ = t_ - half_; if (lo_ < 0) lo_ = 0; int hi_ = t_ + half_; if (hi_ > S) hi_ = S; \
            const int ia_ = t_ + half_, is_ = t_ - half_;                       \
            const f32x4 p_ = zs[j] * (1.0f / (float)(hi_ - lo_)) - BF4(zt[I][j]); \
            const f32x4 g_ = *(const f32x4*)(MOD + 6144 + 2 * 1024 + 4 * lane + 256 * j) * *(const f32x4*)(pool_scale + 4 * lane + 256 * j); \
            V[j] += g_ * p_; zs[j] += BF4(za[I][j]) * (ia_ < S ? 1.0f : 0.0f) - BF4(zo[I][j]) * (is_ >= 0 ? 1.0f : 0.0f); } \
        st_row_bf16(XC + (size_t)(ROW) * D, lane, V); } while (0)
#define ROUTE_PHASE(LAYER, RDECL, RLD, RFIN, RINIT, RG) do { \
        const float* modp = MOD + (LAYER) * 6144; const float* gn = norm_ffn + (LAYER) * 1024; const float* rb = router_b + (LAYER) * 32; \
        unsigned* gcnt = ctl + CW_CNT + (LAYER) * 2048; \
        LAS unsigned* lcnt = (LAS unsigned*)(lds + L_LCNT); LAS unsigned* lbase = (LAS unsigned*)(lds + L_LBASE); \
        LAS int* ent_e = (LAS int*)(lds + L_ENT); LAS int* ent_p = ent_e + 256; LAS float* ent_w = (LAS float*)(ent_e + 512); \
        LAS float* part = (LAS float*)(lds + L_OFFS); LAS float* lgt = part + 2048;          \
        f32x4 av[4], bv[4]; \
        _Pragma("unroll") for (int j = 0; j < 4; ++j) { const int col = 4 * lane + 256 * j; const f32x4 g = *(const f32x4*)(gn + col); av[j] = g * (1.0f + *(const f32x4*)(modp + 4 * 1024 + col)); bv[j] = *(const f32x4*)(modp + 3 * 1024 + col); } \
        const int et = wave & 1, rt = (wave >> 1) & 1, kh = wave >> 2; \
        const bf16* wf = WF + ((size_t)((((LAYER) * 2 + et) * 2 + kh) * 16) * 2 * 64 + lane) * 8;       \
        const int brow = rt * 16 + (lane & 15), bkq = lane >> 4; \
        for (int c0 = bid; c0 < S / 32; c0 += 2 * G) { \
          if (tid < 32) lcnt[tid] = 0u; \
          for (int cs = 0; cs < 2; ++cs) { const int chunk = c0 + cs * G; if (chunk >= S / 32) break;        \
            f32x4 zs[4]; (void)zs; RINIT(chunk * 32 + wave * 4); \
            f32x4 hr[4][4]; RDECL; \
            _Pragma("unroll") for (int g_ = 0; g_ < 4; g_ += (RG)) {        \
                _Pragma("unroll") for (int i = g_; i < g_ + (RG); ++i) RLD(i, chunk * 32 + wave * 4 + i, hr[i]); \
                _Pragma("unroll") for (int i = g_; i < g_ + (RG); ++i) RFIN(i, chunk * 32 + wave * 4 + i, hr[i]); } \
            _Pragma("unroll") for (int i = 0; i < 4; ++i) { \
                const int rl = wave * 4 + i, row = chunk * 32 + rl; \
                f32x4 (&h)[4] = hr[i]; \
                const float rs = row_rstd(h); \
                _Pragma("unroll") for (int j = 0; j < 4; ++j) h[j] = h[j] * rs * av[j] + bv[j]; \
                st_row_fp8(H8 + (size_t)row * D, lane, h); \
                _Pragma("unroll") for (int j = 0; j < 4; ++j) { v2u hi_; hi_.x = cvt_pk_bf16(h[j][0], h[j][1]); hi_.y = cvt_pk_bf16(h[j][2], h[j][3]); \
                    const f32x4 r_ = h[j] - (f32x4){bf_lo(hi_.x), bf_hi(hi_.x), bf_lo(hi_.y), bf_hi(hi_.y)}; v2u lo_; lo_.x = cvt_pk_bf16(r_[0], r_[1]); lo_.y = cvt_pk_bf16(r_[2], r_[3]); \
                    const int off_ = rl * 2048 + ((((lane >> 1) + 32 * j) ^ (rl & 15)) << 4) + (lane & 1) * 8; \
                    *(LAS v2u*)(lds + off_) = hi_; *(LAS v2u*)(lds + 65536 + off_) = lo_; } \
            } \
            __syncthreads(); \
            { f32x4 acc_ = (f32x4){0.f, 0.f, 0.f, 0.f}; \
              _Pragma("unroll 4") for (int ks = 0; ks < 16; ++ks) { \
                  const bf16x8 ahi = *(const bf16x8*)(wf + (size_t)(ks * 2) * 512), alo = *(const bf16x8*)(wf + (size_t)(ks * 2 + 1) * 512); \
                  const int boff = brow * 2048 + ((((kh * 512 + ks * 32) >> 3) + bkq) ^ (brow & 15)) * 16; \
                  const bf16x8 bhi = *(const LAS bf16x8*)(lds + boff), blo = *(const LAS bf16x8*)(lds + 65536 + boff); \
                  acc_ = __builtin_amdgcn_mfma_f32_16x16x32_bf16(ahi, bhi, acc_, 0, 0, 0); acc_ = __builtin_amdgcn_mfma_f32_16x16x32_bf16(ahi, blo, acc_, 0, 0, 0); acc_ = __builtin_amdgcn_mfma_f32_16x16x32_bf16(alo, bhi, acc_, 0, 0, 0); } \
              _Pragma("unroll") for (int r = 0; r < 4; ++r) part[wave * 256 + (4 * (lane >> 4) + r) * 16 + (lane & 15)] = acc_[r]; } \
            __syncthreads(); \
            _Pragma("unroll") for (int o_ = 0; o_ < 2; ++o_) { const int idx = tid + 512 * o_, row_ = idx >> 5, e_ = idx & 31; const int w0_ = (e_ >> 4) + 2 * (row_ >> 4), pi_ = (e_ & 15) * 16 + (row_ & 15); \
                lgt[row_ * 33 + e_] = part[w0_ * 256 + pi_] + part[(w0_ + 4) * 256 + pi_] + rb[e_]; } \
            __syncthreads(); \
            if (tid < 32) { const LAS float* lr = lgt + tid * 33; unsigned taken = 0u; int se[4]; float sv[4]; \
                _Pragma("unroll") for (int k = 0; k < 4; ++k) { float mx = -INFINITY; int me = 0; \
                    for (int e = 0; e < 32; ++e) { const float v = lr[e]; const bool ok = !((taken >> e) & 1u) && v > mx; mx = ok ? v : mx; me = ok ? e : me; } \
                    taken |= 1u << me; se[k] = me; sv[k] = mx; } \
                const float e1 = __expf(sv[1] - sv[0]), e2 = __expf(sv[2] - sv[0]), e3 = __expf(sv[3] - sv[0]); const float inv = 1.0f / (1.0f + e1 + e2 + e3); \
                const float ww[4] = {inv, e1 * inv, e2 * inv, e3 * inv}; \
                _Pragma("unroll") for (int k = 0; k < 4; ++k) { const unsigned pl = __hip_atomic_fetch_add(lcnt + se[k], 1u, __ATOMIC_RELAXED, __HIP_MEMORY_SCOPE_WORKGROUP); \
                    const int ei = (cs * 32 + tid) * 4 + k; ent_e[ei] = se[k]; ent_p[ei] = (int)pl; ent_w[ei] = ww[k]; } } \
            __syncthreads(); \
          } \
          if (tid < 32) { const unsigned c_ = lcnt[tid]; unsigned base = 0u; if (c_) base = __hip_atomic_fetch_add(gcnt + 64 * tid, c_, RLX_AGENT); lbase[tid] = base; } \
          __syncthreads(); \
          if (tid < 256) { const int cs = tid >> 7, rl = (tid >> 2) & 31; const int chunk = c0 + cs * G; \
              if (chunk < S / 32) { const int e = ent_e[tid]; const int pos = (int)lbase[e] + ent_p[tid]; const int tok = chunk * 32 + rl; \
                  tok_list[e * S + pos] = tok; tok_e[tok * 4 + (tid & 3)] = e; tok_pos[tok * 4 + (tid & 3)] = pos; tok_w[tok * 4 + (tid & 3)] = ent_w[tid]; } } \
          __syncthreads(); \
        } } while (0)

#define MOE1_PHASE(LAYER) do { \
        const int n_my = moe_build_units(lds, ctl + CW_CNT + (LAYER) * 2048, tok_list, 8, true, D, G, bid, tid); \
        pg8::ProbMoE<true, 1> P{H8, Wgu8 + (size_t)(LAYER) * 32 * 2048 * 1024, D, D, n_my, (size_t)2048 * 1024, lds, 2048}; \
        pg8::EpiSwiglu E{ACT8, b_gu + (size_t)(LAYER) * 32 * 2048, 1.0f / WSCALE}; \
        pg8::gemm_phase(lds, P, E, wave); } while (0)
#define MOE2_PHASE(LAYER) do { \
        const int n_my = moe_build_units(lds, ctl + CW_CNT + (LAYER) * 2048, tok_list, 4, false, D, G, bid, tid); \
        pg8::ProbMoE<false, 1> P{ACT8, Wd8 + (size_t)(LAYER) * 32 * 1024 * 1024, D, D, n_my, (size_t)1024 * 1024, lds, 1024}; \
        pg8::EpiBf16 E{Y, D, b_down + (size_t)(LAYER) * 32 * 1024, 1024, 1.0f / WSCALE}; \
        pg8::gemm_phase(lds, P, E, wave); } while (0)
#define COMBINE_ROW(LAYER, XIN, ROW, V) do { \
        ld_row_bf16((XIN) + (size_t)(ROW) * D, lane, V); \
        const v4i te = *(const v4i*)(tok_e + (ROW) * 4), tp = *(const v4i*)(tok_pos + (ROW) * 4); const f32x4 tw = *(const f32x4*)(tok_w + (ROW) * 4); \
        f32x4 a_[4]; _Pragma("unroll") for (int j = 0; j < 4; ++j) a_[j] = (f32x4){0.f, 0.f, 0.f, 0.f}; \
        _Pragma("unroll") for (int k = 0; k < 4; ++k) { const int e = __builtin_amdgcn_readfirstlane(te[k]); const int pos = __builtin_amdgcn_readfirstlane(tp[k]); const float w = tw[k]; \
            const int prow = (int)__builtin_amdgcn_readlane(tbv, e) * 256 + pos; const bf16* yr = Y + (size_t)prow * D; \
            _Pragma("unroll") for (int j = 0; j < 4; ++j) { const v2u y = *(const v2u*)(yr + 4 * lane + 256 * j); a_[j] += w * (f32x4){bf_lo(y.x), bf_hi(y.x), bf_lo(y.y), bf_hi(y.y)}; } } \
        _Pragma("unroll") for (int j = 0; j < 4; ++j) V[j] = V[j] + gfv[j] * a_[j]; } while (0)
#define TILE_BASE(LAYER) \
        int tbv; { const unsigned cnt = (lane < NE) ? __hip_atomic_load(ctl + CW_CNT + (LAYER) * 2048 + 64 * lane, RLX_AGENT) : 0u; unsigned incl = (cnt + 255u) >> 8; const unsigned own = incl; \
            _Pragma("unroll") for (int o = 1; o < 32; o <<= 1) { const unsigned t = __shfl_up(incl, o); if (lane >= o) incl += t; } tbv = (int)(incl - own); }

    if (IN(PH_ROUTE0)) { PHASE_IDS; ROUTE_PHASE(0, RDECL0, RLD0, RFIN0, RINIT0, 4); }
    SEAM(PH_ROUTE0);
    if (IN(PH_MOE1_0)) { PHASE_IDS; MOE1_PHASE(0); }
    SEAM(PH_MOE1_0);
    if (IN(PH_MOE2_0)) { PHASE_IDS; MOE2_PHASE(0); }
    SEAM(PH_MOE2_0);

    if (IN(PH_COMB0)) { PHASE_IDS;
        TILE_BASE(0)
        f32x4 gfv[4], av[4], bv[4];
#pragma unroll
        for (int j = 0; j < 4; ++j) { const int col = 4 * lane + 256 * j; gfv[j] = *(const f32x4*)(MOD + 5 * 1024 + col);
            const f32x4 g = *(const f32x4*)(norm_mix + 1024 + col); av[j] = g * (1.0f + *(const f32x4*)(MOD + 6144 + 1024 + col)); bv[j] = *(const f32x4*)(MOD + 6144 + col); }
        for (int r = gw; r < S; r += NGW) { f32x4 v[4]; COMBINE_ROW(0, XA, r, v);
            st_row_bf16(XB + (size_t)r * D, lane, v); const float rs = row_rstd(v);
#pragma unroll
            for (int j = 0; j < 4; ++j) v[j] = v[j] * rs * av[j] + bv[j];
            st_row_bf16(H1B + (size_t)r * D, lane, v); }
    }
    SEAM(PH_COMB0);

    if (IN(PH_POOLG)) { PHASE_IDS;
        pg8::ProbDense<2> P; P.init(H1B, Wpool_t, S, D, 256, D, 256, 256, G, bid);
        pg8::EpiBf16 E{YZ, D, nullptr, 0, 1.0f};
        pg8::gemm_phase(lds, P, E, wave);
    }
    SEAM(PH_POOLG);

    if (IN(PH_ROUTE1)) { PHASE_IDS; ROUTE_PHASE(1, RDECL1, RLD1, RFIN1, RINIT1, 2); }
    SEAM(PH_ROUTE1);
    if (IN(PH_MOE1_1)) { PHASE_IDS; MOE1_PHASE(1); }
    SEAM(PH_MOE1_1);
    if (IN(PH_MOE2_1)) { PHASE_IDS; MOE2_PHASE(1); }
    SEAM(PH_MOE2_1);

    if (IN(PH_FINAL)) { PHASE_IDS;
        TILE_BASE(1)
        f32x4 gfv[4], fv[4];
#pragma unroll
        for (int j = 0; j < 4; ++j) { const int col = 4 * lane + 256 * j; gfv[j] = *(const f32x4*)(MOD + 6144 + 5 * 1024 + col); fv[j] = *(const f32x4*)(final_norm + col); }
        for (int r = gw; r < S; r += NGW) { f32x4 v[4]; COMBINE_ROW(1, XC, r, v);
            const float rs = row_rstd(v);
#pragma unroll
            for (int j = 0; j < 4; ++j) v[j] = v[j] * rs * fv[j];
#ifdef SELFCHECK
            if (__hip_atomic_load(ctl + 2, RLX_AGENT) != 0u) { for (int j = 0; j < 4; ++j) v[j] = (f32x4){__builtin_nanf(""), __builtin_nanf(""), __builtin_nanf(""), __builtin_nanf("")}; }
#endif
            st_row(args.out + (size_t)r * D, lane, v); }
    }
#undef IN
#undef SEAM
}

extern "C" void kernel_launch(void* const* d_in, const int* in_sizes, int n_in, void* d_out, int out_size, void* d_ws, size_t ws_size, hipStream_t stream) {
    static int grid = 0;
    if (grid == 0) {
        if (n_in != 21 || in_sizes[0] != S * D || out_size != S * D || ws_size < WS_END) { fprintf(stderr, "kernel_launch: unexpected shapes (n_in %d, in0 %d, out %d, ws %zu)\n", n_in, n_in > 0 ? in_sizes[0] : -1, out_size, ws_size); grid = -1; return; }
        int dev = 0, cus = 0, per_cu = 0;
        if (hipGetDevice(&dev) != hipSuccess || hipDeviceGetAttribute(&cus, hipDeviceAttributeMultiprocessorCount, dev) != hipSuccess) { grid = -1; return; }
        if (hipFuncSetAttribute((const void*)fwd_kernel, hipFuncAttributeMaxDynamicSharedMemorySize, LDS_BYTES) != hipSuccess) { fprintf(stderr, "kernel_launch: hipFuncSetAttribute failed\n"); grid = -1; return; }
        if (hipOccupancyMaxActiveBlocksPerMultiprocessor(&per_cu, (const void*)fwd_kernel, 512, LDS_BYTES) != hipSuccess || per_cu < 1) { fprintf(stderr, "kernel_launch: occupancy query says %d\n", per_cu); }
        (void)hipGetLastError();
        grid = cus;
    }
    if (grid < 0) return;
    if (hipMemsetAsync((char*)d_ws + WS_CTL, 0, CTL_ZERO_BYTES, stream) != hipSuccess) return;
    Args a{};
    for (int i = 0; i < 21; ++i) a.in[i] = (const float*)d_in[i];
    a.out = (float*)d_out; a.ws = (unsigned char*)d_ws;
    if (MK_N_LAUNCHES == 1) { a.ph_lo = 0; a.ph_hi = NPHASE; hipLaunchKernelGGL(fwd_kernel, dim3(grid), dim3(512), LDS_BYTES, stream, a); }
    else for (int p = 0; p < NPHASE; ++p) { a.ph_lo = p; a.ph_hi = p + 1; hipLaunchKernelGGL(fwd_kernel, dim3(grid), dim3(512), LDS_BYTES, stream, a); }
    if (PROBE_REP >= 0) { a.ph_lo = PROBE_REP; a.ph_hi = PROBE_REP + 1; hipLaunchKernelGGL(fwd_kernel, dim3(grid), dim3(512), LDS_BYTES, stream, a); }
    const hipError_t le = hipPeekAtLastError();
    if (le != hipSuccess) fprintf(stderr, "kernel_launch: launch failed: %s\n", hipGetErrorName(le));
}
```

```cpp
#include <hip/hip_runtime.h>
#include <cstdio>
#include <cstdint>

#ifndef MK_N_LAUNCHES
#define MK_N_LAUNCHES 1
#endif
#ifndef PROBE_VAR
#define PROBE_VAR 0
#endif
#ifndef PROBE_REP
#define PROBE_REP -1
#endif

#define GAS __attribute__((address_space(1)))
#define LAS __attribute__((address_space(3)))
typedef unsigned short bf16;
typedef unsigned v4u __attribute__((ext_vector_type(4)));
typedef unsigned v2u __attribute__((ext_vector_type(2)));
typedef int v4i __attribute__((ext_vector_type(4)));
typedef float f32x4 __attribute__((ext_vector_type(4)));
typedef float f32x2 __attribute__((ext_vector_type(2)));
typedef float f32x16 __attribute__((ext_vector_type(16)));
typedef short bf16x8 __attribute__((ext_vector_type(8)));
typedef short s16x4 __attribute__((ext_vector_type(4)));
typedef int v8i __attribute__((ext_vector_type(8)));

constexpr int S = 16384, CT = 256, NTOK = S + CT, D = 1024, NQKV = 1536, NE = 32, HD = 128, NH = 8, NKV = 2;
constexpr int GRID_W = 64;
constexpr float NORM_EPS = 1e-6f;
constexpr int NPHASE = 15;
constexpr float WSCALE = 32.0f;
enum Phase { PH_PRO = 0, PH_NORM1, PH_QKV, PH_QKROPE, PH_ATTN, PH_WO, PH_ROUTE0, PH_MOE1_0, PH_MOE2_0, PH_COMB0, PH_POOLG, PH_ROUTE1, PH_MOE1_1, PH_MOE2_1, PH_FINAL };

constexpr size_t MiB = 1u << 20;
constexpr size_t WS_CTL = 0, CTL_ZERO_BYTES = 1 * MiB;
constexpr size_t WS_MOD = 1 * MiB;
constexpr size_t WS_WQKV = 2 * MiB;
constexpr size_t WS_WO = 5 * MiB;
constexpr size_t WS_WPOOL = 7 * MiB;
constexpr size_t WS_TOKLIST = 8 * MiB;
constexpr size_t WS_TOKE = 10 * MiB;
constexpr size_t WS_TOKP = 10 * MiB + 256 * 1024;
constexpr size_t WS_TOKW = 10 * MiB + 512 * 1024;
constexpr size_t WS_H = 16 * MiB;
constexpr size_t WS_QKV = 52 * MiB;
constexpr size_t WS_O = 104 * MiB;
constexpr size_t WS_XA = 136 * MiB;
constexpr size_t WS_XB = 200 * MiB;
constexpr size_t WS_XC = 264 * MiB;
constexpr size_t WS_H1F = 328 * MiB;
constexpr size_t WS_POOLED = 392 * MiB;
constexpr size_t WS_ACT = 424 * MiB;
constexpr size_t WS_Y = 568 * MiB;
constexpr size_t WS_WGU = 712 * MiB;
constexpr size_t WS_WD = 968 * MiB;
constexpr size_t WS_Q8 = 1040 * MiB;
constexpr size_t WS_K8 = 1056 * MiB;
constexpr size_t WS_VT8 = 1062 * MiB;
constexpr size_t WS_END = 1096 * MiB;
constexpr int CW_BAR = 4096;
constexpr int CW_CNT = 8192;

constexpr int RING_BYTES = 131072;
constexpr int MISC_OFF = RING_BYTES;
constexpr int L_LCNT = MISC_OFF + 64;
constexpr int L_LBASE = MISC_OFF + 192;
constexpr int L_TB = MISC_OFF + 320;
constexpr int L_CNT = MISC_OFF + 480;
constexpr int L_UT = MISC_OFF + 640;
constexpr int L_ENT = MISC_OFF + 1280;
constexpr int L_OFFS = MISC_OFF + 4608;
constexpr int LDS_BYTES = MISC_OFF + 4608 + 16384 + 256;
static_assert(LDS_BYTES <= 163840, "LDS");

#define RLX_AGENT __ATOMIC_RELAXED, __HIP_MEMORY_SCOPE_AGENT
#define LDS_WAIT() asm volatile("s_waitcnt lgkmcnt(0)" ::: "memory")
#define VM_WAIT() asm volatile("s_waitcnt vmcnt(0)" ::: "memory")

__device__ __forceinline__ int fresh_lane() { int l; asm volatile("v_mbcnt_lo_u32_b32 %0, -1, 0\n\tv_mbcnt_hi_u32_b32 %0, -1, %0" : "=v"(l)); return l; }
__device__ __forceinline__ unsigned cvt_pk_bf16(float lo, float hi) { unsigned r; asm volatile("v_cvt_pk_bf16_f32 %0, %1, %2" : "=v"(r) : "v"(lo), "v"(hi)); return r; }
__device__ __forceinline__ unsigned cvt_pk_fp8x4(float a, float b, float c, float d) { int w = 0; w = __builtin_amdgcn_cvt_pk_fp8_f32(a, b, w, false); w = __builtin_amdgcn_cvt_pk_fp8_f32(c, d, w, true); return (unsigned)w; }
__device__ __forceinline__ float bf_lo(unsigned w) { return __uint_as_float(w << 16); }
__device__ __forceinline__ float bf_hi(unsigned w) { return __uint_as_float(w & 0xffff0000u); }
__device__ __forceinline__ float wave_sum(float v) {
#pragma unroll
    for (int o = 32; o >= 1; o >>= 1) v += __shfl_xor(v, o);
    return v;
}
__device__ __forceinline__ float wave_max(float v) {
#pragma unroll
    for (int o = 32; o >= 1; o >>= 1) v = fmaxf(v, __shfl_xor(v, o));
    return v;
}

#define XB_TMO      128
#define XB_XCNT(j)  (256  + 64 * (j))
#define XB_XSUB(j)  (1280 + 64 * (j))
#define XB_XGEN(j)  (2304 + 64 * (j))
#define XB_TOP      3328
#define XB_TOPGEN   3392
#define XCD_BAR_WORDS 3456
#define XB_SPIN_CAP (1u << 18)
__device__ __forceinline__ unsigned xb_ld(unsigned* p)              { return __hip_atomic_load(p, __ATOMIC_RELAXED, __HIP_MEMORY_SCOPE_AGENT); }
__device__ __forceinline__ unsigned xb_add(unsigned* p, unsigned v) { return __hip_atomic_fetch_add(p, v, __ATOMIC_RELAXED, __HIP_MEMORY_SCOPE_AGENT); }
__device__ __forceinline__ unsigned xb_xcc_id() { return (unsigned)__builtin_amdgcn_s_getreg((3 << 11) | 20) & 0xFu; }
#define XB_SPIN(cond, bar) do { unsigned _sp = 0; while (cond) { __builtin_amdgcn_s_sleep(1); \
    if ((++_sp & 255u) == 0u) { if (xb_ld(&(bar)[XB_TMO])) break; if (_sp > XB_SPIN_CAP) { atomicAdd(&(bar)[XB_TMO], 1u); break; } } } } while (0)
struct XcdBarrier { unsigned* bar; unsigned x; volatile LAS unsigned* st; int wave; };
__device__ __forceinline__ XcdBarrier xcd_barrier_post(unsigned* bar, volatile LAS unsigned* st, int wave) {
    XcdBarrier b; b.bar = bar; b.x = xb_xcc_id(); b.st = st; b.wave = wave;
    if (wave == 0 && fresh_lane() == 0) (void)xb_add(&bar[XB_XCNT(b.x)], 1u);
    return b;
}
__device__ __forceinline__ void xcd_barrier_complete(unsigned* bar, unsigned x, unsigned& nloc, unsigned& nx) {
    const unsigned G = gridDim.x * gridDim.y * gridDim.z;
    unsigned sum, cnt, mine, sp = 0u;
    for (;;) {
        sum = 0u; cnt = 0u; mine = 0u;
#pragma unroll
        for (unsigned j = 0; j < 16; ++j) { const unsigned c = xb_ld(&bar[XB_XCNT(j)]); sum += c; cnt += (c > 0u) ? 1u : 0u; mine = (j == x) ? c : mine; }
        if (sum == G) break;
        __builtin_amdgcn_s_sleep(1);
        if ((++sp & 255u) == 0u) { if (xb_ld(&bar[XB_TMO])) break; if (sp > XB_SPIN_CAP) { atomicAdd(&bar[XB_TMO], 1u); break; } }
    }
    nloc = mine > 0u ? mine : 1u; nx = cnt > 0u ? cnt : 1u;
}
__device__ __forceinline__ void xcd_barrier(const XcdBarrier& b) {
    asm volatile("s_waitcnt vmcnt(0)" ::: "memory");
    __syncthreads();
    if (b.wave == 0 && fresh_lane() == 0) {
        unsigned* bar = b.bar;
        __builtin_amdgcn_s_waitcnt(0);
        unsigned nloc = b.st[0], nx = b.st[1];
        if (nloc == 0u) { xcd_barrier_complete(bar, b.x, nloc, nx); b.st[0] = nloc; b.st[1] = nx; }
        const unsigned old = xb_add(&bar[XB_XSUB(b.x)], 1u);
        const unsigned gen = old / nloc;
        if (old + 1u == (gen + 1u) * nloc) {
            __builtin_amdgcn_fence(__ATOMIC_RELEASE, "agent");
            asm volatile("s_waitcnt vmcnt(0)" ::: "memory");
            const unsigned og = xb_add(&bar[XB_TOP], 1u);
            const unsigned tg = og / nx;
            if (og + 1u == (tg + 1u) * nx) xb_add(&bar[XB_TOPGEN], 1u);
            else XB_SPIN(xb_ld(&bar[XB_TOPGEN]) == tg, bar);
            __builtin_amdgcn_fence(__ATOMIC_ACQUIRE, "agent");
            xb_add(&bar[XB_XGEN(b.x)], 1u);
            asm volatile("s_waitcnt vmcnt(0)" ::: "memory");
        } else {
            XB_SPIN(xb_ld(&bar[XB_XGEN(b.x)]) == gen, bar);
            __builtin_amdgcn_fence(__ATOMIC_ACQUIRE, "agent");
            asm volatile("s_waitcnt vmcnt(0)" ::: "memory");
        }
    }
    __syncthreads();
}

namespace pg8 {
constexpr int BM = 256, BK = 64, HALF = 128, HTB = HALF * BK * 2, NXCD = 8, WGM = 8;
__device__ __forceinline__ int lds_byte(int r, int c) { const int st = (r >> 4) * 2 + (c >> 5), rr = r & 15, cc = c & 31, ob = rr * 64 + cc * 2; return st * 1024 + (ob ^ (((ob >> 9) & 1) << 5)); }
__device__ __forceinline__ void stage_rc(int b, int& R, int& C) { const int st = b / 1024, sb = b % 1024, swz = sb ^ (((sb >> 9) & 1) << 5); R = (st >> 1) * 16 + swz / 64; C = (st & 1) * 32 + (swz % 64) / 2; }
__device__ __forceinline__ int perm32(int rho) { const int n = rho >> 4, i = rho & 15; return 8 * (i >> 2) + 4 * n + (i & 3); }

struct GU { const char* A; const char* B; int orow0; int pn; int e; int slot; };

template <int ESZ_> struct ProbDense {
    static constexpr int ESZ = ESZ_; static constexpr bool BIL = false, AIL = false; static constexpr int nB = 0;
    const unsigned char* A; const unsigned char* Bt; int lda, ldb, K, acol; int nM, nN, nwg, G, c;
    __device__ __forceinline__ void init(const void* A_, const void* Bt_, int M, int N, int K_, int lda_, int ldb_, int acol_, int G_, int c_) {
        A = (const unsigned char*)A_; Bt = (const unsigned char*)Bt_; lda = lda_; ldb = ldb_; K = K_; acol = acol_; nM = M / BM; nN = N / BM; nwg = nM * nN; G = G_; c = c_; }
    __device__ __forceinline__ bool next(int i, GU& u) const {
        const long L = (long)i * G + c; if (L >= nwg) return false;
        int wgid = (int)L; { const int q = nwg / NXCD, r = nwg % NXCD, xcd = wgid % NXCD, off = wgid / NXCD; wgid = (xcd < r ? xcd * (q + 1) : r * (q + 1) + (xcd - r) * q) + off; }
        const int nig = WGM * nN, gid = wgid / nig, fm = gid * WGM, gsz = (nM - fm) < WGM ? (nM - fm) : WGM;
        const int pm = fm + ((wgid % nig) % gsz), pn = (wgid % nig) / gsz;
        u.A = (const char*)(A + ((size_t)pm * BM * lda + (size_t)pn * acol) * ESZ); u.B = (const char*)(Bt + (size_t)pn * BM * ldb * ESZ); u.orow0 = pm * BM; u.pn = pn; u.e = 0; u.slot = i; return true;
    }
    __device__ __forceinline__ void a_offs(const GU&, const int (&R)[2], const int (&C)[2], unsigned (&vo)[2][2], LAS unsigned char*, int) const {
#pragma unroll
        for (int h = 0; h < 2; ++h)
#pragma unroll
            for (int i = 0; i < 2; ++i) vo[h][i] = (unsigned)((R[i] + HALF * h) * lda * ESZ + C[i] * 2);
    }
};
template <bool GATHER, int ESZ_> struct ProbMoE {
    static constexpr int ESZ = ESZ_; static constexpr bool BIL = true, AIL = !GATHER;
    const unsigned char* A; const unsigned char* Bt; int ldb, K; int n_my; size_t b_expert_stride  ; LAS unsigned char* ldsp; int nB;
    __device__ __forceinline__ bool next(int i, GU& u) const {
        if (i >= n_my) return false;
        const LAS int* ut = (const LAS int*)(ldsp + L_UT) + i * 8;
        const int e = __builtin_amdgcn_readfirstlane(ut[0]), pn = __builtin_amdgcn_readfirstlane(ut[2]), mtg = __builtin_amdgcn_readfirstlane(ut[3]);
        u.e = e; u.pn = pn; u.orow0 = mtg * BM; u.slot = i;
        u.A = GATHER ? (const char*)A : (const char*)(A + (size_t)mtg * BM * D * ESZ);
        u.B = (const char*)(Bt + (size_t)e * b_expert_stride + (size_t)pn * BM * 16);
        return true;
    }
    __device__ __forceinline__ void a_offs(const GU& u, const int (&R)[2], const int (&C)[2], unsigned (&vo)[2][2], LAS unsigned char* lds, int tid) const {
        if (GATHER) {
            const LAS unsigned* offs = (const LAS unsigned*)(lds + L_OFFS) + u.slot * 256;
#pragma unroll
            for (int h = 0; h < 2; ++h)
#pragma unroll
                for (int i = 0; i < 2; ++i) vo[h][i] = offs[R[i] + HALF * h] + (unsigned)C[i] * 2u;
        } else {
#pragma unroll
            for (int h = 0; h < 2; ++h)
#pragma unroll
                for (int i = 0; i < 2; ++i) { const int sti = (tid >> 6) + 8 * i, aR = (sti >> 1) * 16 + (tid & 15), aC = (sti & 1) * 4 + ((tid >> 4) & 3);
                    vo[h][i] = (unsigned)(aC * (BM * 16) + (aR + HALF * h) * 16); }
        }
    }
};

typedef f32x4 Acc[2][2][4][2];

struct EpiBf16 {
    static constexpr bool PERM = true;
    bf16* O; int ldc; const float* bias; int bias_stride; float scale;
    __device__ __forceinline__ void operator()(const Acc& acc, const GU& u, int wr, int wc, int fr, int fq) const {
        const int row0 = u.orow0 + wr * 64 + fr, col0 = u.pn * BM + wc * 32 + 8 * fq;
        f32x4 bv[2][2];
#pragma unroll
        for (int bj = 0; bj < 2; ++bj)
#pragma unroll
            for (int n = 0; n < 2; ++n) bv[bj][n] = bias ? *(const f32x4*)(bias + (size_t)u.e * bias_stride + col0 + bj * HALF + 4 * n) : (f32x4){0.f, 0.f, 0.f, 0.f};
#pragma unroll
        for (int ai = 0; ai < 2; ++ai)
#pragma unroll
            for (int m = 0; m < 4; ++m) { bf16* rowp = O + (size_t)(row0 + ai * HALF + m * 16) * ldc + col0;
#pragma unroll
                for (int bj = 0; bj < 2; ++bj) { const f32x4 v0 = acc[ai][bj][m][0] * scale + bv[bj][0], v1 = acc[ai][bj][m][1] * scale + bv[bj][1];
                    v4u w; w.x = cvt_pk_bf16(v0[0], v0[1]); w.y = cvt_pk_bf16(v0[2], v0[3]); w.z = cvt_pk_bf16(v1[0], v1[1]); w.w = cvt_pk_bf16(v1[2], v1[3]);
                    *(v4u*)(rowp + bj * HALF) = w; } }
    }
};
struct EpiResid {
    static constexpr bool PERM = false;
    const float* Base; float* Out; const float* gate; const float* gate2;
    __device__ __forceinline__ void operator()(const Acc& acc, const GU& u, int wr, int wc, int fr, int fq) const {
        const int row0 = u.orow0 + wr * 64 + fr, col0 = u.pn * BM + wc * 32 + 4 * fq;
#pragma unroll
        for (int bj = 0; bj < 2; ++bj)
#pragma unroll
            for (int n = 0; n < 2; ++n) { const int col = col0 + bj * HALF + n * 16;
                f32x4 gv = *(const f32x4*)(gate + col); if (gate2) gv = gv * *(const f32x4*)(gate2 + col);
#pragma unroll
                for (int ai = 0; ai < 2; ++ai) {
#pragma unroll
                    for (int m = 0; m < 4; ++m) { const size_t off = (size_t)(row0 + ai * HALF + m * 16) * D + col;
                        const f32x4 b4 = *(const f32x4*)(Base + off); *(f32x4*)(Out + off) = b4 + gv * acc[ai][bj][m][n]; }
                    asm volatile("" ::: "memory"); } }
    }
};
struct EpiSwiglu {
    static constexpr bool PERM = true;
    unsigned char* O; const float* bias; float scale;
    __device__ __forceinline__ void operator()(const Acc& acc, const GU& u, int wr, int wc, int fr, int fq) const {
        const int row0 = u.orow0 + wr * 64 + fr, c0 = u.pn * HALF + wc * 32 + 8 * fq;
        const float* bp = bias + (size_t)u.e * 2048 + c0;
        f32x4 bg[2], bu[2];
#pragma unroll
        for (int n = 0; n < 2; ++n) { bg[n] = *(const f32x4*)(bp + 4 * n); bu[n] = *(const f32x4*)(bp + 1024 + 4 * n); }
#pragma unroll
        for (int ai = 0; ai < 2; ++ai)
#pragma unroll
            for (int m = 0; m < 4; ++m) { const int rt_ = wr * 64 + fr + ai * HALF + m * 16, k16_ = c0 >> 4;
                unsigned char* rowp = O + (size_t)u.orow0 * D + ((size_t)k16_ * BM + rt_) * 16 + (c0 & 15);
                float r[8];
#pragma unroll
                for (int n = 0; n < 2; ++n) { const f32x4 g4 = acc[ai][0][m][n] * scale + bg[n], u4 = acc[ai][1][m][n] * scale + bu[n];
#pragma unroll
                    for (int j = 0; j < 4; ++j) { const float g = fminf(g4[j], 7.0f), up = fminf(fmaxf(u4[j], -7.0f), 7.0f);
                        const float sg = __builtin_amdgcn_rcpf(1.0f + __builtin_amdgcn_exp2f(g * (-1.702f * 1.4426950408889634f)));
                        r[n * 4 + j] = (up + 1.0f) * (g * sg); } }
                v2u w; w.x = cvt_pk_fp8x4(r[0], r[1], r[2], r[3]); w.y = cvt_pk_fp8x4(r[4], r[5], r[6], r[7]);
                *(v2u*)rowp = w; }
    }
};

__device__ __forceinline__ const char* uni(const char* p) {
    const unsigned long long v = (unsigned long long)p; const unsigned lo = __builtin_amdgcn_readfirstlane((unsigned)v), hi = __builtin_amdgcn_readfirstlane((unsigned)(v >> 32));
    return (const char*)(((unsigned long long)hi << 32) | lo); }
template <int ESZ> struct FragT;
template <> struct FragT<2> { struct T { bf16x8 k0, k1; };
    static __device__ __forceinline__ T ld(const LAS v4i* p) { T r; r.k0 = __builtin_bit_cast(bf16x8, p[0]); r.k1 = __builtin_bit_cast(bf16x8, p[64]); return r; }
    template <int KK> static __device__ __forceinline__ void mma(const T& b, const T& a, f32x4& c) {
        if (KK == 0) asm volatile("v_mfma_f32_16x16x32_bf16 %0, %1, %2, %0" : "+v"(c) : "v"(b.k0), "v"(a.k0));
        else asm volatile("v_mfma_f32_16x16x32_bf16 %0, %1, %2, %0" : "+v"(c) : "v"(b.k1), "v"(a.k1)); }
    static constexpr int NK = 2; };
template <> struct FragT<1> { typedef v8i T;
    static __device__ __forceinline__ T ld(const LAS v4i* p) { const v4i lo = p[0], hi = p[64]; return __builtin_shufflevector(lo, hi, 0, 1, 2, 3, 4, 5, 6, 7); }
    template <int KK> static __device__ __forceinline__ void mma(const T& b, const T& a, f32x4& c) { asm volatile("v_mfma_f32_16x16x128_f8f6f4 %0, %1, %2, %0" : "+v"(c) : "v"(b), "v"(a)); }
    static constexpr int NK = 1; };

template <class Prob, class Epi>
__device__ __forceinline__ void gemm_phase(LAS unsigned char* lds, const Prob& P, const Epi& E, const int wid) {
    const int lane = fresh_lane(), tid = wid * 64 + lane, wr = wid >> 2, wc = wid & 3, fr = lane & 15, fq = lane >> 4;
    constexpr int ESZ = Prob::ESZ;
    const int K = P.K, nt = K * ESZ / (BK * 2);
    int R[2], C[2]; unsigned voffB[2];
#pragma unroll
    for (int i = 0; i < 2; ++i) { stage_rc(tid * 16 + i * 8192, R[i], C[i]); const int Rb = Epi::PERM ? ((R[i] & ~31) + perm32(R[i] & 31)) : R[i];
        const int sti = wid + 8 * i, bR = (sti >> 1) * 16 + (lane & 15), bC = (sti & 1) * 4 + (lane >> 4);
        voffB[i] = Prob::BIL ? (unsigned)(bC * (P.nB * 16) + bR * 16) : (unsigned)(Rb * P.ldb * ESZ + C[i] * 2); }
    const size_t kstep = (size_t)(BK * 2);
    const size_t kstepA = Prob::AIL ? (size_t)8 * BM * 16 : kstep;
    const size_t kstepB = Prob::BIL ? (size_t)8 * P.nB * 16 : kstep;
    const size_t hstepB = Prob::BIL ? (size_t)HALF * 16 : (size_t)HALF * P.ldb * ESZ;
    const unsigned ldsw = (unsigned)wid * 1024u;
    const int aoff = Prob::AIL ? (wr * 8192 + fq * 256 + fr * 16) : lds_byte(wr * 64 + fr, fq * 8), boff = Prob::BIL ? (wc * 4096 + fq * 256 + fr * 16) : lds_byte(wc * 32 + fr, fq * 8);
#define PG8_SA(b, h) (((b) * 2 + (h)) * HTB)
#define PG8_SB(b, h) ((4 + (b) * 2 + (h)) * HTB)
#define PG8_STAGE(bufoff, gbase, voff) do { _Pragma("unroll") for (int _i = 0; _i < 2; ++_i) { unsigned o_ = (voff)[_i]; asm volatile("" : "+v"(o_));     \
        __builtin_amdgcn_global_load_lds((const unsigned*)((const char*)(gbase) + o_), (LAS unsigned*)(lds + (bufoff) + ldsw + _i * 8192), 16, 0, 0); } } while (0)
#define PG8_LD2(p) FragT<ESZ>::ld((const LAS v4i*)(p))
#define PG8_LDA(dst, b, h) do { _Pragma("unroll") for (int m = 0; m < 4; ++m) dst[m] = PG8_LD2(lds + PG8_SA(b, h) + aoff + m * 2048); } while (0)
#define PG8_LDB(dst, b, h) do { _Pragma("unroll") for (int n = 0; n < 2; ++n) dst[n] = PG8_LD2(lds + PG8_SB(b, h) + boff + n * 2048); } while (0)
#define PG8_MMA(ai, bj, At, Bt) do { __builtin_amdgcn_s_setprio(1); \
        _Pragma("unroll") for (int m = 0; m < 4; ++m) _Pragma("unroll") for (int n = 0; n < 2; ++n) FragT<ESZ>::template mma<0>(Bt[n], At[m], acc[ai][bj][m][n]); \
        if constexpr (FragT<ESZ>::NK == 2) { _Pragma("unroll") for (int m = 0; m < 4; ++m) _Pragma("unroll") for (int n = 0; n < 2; ++n) FragT<ESZ>::template mma<1>(Bt[n], At[m], acc[ai][bj][m][n]); } \
        __builtin_amdgcn_s_setprio(0); } while (0)
#define PG8_WAIT_V(n) asm volatile("s_waitcnt vmcnt(" #n ")" ::: "memory")
#define PG8_WAIT_L(n) asm volatile("s_waitcnt lgkmcnt(" #n ")" ::: "memory")
#define PG8_BAR __builtin_amdgcn_s_barrier()
#define PG8_SCHED __builtin_amdgcn_sched_barrier(0)
    GU cur, nxt; int ui = 0;
    if (!P.next(0, cur)) return;
    Acc acc;
#pragma unroll
    for (int a = 0; a < 2; ++a)
#pragma unroll
        for (int b = 0; b < 2; ++b)
#pragma unroll
            for (int m = 0; m < 4; ++m)
#pragma unroll
                for (int n = 0; n < 2; ++n) acc[a][b][m][n] = (f32x4){0.f, 0.f, 0.f, 0.f};
    typename FragT<ESZ>::T At[4], B0[2], B1[2];
    unsigned cvo[2][2];
    P.a_offs(cur, R, C, cvo, lds, tid);
    const char* cA = uni(cur.A); const char* cB = uni(cur.B);
    PG8_STAGE(PG8_SB(0, 0), cB, voffB); PG8_STAGE(PG8_SB(0, 1), cB + hstepB, voffB); PG8_STAGE(PG8_SA(0, 0), cA, cvo[0]); PG8_STAGE(PG8_SA(0, 1), cA, cvo[1]);
    if (wr == 1) PG8_BAR;
    PG8_WAIT_V(2); PG8_BAR;
    PG8_STAGE(PG8_SB(1, 0), cB + kstepB, voffB); PG8_STAGE(PG8_SA(1, 0), cA + kstepA, cvo[0]); PG8_STAGE(PG8_SB(1, 1), cB + hstepB + kstepB, voffB);
    PG8_WAIT_V(6); PG8_BAR;
    for (;;) {
        const bool has_next = P.next(ui + 1, nxt);
        const char* nA = uni(has_next ? nxt.A : cA); const char* nB = uni(has_next ? nxt.B : cB);
#define PG8_KBODY(VA2) do { \
              \
            PG8_LDB(B0, 0, 0); PG8_LDB(B1, 0, 1); PG8_SCHED; PG8_LDA(At, 0, 0); PG8_STAGE(PG8_SA(1, 1), a1, cvo[1]); \
            PG8_WAIT_V(8); PG8_WAIT_L(0); PG8_BAR; PG8_MMA(0, 0, At, B0); PG8_MMA(0, 1, At, B1); PG8_BAR; PG8_SCHED; \
              \
            PG8_LDA(At, 0, 1); PG8_STAGE(PG8_SB(0, 0), b2, voffB); PG8_STAGE(PG8_SB(0, 1), b2 + hstepB, voffB); PG8_STAGE(PG8_SA(0, 0), a2, VA2[0]); \
            PG8_WAIT_V(8); PG8_WAIT_L(0); PG8_BAR; PG8_MMA(1, 0, At, B0); PG8_MMA(1, 1, At, B1); PG8_BAR; PG8_SCHED; \
              \
            PG8_LDB(B0, 1, 0); PG8_LDB(B1, 1, 1); PG8_SCHED; PG8_LDA(At, 1, 0); PG8_STAGE(PG8_SA(0, 1), a2, VA2[1]); \
            PG8_WAIT_V(8); PG8_WAIT_L(0); PG8_BAR; PG8_MMA(0, 0, At, B0); PG8_MMA(0, 1, At, B1); PG8_BAR; PG8_SCHED; \
              \
            PG8_LDA(At, 1, 1); PG8_STAGE(PG8_SB(1, 0), b3, voffB); PG8_STAGE(PG8_SB(1, 1), b3 + hstepB, voffB); PG8_STAGE(PG8_SA(1, 0), a3, VA2[0]); \
            PG8_WAIT_V(8); PG8_WAIT_L(0); PG8_BAR; PG8_MMA(1, 0, At, B0); PG8_MMA(1, 1, At, B1); PG8_BAR; PG8_SCHED; } while (0)
        for (int t = 0; t < nt - 2; t += 2) {
            const char* a1 = cA + (size_t)(t + 1) * kstepA; const char* a2 = cA + (size_t)(t + 2) * kstepA; const char* b2 = cB + (size_t)(t + 2) * kstepB;
            const char* a3 = a2 + kstepA; const char* b3 = b2 + kstepB;
            PG8_KBODY(cvo);
        }
        unsigned nv[2][2];
        {
            if (has_next) {
                int l2_; asm volatile("v_mbcnt_lo_u32_b32 %0, -1, 0\n\tv_mbcnt_hi_u32_b32 %0, -1, %0" : "=v"(l2_)); int R2[2], C2[2];
#pragma unroll
                for (int i = 0; i < 2; ++i) stage_rc((wid * 64 + l2_) * 16 + i * 8192, R2[i], C2[i]);
                P.a_offs(nxt, R2, C2, nv, lds, wid * 64 + l2_);
            } else {
#pragma unroll
                for (int h = 0; h < 2; ++h)
#pragma unroll
                    for (int i = 0; i < 2; ++i) nv[h][i] = cvo[h][i]; }
            const char* a1 = cA + (size_t)(nt - 1) * kstepA; const char* a2 = nA; const char* b2 = nB; const char* a3 = a2 + kstepA; const char* b3 = b2 + kstepB;
            PG8_KBODY(nv);
        }
#undef PG8_KBODY
        asm volatile("s_nop 7\n\ts_nop 7\n\ts_nop 7" ::: "memory");
        if (wr == 0) PG8_BAR;
        { int l3_; asm volatile("v_mbcnt_lo_u32_b32 %0, -1, 0\n\tv_mbcnt_hi_u32_b32 %0, -1, %0" : "=v"(l3_));
          E(acc, cur, wr, wc, l3_ & 15, l3_ >> 4); }
        if (!has_next) break;
#pragma unroll
        for (int a = 0; a < 2; ++a)
#pragma unroll
            for (int b = 0; b < 2; ++b)
#pragma unroll
                for (int m = 0; m < 4; ++m)
#pragma unroll
                    for (int n = 0; n < 2; ++n) acc[a][b][m][n] = (f32x4){0.f, 0.f, 0.f, 0.f};
        cur = nxt; cA = nA; cB = nB; ++ui;
#pragma unroll
        for (int h = 0; h < 2; ++h)
#pragma unroll
            for (int i = 0; i < 2; ++i) cvo[h][i] = nv[h][i];
        if (wr == 1) PG8_BAR;
    }
    PG8_WAIT_V(0);
    PG8_BAR;
#undef PG8_SA
#undef PG8_SB
#undef PG8_STAGE
#undef PG8_LDA
#undef PG8_LDB
#undef PG8_MMA
#undef PG8_LD2
#undef PG8_WAIT_V
#undef PG8_WAIT_L
#undef PG8_BAR
#undef PG8_SCHED
}
}

namespace att {
constexpr int NW = 8, QBLK = 32, KVBLK = 64;
constexpr float SCALE = 0.088388347648318440f;
constexpr float THR = 8.f;
constexpr int LDQ = NQKV, LDK = NQKV, LDO = D;
constexpr int SHM_V = KVBLK * HD * 2, SHM_K = KVBLK * HD * 2, SHM_ATTN = 2 * SHM_V + 2 * SHM_K + NW * 64 * 4;
#define KSWZ(row, colB) ((row) * 256 + ((colB) ^ (((row) & 7) << 4)))
#define SBAR() __builtin_amdgcn_sched_barrier(0)
__device__ __forceinline__ int crow(int r, int hi) { return (r & 3) + 8 * (r >> 2) + 4 * hi; }
__device__ __forceinline__ void partialSM(f32x16& p0, f32x16& p1, float& m_reg, float& mn, float& alpha) {
    constexpr float C = 1.0f;
    float pmax = p0[0];
#pragma unroll
    for (int r = 1; r < 16; ++r) pmax = fmaxf(pmax, p0[r]);
#pragma unroll
    for (int r = 0; r < 16; ++r) pmax = fmaxf(pmax, p1[r]);
    { auto rr = __builtin_amdgcn_permlane32_swap(__float_as_uint(pmax), __float_as_uint(pmax), false, false);
      pmax = fmaxf(__uint_as_float(rr[0]), __uint_as_float(rr[1])); }
    if (__builtin_expect(__all(pmax - m_reg <= THR * 1.4426950408889634f), 1)) { mn = m_reg; alpha = 1.f; }
    else { mn = fmaxf(m_reg, pmax); alpha = __builtin_amdgcn_exp2f((m_reg - mn) * C); m_reg = mn; }
    const float mnC = -mn * C;
#pragma unroll
    for (int r = 0; r < 16; ++r) p0[r] = fmaf(p0[r], C, mnC);
#pragma unroll
    for (int r = 0; r < 16; ++r) p1[r] = fmaf(p1[r], C, mnC);
#pragma unroll
    for (int r = 0; r < 16; ++r) p0[r] = __builtin_amdgcn_exp2f(p0[r]);
}
__device__ __forceinline__ void finishSM(f32x16& p0, f32x16& p1, float alpha, float& l_reg, bf16x8& pa0, bf16x8& pa1, bf16x8& pa2, bf16x8& pa3) {
#pragma unroll
    for (int r = 0; r < 16; ++r) p1[r] = __builtin_amdgcn_exp2f(p1[r]);
    float ps = 0;
#pragma unroll
    for (int r = 0; r < 16; ++r) ps += p0[r];
#pragma unroll
    for (int r = 0; r < 16; ++r) ps += p1[r];
    { auto rr = __builtin_amdgcn_permlane32_swap(__float_as_uint(ps), __float_as_uint(ps), false, false);
      ps = __uint_as_float(rr[0]) + __uint_as_float(rr[1]); }
    l_reg = l_reg * alpha + ps;
#define PK4(P, BASE, OUT) do { unsigned a0 = cvt_pk_bf16(P[BASE + 0], P[BASE + 1]), a1 = cvt_pk_bf16(P[BASE + 2], P[BASE + 3]);   \
    unsigned b0 = cvt_pk_bf16(P[BASE + 4], P[BASE + 5]), b1 = cvt_pk_bf16(P[BASE + 6], P[BASE + 7]);                              \
    auto r0 = __builtin_amdgcn_permlane32_swap(a0, b0, false, false); auto r1 = __builtin_amdgcn_permlane32_swap(a1, b1, false, false); \
    v4u w = {r0[0], r1[0], r0[1], r1[1]}; OUT = *reinterpret_cast<bf16x8*>(&w); } while (0)
    PK4(p0, 0, pa0); PK4(p0, 8, pa1); PK4(p1, 0, pa2); PK4(p1, 8, pa3);
#undef PK4
}
__device__ __forceinline__ void qkt(f32x16& p0, f32x16& p1, const LAS char* Ks, const bf16x8* qr, int r32, int hi) {
    p0 = f32x16{}; p1 = f32x16{};
#pragma unroll
    for (int d0 = 0; d0 < 8; ++d0) {
        const int a4 = r32 * 256 + ((((d0 & 3) * 32) + hi * 16) ^ ((r32 & 7) << 4));
        const bf16x8 b0 = *reinterpret_cast<const LAS bf16x8*>(Ks + a4 + (d0 >> 2) * 128);
        const bf16x8 b1 = *reinterpret_cast<const LAS bf16x8*>(Ks + a4 + (d0 >> 2) * 128 + 8192);
        p0 = __builtin_amdgcn_mfma_f32_32x32x16_bf16(b0, qr[d0], p0, 0, 0, 0);
        p1 = __builtin_amdgcn_mfma_f32_32x32x16_bf16(b1, qr[d0], p1, 0, 0, 0); }
}
__device__ __forceinline__ int v_st(int k, int c) { const int kk = (k & ~0xC) | ((k & 4) << 1) | ((k & 8) >> 1); return ((kk >> 3) * 4 + (c >> 5)) * 512 + ((kk & 7) * 32 + (c & 31)) * 2; }
__device__ __forceinline__ int v_rd_base(int lane) { return ((lane & 3) << 3) | (((lane >> 2) & 3) << 6) | (((lane >> 4) & 1) << 5) | (((lane >> 5) & 1) << 8); }
constexpr int v_rd_off(int d0, int ks, int half) { return d0 * 512 + ks * 4096 + half * 2048; }
template <int OFF> __device__ __forceinline__ s16x4 tr_read(int vb) {
    s16x4 r; asm volatile("ds_read_b64_tr_b16 %0, %1 offset:%2" : "=&v"(r) : "v"(vb), "i"(OFF) : "memory"); return r;
}
template <int D0> __device__ __forceinline__ void pv_one(f32x16& od, int vb, bf16x8 pa0, bf16x8 pa1, bf16x8 pa2, bf16x8 pa3) {
    const s16x4 l0 = tr_read<v_rd_off(D0, 0, 0)>(vb), h0 = tr_read<v_rd_off(D0, 0, 1)>(vb), l1 = tr_read<v_rd_off(D0, 1, 0)>(vb), h1 = tr_read<v_rd_off(D0, 1, 1)>(vb);
    const s16x4 l2 = tr_read<v_rd_off(D0, 2, 0)>(vb), h2 = tr_read<v_rd_off(D0, 2, 1)>(vb), l3 = tr_read<v_rd_off(D0, 3, 0)>(vb), h3 = tr_read<v_rd_off(D0, 3, 1)>(vb);
    asm volatile("s_waitcnt lgkmcnt(0)" ::: "memory"); SBAR();
#define PK(L, H) (bf16x8){L[0], L[1], L[2], L[3], H[0], H[1], H[2], H[3]}
    od = __builtin_amdgcn_mfma_f32_32x32x16_bf16(pa0, PK(l0, h0), od, 0, 0, 0);
    od = __builtin_amdgcn_mfma_f32_32x32x16_bf16(pa1, PK(l1, h1), od, 0, 0, 0);
    od = __builtin_amdgcn_mfma_f32_32x32x16_bf16(pa2, PK(l2, h2), od, 0, 0, 0);
    od = __builtin_amdgcn_mfma_f32_32x32x16_bf16(pa3, PK(l3, h3), od, 0, 0, 0);
#undef PK
}
__device__ __forceinline__ void pv_d0(f32x16* o, int vb, bf16x8 pa0, bf16x8 pa1, bf16x8 pa2, bf16x8 pa3) {
    pv_one<0>(o[0], vb, pa0, pa1, pa2, pa3); pv_one<1>(o[1], vb, pa0, pa1, pa2, pa3); pv_one<2>(o[2], vb, pa0, pa1, pa2, pa3); pv_one<3>(o[3], vb, pa0, pa1, pa2, pa3);
}
__device__ __forceinline__ void attn_dense_body(const bf16* __restrict__ Qb, const bf16* __restrict__ Kh, const bf16* __restrict__ Vh, bf16* __restrict__ Ob, int seq, LAS char* lds, const int wid) {
    const int lane = fresh_lane(), tid = wid * 64 + lane, r32 = lane & 31, hi = lane >> 5;
    LAS char* V_lds = lds; LAS char* K_lds = lds + 2 * SHM_V;
    LAS float* ws = (LAS float*)(lds + 2 * SHM_V + 2 * SHM_K) + wid * 64; LAS float* li_l = ws; LAS float* al_l = ws + 32;
    float m_reg = -1e30f, l_reg = 0; f32x16 o[4] = {}; bf16x8 qr[8];
    const bf16* Qw = Qb + (long)(wid * QBLK + r32) * LDQ + hi * 8;
#pragma unroll
    for (int d0 = 0; d0 < 8; ++d0) qr[d0] = *reinterpret_cast<const bf16x8*>(Qw + d0 * 16);
    const int sr = tid >> 4, sc = (tid & 15) * 8, vst0 = v_st(sr, sc), vst1 = v_st(32 + sr, sc);
    const int vb0 = (int)(unsigned)(uintptr_t)V_lds + v_rd_base(lane);
    struct { bf16x8 vs0, vs1, ks0, ks1; } sr_[2];
#define SLOAD(i, k0) do { sr_[i].vs0 = *reinterpret_cast<const bf16x8*>(&Vh[(long)((k0) + sr) * LDK + sc]); sr_[i].vs1 = *reinterpret_cast<const bf16x8*>(&Vh[(long)((k0) + 32 + sr) * LDK + sc]); \
    sr_[i].ks0 = *reinterpret_cast<const bf16x8*>(&Kh[(long)((k0) + sr) * LDK + sc]); sr_[i].ks1 = *reinterpret_cast<const bf16x8*>(&Kh[(long)((k0) + 32 + sr) * LDK + sc]); } while (0)
#define SWRITE(b, i) do { *(LAS bf16x8*)(V_lds + (b) * SHM_V + vst0) = sr_[i].vs0;          \
    *(LAS bf16x8*)(V_lds + (b) * SHM_V + vst1) = sr_[i].vs1; const int kc = sc * 2;               \
    *(LAS bf16x8*)(K_lds + (b) * SHM_K + KSWZ(sr, kc)) = sr_[i].ks0;                       \
    *(LAS bf16x8*)(K_lds + (b) * SHM_K + KSWZ(32 + sr, kc)) = sr_[i].ks1; } while (0)
#define SWAIT() asm volatile("s_waitcnt vmcnt(4)" ::: "memory")
#define RESC(a) do { if (__any((a) < 1.f)) { if (hi == 0) al_l[r32] = (a); asm volatile("s_waitcnt lgkmcnt(0)" ::: "memory"); \
    _Pragma("unroll") for (int d = 0; d < 4; ++d) _Pragma("unroll") for (int r = 0; r < 16; ++r) o[d][r] *= al_l[crow(r, hi)]; } } while (0)
    f32x16 pA0, pA1, pB0, pB1; float mnA, mnB, alA, alB; bf16x8 pa0, pa1, pa2, pa3; const int NT = seq / KVBLK;
    constexpr int SE = 0, SO = 1;
    SLOAD(SE, 0); asm volatile("s_waitcnt vmcnt(0)" ::: "memory"); SWRITE(0, SE); __syncthreads();
    qkt(pA0, pA1, K_lds, qr, r32, hi); partialSM(pA0, pA1, m_reg, mnA, alA);
    SLOAD(SO, KVBLK); if (2 < NT) SLOAD(SE, 2 * KVBLK);
    SWAIT(); SWRITE(1, SO); __syncthreads();
    for (int j = 1; j + 1 < NT; j += 2) {
        SBAR(); qkt(pB0, pB1, K_lds + SHM_K, qr, r32, hi);
        finishSM(pA0, pA1, alA, l_reg, pa0, pa1, pa2, pa3); SBAR();
        SLOAD(SO, (j + 2) * KVBLK); SBAR();
        pv_d0(o, vb0, pa0, pa1, pa2, pa3); partialSM(pB0, pB1, m_reg, mnB, alB);
        __syncthreads(); SWAIT(); SWRITE(0, SE);
        RESC(alB); __syncthreads();
        SBAR(); qkt(pA0, pA1, K_lds, qr, r32, hi);
        finishSM(pB0, pB1, alB, l_reg, pa0, pa1, pa2, pa3); SBAR();
        if (j + 3 < NT) SLOAD(SE, (j + 3) * KVBLK); SBAR();
        pv_d0(o, vb0 + (int)SHM_V, pa0, pa1, pa2, pa3); partialSM(pA0, pA1, m_reg, mnA, alA);
        __syncthreads(); SWAIT(); SWRITE(1, SO);
        RESC(alA); __syncthreads();
    }
    SBAR(); qkt(pB0, pB1, K_lds + SHM_K, qr, r32, hi);
    finishSM(pA0, pA1, alA, l_reg, pa0, pa1, pa2, pa3); SBAR();
    pv_d0(o, vb0, pa0, pa1, pa2, pa3); partialSM(pB0, pB1, m_reg, mnB, alB);
    __syncthreads(); RESC(alB);
    finishSM(pB0, pB1, alB, l_reg, pa0, pa1, pa2, pa3); SBAR();
    pv_d0(o, vb0 + (int)SHM_V, pa0, pa1, pa2, pa3);
    if (hi == 0) li_l[r32] = l_reg; asm volatile("s_waitcnt lgkmcnt(0)" ::: "memory");
    float rli[16];
#pragma unroll
    for (int r = 0; r < 16; ++r) rli[r] = __builtin_amdgcn_rcpf(li_l[crow(r, hi)]);
    bf16* Ow = Ob + (long)(wid * QBLK) * LDO;
#pragma unroll
    for (int r = 0; r < 16; ++r) { const int orow = crow(r, hi);
#pragma unroll
        for (int d0 = 0; d0 < 4; ++d0) { const float v = o[d0][r] * rli[r]; Ow[(long)orow * LDO + d0 * 32 + r32] = (bf16)(cvt_pk_bf16(v, v) & 0xffffu); } }
    __syncthreads();
#undef SLOAD
#undef SWRITE
#undef SWAIT
#undef RESC
}

}


struct WConv { const float* w_gu; const float* w_down; unsigned char* Wgu8; unsigned char* Wd8; };
constexpr int WQ_GU = 64 * 64 * 4, WQ_D = 64 * 64 * 2, WQ_N = WQ_GU + WQ_D;
__device__ __forceinline__ void wquad_src(const WConv& W, int q, int tid, const float*& src  , int& N) {
    if (q < WQ_GU) { N = 2048; src = W.w_gu + (size_t)(q >> 8) * (1024 * 2048) + (size_t)(16 * ((q >> 2) & 63)) * 2048 + 512 * (q & 3); }
    else { q -= WQ_GU; N = 1024; src = W.w_down + (size_t)(q >> 7) * (1024 * 1024) + (size_t)(16 * ((q >> 1) & 63)) * 1024 + 512 * (q & 1); }
}
__device__ __forceinline__ unsigned char* wquad_dst(const WConv& W, int q, int tid) {
    if (q < WQ_GU) { const int n = 512 * (q & 3) + tid, j = n & 1023, np = 256 * (j >> 7) + 128 * (n >> 10) + (j & 127), c = np & 31, rho = 16 * ((c >> 2) & 1) + 4 * (c >> 3) + (c & 3);
        return W.Wgu8 + (size_t)(q >> 8) * (2048 * 1024) + ((size_t)((q >> 2) & 63) * 2048 + (np & ~31) + rho) * 16; }
    q -= WQ_GU; { const int n = 512 * (q & 1) + tid, c = n & 31, rho = 16 * ((c >> 2) & 1) + 4 * (c >> 3) + (c & 3);
        return W.Wd8 + (size_t)(q >> 7) * (1024 * 1024) + ((size_t)((q >> 1) & 63) * 1024 + (n & ~31) + rho) * 16; }
}
__device__ __forceinline__ unsigned wquad_cvt(float a, float b, float c, float d) {
    int w_; const float isc = 1.0f / WSCALE;
    asm volatile("v_cvt_scalef32_pk_fp8_f32 %0, %1, %2, %3" : "=v"(w_) : "v"(a), "v"(b), "s"(isc));
    asm volatile("v_cvt_scalef32_pk_fp8_f32 %0, %1, %2, %3 op_sel:[0,0,0,1]" : "+v"(w_) : "v"(c), "v"(d), "s"(isc));
    return (unsigned)w_;
}
__device__ __forceinline__ void wquad_whole(const WConv& W, int q, int tid) {
    const float* src; int N; wquad_src(W, q, tid, src, N); float r[16];
#pragma unroll
    for (int i = 0; i < 16; ++i) r[i] = src[(size_t)i * N + tid];
    v4u o; o.x = wquad_cvt(r[0], r[1], r[2], r[3]); o.y = wquad_cvt(r[4], r[5], r[6], r[7]); o.z = wquad_cvt(r[8], r[9], r[10], r[11]); o.w = wquad_cvt(r[12], r[13], r[14], r[15]);
    *(v4u*)wquad_dst(W, q, tid) = o;
}

namespace att8 {
constexpr int TB = 8192, NB = 8, VOFF = NB * TB;
static_assert((NTOK / 64) % 8 == 4 && 2 * NB * TB <= 131072, "attn_fp8_body: 4 peeled tiles + whole groups of 8; 8 buffers in the ring");
#define MF8Z(Dd, A, Bv) do { if (VAR != 2) asm volatile("v_mfma_f32_32x32x64_f8f6f4 %0, %1, %2, 0" : "=&v"(Dd) : "v"(A), "v"(Bv)); else asm volatile("v_mov_b32 %0, 0" : "=v"(Dd[0]) : "v"(A), "v"(Bv)); } while (0)
#define MF8(Dd, A, Bv) do { if (VAR != 2) asm volatile("v_mfma_f32_32x32x64_f8f6f4 %0, %1, %2, %0" : "+v"(Dd) : "v"(A), "v"(Bv)); else asm volatile("" : "+v"(Dd) : "v"(A), "v"(Bv)); } while (0)
#define MFP(Dd, A, Bv) do { if (VAR != 2) asm volatile("v_mfma_f32_32x32x64_f8f6f4 %0, %1, %2, %0 cbsz:1" : "+v"(Dd) : "v"(A), "v"(Bv)); else asm volatile("" : "+v"(Dd) : "v"(A), "v"(Bv)); } while (0)
#define FEXP(x) do { if (VAR != 1) asm volatile("v_exp_f32_e32 %0, %0" : "+v"(x)); } while (0)
#define FADD(acc, x) do { if (VAR != 1) asm volatile("v_add_f32_e32 %0, %0, %1" : "+v"(acc) : "v"(x)); } while (0)
#define CVLO(w, a, b) do { if (VAR != 1) asm volatile("v_cvt_scalef32_pk_bf8_f32 %0, %1, %2, %3" : "=v"(w) : "v"(a), "v"(b), "s"(pscale)); else w = 0; } while (0)
#define CVHI(w, a, b) do { if (VAR != 1) asm volatile("v_cvt_scalef32_pk_bf8_f32 %0, %1, %2, %3 op_sel:[0,0,0,1]" : "+v"(w) : "v"(a), "v"(b), "s"(pscale)); } while (0)
__device__ __forceinline__ v8i ld32(const LAS unsigned char* p0, const LAS unsigned char* p1) { const v4i a = *(const LAS v4i*)p0, b = *(const LAS v4i*)p1; return __builtin_shufflevector(a, b, 0, 1, 2, 3, 4, 5, 6, 7); }
__device__ __forceinline__ void softmax8(f32x16& PC0, f32x16& PC1, float& l0, float& l1, v8i& pa, const float pscale) {
    constexpr int VAR = 0;
    int w0, w1, w2, w3, w4, w5, w6, w7;
    FEXP(PC0[0]); FEXP(PC0[1]); FEXP(PC0[2]); FEXP(PC0[3]); FADD(l0, PC0[0]); FEXP(PC0[4]); FADD(l1, PC0[1]); FEXP(PC0[5]); FADD(l0, PC0[2]); FEXP(PC0[6]); FADD(l1, PC0[3]); FEXP(PC0[7]); FADD(l0, PC0[4]); FEXP(PC0[8]); FADD(l1, PC0[5]); FEXP(PC0[9]); FADD(l0, PC0[6]); FEXP(PC0[10]); FADD(l1, PC0[7]); FEXP(PC0[11]); FADD(l0, PC0[8]); FEXP(PC0[12]); FADD(l1, PC0[9]); FEXP(PC0[13]); FADD(l0, PC0[10]); FEXP(PC0[14]); FADD(l1, PC0[11]); FEXP(PC0[15]); FADD(l0, PC0[12]); FEXP(PC1[0]); FADD(l1, PC0[13]); FEXP(PC1[1]); FADD(l0, PC0[14]); FEXP(PC1[2]); FADD(l1, PC0[15]); FEXP(PC1[3]); FADD(l0, PC1[0]); FEXP(PC1[4]); FADD(l1, PC1[1]); FEXP(PC1[5]); FADD(l0, PC1[2]); FEXP(PC1[6]); FADD(l1, PC1[3]); FEXP(PC1[7]); FADD(l0, PC1[4]); FEXP(PC1[8]); FADD(l1, PC1[5]); FEXP(PC1[9]); FADD(l0, PC1[6]); FEXP(PC1[10]); FADD(l1, PC1[7]); FEXP(PC1[11]); FADD(l0, PC1[8]); FEXP(PC1[12]); FADD(l1, PC1[9]); FEXP(PC1[13]); FADD(l0, PC1[10]); FEXP(PC1[14]); FADD(l1, PC1[11]); FEXP(PC1[15]); FADD(l0, PC1[12]); FADD(l1, PC1[13]); FADD(l0, PC1[14]); FADD(l1, PC1[15]); CVLO(w0, PC0[0], PC0[1]); CVHI(w0, PC0[2], PC0[3]); CVLO(w1, PC0[4], PC0[5]); CVHI(w1, PC0[6], PC0[7]); CVLO(w2, PC0[8], PC0[9]); CVHI(w2, PC0[10], PC0[11]); CVLO(w3, PC0[12], PC0[13]); CVHI(w3, PC0[14], PC0[15]); CVLO(w4, PC1[0], PC1[1]); CVHI(w4, PC1[2], PC1[3]); CVLO(w5, PC1[4], PC1[5]); CVHI(w5, PC1[6], PC1[7]); CVLO(w6, PC1[8], PC1[9]); CVHI(w6, PC1[10], PC1[11]); CVLO(w7, PC1[12], PC1[13]); CVHI(w7, PC1[14], PC1[15]);
    pa = (v8i){w0, w1, w2, w3, w4, w5, w6, w7};
}
template <int VAR> __device__ __forceinline__ void attn_fp8_body(const unsigned char* __restrict__ Qb, const unsigned char* __restrict__ Kh, const unsigned char* __restrict__ Vth, bf16* __restrict__ Ob,
                                              int NT, LAS unsigned char* lds, const int wid, const float pscale_in, const WConv& wc, const int wq0, const int wqs) {
    const int lane = fresh_lane(), tid = wid * 64 + lane, r32 = lane & 31, hi = lane >> 5;
    float l0 = 0.f, l1 = 0.f; f32x16 o[4] = {}; v8i qr[2];
    { const unsigned char* qp = Qb + (size_t)(wid * 32 + r32) * D + 32 * hi;
#pragma unroll
      for (int s_ = 0; s_ < 2; ++s_) { const v4i a = *(const v4i*)(qp + 64 * s_), b = *(const v4i*)(qp + 64 * s_ + 16); qr[s_] = __builtin_shufflevector(a, b, 0, 1, 2, 3, 4, 5, 6, 7); } }
    const float pscale = __uint_as_float(__builtin_amdgcn_readfirstlane(__float_as_uint(pscale_in)));
    const int kx = (r32 >> 1) & 7, vx = (r32 >> 2) & 3;
    int ka[2][2], va[2];
#pragma unroll
    for (int s_ = 0; s_ < 2; ++s_)
#pragma unroll
        for (int c = 0; c < 2; ++c) ka[s_][c] = r32 * 128 + (((4 * s_ + 2 * hi + c) ^ kx) << 4);
#pragma unroll
    for (int c = 0; c < 2; ++c) va[c] = VOFF + r32 * 64 + (((2 * hi + c) ^ vx) << 4);
    const int skey = tid >> 3, sch = tid & 7, sd = tid >> 2, svc = tid & 3;
    const int lw = (int)(unsigned)(uintptr_t)lds;
    const int kst = lw + skey * 128 + ((sch ^ ((skey >> 1) & 7)) << 4), vst = lw + VOFF + sd * 64 + ((svc ^ ((sd >> 2) & 3)) << 4);
    const __amdgpu_buffer_rsrc_t krs = __builtin_amdgcn_make_buffer_rsrc((void*)Kh, 0, 0x7fffffff, 0x00020000);
    const __amdgpu_buffer_rsrc_t vrs = __builtin_amdgcn_make_buffer_rsrc((void*)Vth, 0, 0x7fffffff, 0x00020000);
    const int kgo = skey * (NKV * HD) + sch * 16, vgo = tid * 16; int kso = 0, vso = 0;
    v4i ks, vs;
#define FLOAD() do { ks = __builtin_bit_cast(v4i, __builtin_amdgcn_raw_buffer_load_b128(krs, kgo, kso, 0)); vs = __builtin_bit_cast(v4i, __builtin_amdgcn_raw_buffer_load_b128(vrs, vgo, vso, 0)); \
        if (kso < (NT - 1) * 64 * NKV * HD) { kso += 64 * NKV * HD; vso += 8192; } } while (0)
#define DSW(addr, val, OFF) asm volatile("ds_write_b128 %0, %1 offset:%2" :: "v"(addr), "v"(val), "i"(OFF) : "memory")
#define FWRITE(B) do { DSW(kst, ks, (B) * TB); DSW(vst, vs, (B) * TB); } while (0)
#define KF(B, kb, s_) ((VAR == 5) ? qr[0] : ld32(lds + (B) * TB + (kb) * 4096 + ka[s_][0], lds + (B) * TB + (kb) * 4096 + ka[s_][1]))
#define VF(B, d0) ((VAR == 5) ? qr[1] : ld32(lds + (B) * TB + (d0) * 2048 + va[0], lds + (B) * TB + (d0) * 2048 + va[1]))
    f32x16 pA0, pA1, pB0, pB1; v8i paX, paY; float wrow[16] = {}; unsigned wd0 = 0, wd1 = 0, wd2 = 0;
    FLOAD(); asm volatile("s_waitcnt vmcnt(0)" ::: "memory"); FWRITE(0);
    FLOAD(); asm volatile("s_waitcnt vmcnt(0)" ::: "memory"); FWRITE(1);
    FLOAD(); asm volatile("s_waitcnt vmcnt(0)" ::: "memory"); FWRITE(2);
    FLOAD();
    asm volatile("s_waitcnt lgkmcnt(0)" ::: "memory"); __syncthreads();
    { const v8i k00 = KF(0, 0, 0), k10 = KF(0, 1, 0), k01 = KF(0, 0, 1), k11 = KF(0, 1, 1);
      MF8Z(pA0, k00, qr[0]); MF8Z(pA1, k10, qr[0]); MF8(pA0, k01, qr[1]); MF8(pA1, k11, qr[1]); }
#define FSTEP(PC0, PC1, PN0, PN1, PCUR, PPRV, J, T8, B, EM) do { \
        if (VAR != 6) { if ((J) + 3 < NT) FWRITE(((T8) + 3) & 7); \
        FLOAD(); } __builtin_amdgcn_sched_barrier(0); \
        if (VAR != 3) {   \
          const unsigned dw_ = wquad_cvt(wrow[4 * (B)], wrow[4 * (B) + 1], wrow[4 * (B) + 2], wrow[4 * (B) + 3]); \
          if ((B) == 0) wd0 = dw_; else if ((B) == 1) wd1 = dw_; else if ((B) == 2) wd2 = dw_; \
          else if (EM) { v4u o_ = {wd0, wd1, wd2, dw_}; *(v4u*)wquad_dst(wc, (wq0 + (((J) >> 2) - 1) * wqs) % WQ_N, tid) = o_; } \
          const float* src_; int N_; wquad_src(wc, (wq0 + ((J) >> 2) * wqs) % WQ_N, tid, src_, N_); \
          _Pragma("unroll") for (int i_ = 0; i_ < 4; ++i_) wrow[4 * (B) + i_] = src_[(size_t)(4 * (B) + i_) * N_ + tid]; } \
        __builtin_amdgcn_sched_barrier(0); \
        { int w0, w1, w2, w3, w4, w5, w6, w7; const bool qk_ = (J) + 1 < NT, pv_ = (J) > 0; \
            \
          v8i kA = KF(((T8) + 1) & 7, 0, 0), vA = VF(((T8) + 7) & 7, 0), kB, vB; \
          __builtin_amdgcn_sched_barrier(0); \
          kB = KF(((T8) + 1) & 7, 1, 0); vB = VF(((T8) + 7) & 7, 1); \
          if (qk_) MF8Z(PN0, kA, qr[0]);       G0(PC0, PC1) \
          if (pv_) MFP(o[0], PPRV, vA);        G1(PC0, PC1) \
          __builtin_amdgcn_sched_barrier(0); \
          kA = KF(((T8) + 1) & 7, 0, 1); vA = VF(((T8) + 7) & 7, 2); \
          if (qk_) MF8Z(PN1, kB, qr[0]);       G2(PC0, PC1) \
          if (pv_) MFP(o[1], PPRV, vB);        G3(PC0, PC1) \
          __builtin_amdgcn_sched_barrier(0); \
          kB = KF(((T8) + 1) & 7, 1, 1); vB = VF(((T8) + 7) & 7, 3); \
          if (qk_) MF8(PN0, kA, qr[1]);        G4(PC0, PC1) \
          if (pv_) MFP(o[2], PPRV, vA);        G5(PC0, PC1) \
          __builtin_amdgcn_sched_barrier(0); \
          if (qk_) MF8(PN1, kB, qr[1]);        G6(PC0, PC1) \
          if (pv_) MFP(o[3], PPRV, vB);        G7(PC0, PC1) \
          PCUR = (v8i){w0, w1, w2, w3, w4, w5, w6, w7}; } \
        if ((T8) & 1) { asm volatile("s_waitcnt lgkmcnt(0)" ::: "memory"); if (VAR != 4) __syncthreads(); } } while (0)
#define G0(PC0, PC1) FEXP(PC0[0]); FEXP(PC0[1]); FEXP(PC0[2]); FEXP(PC0[3]); FADD(l0, PC0[0]); FEXP(PC0[4]); FADD(l1, PC0[1]); FEXP(PC0[5]); FADD(l0, PC0[2]); FEXP(PC0[6]);
#define G1(PC0, PC1) FADD(l1, PC0[3]); FEXP(PC0[7]); FADD(l0, PC0[4]); FEXP(PC0[8]); FADD(l1, PC0[5]); FEXP(PC0[9]); FADD(l0, PC0[6]); FEXP(PC0[10]); FADD(l1, PC0[7]); FEXP(PC0[11]);
#define G2(PC0, PC1) FADD(l0, PC0[8]); FEXP(PC0[12]); FADD(l1, PC0[9]); FEXP(PC0[13]); FADD(l0, PC0[10]); FEXP(PC0[14]); FADD(l1, PC0[11]); FEXP(PC0[15]); FADD(l0, PC0[12]); FEXP(PC1[0]);
#define G3(PC0, PC1) FADD(l1, PC0[13]); FEXP(PC1[1]); FADD(l0, PC0[14]); FEXP(PC1[2]); FADD(l1, PC0[15]); FEXP(PC1[3]); FADD(l0, PC1[0]); FEXP(PC1[4]); FADD(l1, PC1[1]); FEXP(PC1[5]);
#define G4(PC0, PC1) FADD(l0, PC1[2]); FEXP(PC1[6]); FADD(l1, PC1[3]); FEXP(PC1[7]); FADD(l0, PC1[4]); FEXP(PC1[8]); FADD(l1, PC1[5]); FEXP(PC1[9]); FADD(l0, PC1[6]); FEXP(PC1[10]);
#define G5(PC0, PC1) FADD(l1, PC1[7]); FEXP(PC1[11]); FADD(l0, PC1[8]); FEXP(PC1[12]); FADD(l1, PC1[9]); FEXP(PC1[13]); FADD(l0, PC1[10]); FEXP(PC1[14]); FADD(l1, PC1[11]); FEXP(PC1[15]);
#define G6(PC0, PC1) FADD(l0, PC1[12]); FADD(l1, PC1[13]); FADD(l0, PC1[14]); FADD(l1, PC1[15]); CVLO(w0, PC0[0], PC0[1]); CVHI(w0, PC0[2], PC0[3]); CVLO(w1, PC0[4], PC0[5]); CVHI(w1, PC0[6], PC0[7]); CVLO(w2, PC0[8], PC0[9]); CVHI(w2, PC0[10], PC0[11]);
#define G7(PC0, PC1) CVLO(w3, PC0[12], PC0[13]); CVHI(w3, PC0[14], PC0[15]); CVLO(w4, PC1[0], PC1[1]); CVHI(w4, PC1[2], PC1[3]); CVLO(w5, PC1[4], PC1[5]); CVHI(w5, PC1[6], PC1[7]); CVLO(w6, PC1[8], PC1[9]); CVHI(w6, PC1[10], PC1[11]); CVLO(w7, PC1[12], PC1[13]); CVHI(w7, PC1[14], PC1[15]);
    FSTEP(pA0, pA1, pB0, pB1, paX, paY, 0, 0, 0, 0); FSTEP(pB0, pB1, pA0, pA1, paY, paX, 1, 1, 1, 0); FSTEP(pA0, pA1, pB0, pB1, paX, paY, 2, 2, 2, 0); FSTEP(pB0, pB1, pA0, pA1, paY, paX, 3, 3, 3, 0);
    for (int j = 4; j < NT; j += 8) {
        FSTEP(pA0, pA1, pB0, pB1, paX, paY, j, 4, 0, 1); FSTEP(pB0, pB1, pA0, pA1, paY, paX, j + 1, 5, 1, 1); FSTEP(pA0, pA1, pB0, pB1, paX, paY, j + 2, 6, 2, 1); FSTEP(pB0, pB1, pA0, pA1, paY, paX, j + 3, 7, 3, 1);
        FSTEP(pA0, pA1, pB0, pB1, paX, paY, j + 4, 0, 0, 1); FSTEP(pB0, pB1, pA0, pA1, paY, paX, j + 5, 1, 1, 1); FSTEP(pA0, pA1, pB0, pB1, paX, paY, j + 6, 2, 2, 1); FSTEP(pB0, pB1, pA0, pA1, paY, paX, j + 7, 3, 3, 1); }
    {
        v4u o_ = {wquad_cvt(wrow[0], wrow[1], wrow[2], wrow[3]), wquad_cvt(wrow[4], wrow[5], wrow[6], wrow[7]), wquad_cvt(wrow[8], wrow[9], wrow[10], wrow[11]), wquad_cvt(wrow[12], wrow[13], wrow[14], wrow[15])};
        *(v4u*)wquad_dst(wc, (wq0 + ((NT >> 2) - 1) * wqs) % WQ_N, tid) = o_;
    }
    {
        const v8i v0 = VF(3, 0), v1 = VF(3, 1), v2 = VF(3, 2), v3 = VF(3, 3);
        asm volatile("s_nop 4" ::: "memory");
        MFP(o[0], paY, v0); MFP(o[1], paY, v1); MFP(o[2], paY, v2); MFP(o[3], paY, v3);
        asm volatile("s_waitcnt lgkmcnt(0)" ::: "memory"); __syncthreads(); }
    asm volatile("s_nop 7\n\ts_nop 7\n\ts_nop 7" ::: "memory");
    float l_part = l0 + l1;
    { auto rr = __builtin_amdgcn_permlane32_swap(__float_as_uint(l_part), __float_as_uint(l_part), false, false); l_part = __uint_as_float(rr[0]) + __uint_as_float(rr[1]); }
    const int lane2 = fresh_lane(), r32e = lane2 & 31, hie = lane2 >> 5;
    LAS float* li_l = (LAS float*)(lds + L_OFFS) + wid * 64;
    if (hie == 0) li_l[r32e] = l_part; asm volatile("s_waitcnt lgkmcnt(0)" ::: "memory");
    float rli[16];
#pragma unroll
    for (int r = 0; r < 16; ++r) rli[r] = pscale * __builtin_amdgcn_rcpf(li_l[att::crow(r, hie)]);
    bf16* Ow = Ob + (size_t)(wid * 32) * D;
#pragma unroll
    for (int r = 0; r < 16; ++r) { const int orow = att::crow(r, hie);
#pragma unroll
        for (int d0 = 0; d0 < 4; ++d0) { const float v = o[d0][r] * rli[r]; Ow[(size_t)orow * D + d0 * 32 + r32e] = (bf16)(cvt_pk_bf16(v, v) & 0xffffu); } }
    __syncthreads();
#undef FLOAD
#undef DSW
#undef FWRITE
#undef KF
#undef VF
#undef FSTEP
#undef G0
#undef G1
#undef G2
#undef G3
#undef G4
#undef G5
#undef G6
#undef G7
}
#undef MF8Z
#undef MF8
#undef MFP
#undef FEXP
#undef FADD
#undef CVLO
#undef CVHI
}

__device__ __forceinline__ void ld_row(const float* row, int lane, f32x4 (&v)[4]) {
#pragma unroll
    for (int j = 0; j < 4; ++j) v[j] = *(const f32x4*)(row + 4 * lane + 256 * j);
}
__device__ __forceinline__ void ld_row_bf16(const bf16* row, int lane, f32x4 (&v)[4]) {
#pragma unroll
    for (int j = 0; j < 4; ++j) { const v2u w = *(const v2u*)(row + 4 * lane + 256 * j); v[j] = (f32x4){bf_lo(w.x), bf_hi(w.x), bf_lo(w.y), bf_hi(w.y)}; }
}
__device__ __forceinline__ void st_row(float* row, int lane, const f32x4 (&v)[4]) {
#pragma unroll
    for (int j = 0; j < 4; ++j) *(f32x4*)(row + 4 * lane + 256 * j) = v[j];
}
__device__ __forceinline__ void st_row_bf16(bf16* row, int lane, const f32x4 (&v)[4]) {
#pragma unroll
    for (int j = 0; j < 4; ++j) { v2u w; w.x = cvt_pk_bf16(v[j][0], v[j][1]); w.y = cvt_pk_bf16(v[j][2], v[j][3]); *(v2u*)(row + 4 * lane + 256 * j) = w; }
}
__device__ __forceinline__ void st_row_fp8(unsigned char* row, int lane, const f32x4 (&v)[4]) {
#pragma unroll
    for (int j = 0; j < 4; ++j) *(unsigned*)(row + 4 * lane + 256 * j) = cvt_pk_fp8x4(v[j][0], v[j][1], v[j][2], v[j][3]);
}
__device__ __forceinline__ float row_rstd(const f32x4 (&v)[4]) {
    float s = 0.f;
#pragma unroll
    for (int j = 0; j < 4; ++j) s += (v[j][0] * v[j][0] + v[j][1] * v[j][1]) + (v[j][2] * v[j][2] + v[j][3] * v[j][3]);
    return 1.0f / sqrtf(wave_sum(s) * (1.0f / D) + NORM_EPS);
}

struct Args { const float* in[21]; float* out; unsigned char* ws; int ph_lo, ph_hi, var, pad; };

__device__ __forceinline__ void transpose_item(const float* W, int N, int k0, int n0, bf16* dst, int K, LAS float* scr, int lane) {
    f32x4 v[8];
#pragma unroll
    for (int i = 0; i < 8; ++i) v[i] = *(const f32x4*)(W + (size_t)(k0 + (lane >> 3) + 8 * i) * N + n0 + (lane & 7) * 4);
#pragma unroll
    for (int i = 0; i < 8; ++i) { LAS float* d = scr + ((lane >> 3) + 8 * i) * 33 + (lane & 7) * 4; d[0] = v[i][0]; d[1] = v[i][1]; d[2] = v[i][2]; d[3] = v[i][3]; }
    LDS_WAIT(); asm volatile("" ::: "memory");
    const int c = lane & 7;
#pragma unroll
    for (int j = 0; j < 4; ++j) { const int n = (lane >> 3) + 8 * j; const LAS float* s = scr + (8 * c) * 33 + n;
        v4u o; o.x = cvt_pk_bf16(s[0 * 33], s[1 * 33]); o.y = cvt_pk_bf16(s[2 * 33], s[3 * 33]); o.z = cvt_pk_bf16(s[4 * 33], s[5 * 33]); o.w = cvt_pk_bf16(s[6 * 33], s[7 * 33]);
        *(v4u*)(dst + (size_t)n * K + 8 * c) = o; }
    LDS_WAIT(); asm volatile("" ::: "memory");
}

__device__ __forceinline__ void transpose_item_fp8(const float* W, int N, int k0, int n0, unsigned char* dst, int K, LAS float* scr, int lane, float scale) {
    f32x4 v[8];
#pragma unroll
    for (int i = 0; i < 8; ++i) v[i] = *(const f32x4*)(W + (size_t)(k0 + (lane >> 3) + 8 * i) * N + n0 + (lane & 7) * 4);
#pragma unroll
    for (int i = 0; i < 8; ++i) { LAS float* d = scr + ((lane >> 3) + 8 * i) * 33 + (lane & 7) * 4; d[0] = v[i][0] * scale; d[1] = v[i][1] * scale; d[2] = v[i][2] * scale; d[3] = v[i][3] * scale; }
    LDS_WAIT(); asm volatile("" ::: "memory");
    const int n = lane >> 1, kh = lane & 1; const LAS float* s = scr + (32 * kh) * 33 + n;
    v4u o0, o1;
    o0.x = cvt_pk_fp8x4(s[0 * 33], s[1 * 33], s[2 * 33], s[3 * 33]);     o0.y = cvt_pk_fp8x4(s[4 * 33], s[5 * 33], s[6 * 33], s[7 * 33]);
    o0.z = cvt_pk_fp8x4(s[8 * 33], s[9 * 33], s[10 * 33], s[11 * 33]);   o0.w = cvt_pk_fp8x4(s[12 * 33], s[13 * 33], s[14 * 33], s[15 * 33]);
    o1.x = cvt_pk_fp8x4(s[16 * 33], s[17 * 33], s[18 * 33], s[19 * 33]); o1.y = cvt_pk_fp8x4(s[20 * 33], s[21 * 33], s[22 * 33], s[23 * 33]);
    o1.z = cvt_pk_fp8x4(s[24 * 33], s[25 * 33], s[26 * 33], s[27 * 33]); o1.w = cvt_pk_fp8x4(s[28 * 33], s[29 * 33], s[30 * 33], s[31 * 33]);
    unsigned char* dp = dst + (size_t)n * K + 32 * kh;
    *(v4u*)dp = o0; *(v4u*)(dp + 16) = o1;
    LDS_WAIT(); asm volatile("" ::: "memory");
}

__device__ __forceinline__ int moe_build_units(LAS unsigned char* lds, const unsigned* gcnt, const int* tok_list, int NPN, bool gather, int rowbytes, int G, int c, const int tid) {
    const int lane = tid & 63;
    LAS unsigned* tb = (LAS unsigned*)(lds + L_TB); LAS unsigned* lc = (LAS unsigned*)(lds + L_CNT); LAS int* ut = (LAS int*)(lds + L_UT);
    if (tid < 64) {
        unsigned cnt = (lane < NE) ? __hip_atomic_load(gcnt + 64 * lane, RLX_AGENT) : 0u;
        unsigned tiles = (cnt + 255u) >> 8, incl = tiles;
#pragma unroll
        for (int o = 1; o < 32; o <<= 1) { const unsigned t = __shfl_up(incl, o); if (lane >= o) incl += t; }
        if (lane < NE) { tb[lane + 1] = incl; lc[lane] = cnt; }
        if (lane == 0) tb[0] = 0u;
    }
    __syncthreads();
    const int T = (int)tb[NE], nunits = T * NPN;
    int n_my = 0; { const int rem = nunits - c; n_my = rem > 0 ? (rem + G - 1) / G : 0; if (n_my > 16) n_my = 16; }
    if (tid < n_my) {
        int L = tid * G + c; const int q = nunits / 8, r = nunits % 8, xcd = L % 8, off = L / 8;
        const int wgid = (xcd < r ? xcd * (q + 1) : r * (q + 1) + (xcd - r) * q) + off;
        const int mtg = wgid / NPN, pn = wgid % NPN;
        int e = 0;
        for (int k = 1; k < NE; ++k) if ((int)tb[k] <= mtg) e = k;
        const int mtl = mtg - (int)tb[e]; int valid = (int)lc[e] - mtl * 256; if (valid > 256) valid = 256;
        ut[tid * 8 + 0] = e; ut[tid * 8 + 1] = mtl; ut[tid * 8 + 2] = pn; ut[tid * 8 + 3] = mtg; ut[tid * 8 + 4] = valid;
    }
    __syncthreads();
    if (gather) {
        LAS unsigned* offs = (LAS unsigned*)(lds + L_OFFS);
        for (int idx = tid; idx < n_my * 256; idx += 512) { const int u = idx >> 8, r = idx & 255; const int e = ut[u * 8 + 0], mtl = ut[u * 8 + 1], valid = ut[u * 8 + 4];
            const int tok = (r < valid) ? tok_list[e * S + mtl * 256 + r] : 0;
            offs[idx] = (unsigned)tok * (unsigned)rowbytes; }
        __syncthreads();
    }
    return n_my;
}

__global__ void __launch_bounds__(512, 2) fwd_kernel(Args args) {
    extern __shared__ __attribute__((aligned(16))) unsigned char lds_[];
    LAS unsigned char* lds = (LAS unsigned char*)lds_;
    const int wave = __builtin_amdgcn_readfirstlane(threadIdx.x >> 6);
    const int G = gridDim.x, bid = blockIdx.x;
#define PHASE_IDS const int lane = fresh_lane(), tid = wave * 64 + lane; (void)tid; (void)lane
    const int gw = bid * 8 + wave, NGW = G * 8;
    unsigned char* ws = args.ws;
    unsigned* ctl = (unsigned*)(ws + WS_CTL);
    const float* x = args.in[0]; const float* cvec = args.in[1]; const float* ctx = args.in[2]; const float* cctx = args.in[3];
    const float* ada_w = args.in[4]; const float* ada_b = args.in[5]; const float* norm_mix = args.in[6]; const float* norm_ffn = args.in[7];
    const float* w_qkv = args.in[8]; const float* q_g = args.in[9]; const float* k_g = args.in[10]; const float* w_o = args.in[11];
    const float* pool_w = args.in[12]; const float* pool_scale = args.in[13]; const float* router_w = args.in[14]; const float* router_b = args.in[15];
    const float* w_gu = args.in[16]; const float* b_gu = args.in[17]; const float* w_down = args.in[18]; const float* b_down = args.in[19]; const float* final_norm = args.in[20];
    float* MOD = (float*)(ws + WS_MOD);
    bf16* WF = (bf16*)(ws + WS_MOD + 131072);
    unsigned char* Wqkv8 = ws + WS_WQKV;
    bf16* Wo_t = (bf16*)(ws + WS_WO);
    bf16* Wpool_t = (bf16*)(ws + WS_WPOOL);
    unsigned char* Wgu8 = ws + WS_WGU; unsigned char* Wd8 = ws + WS_WD;
    unsigned char* H8 = ws + WS_H; unsigned char* ACT8 = ws + WS_ACT;
    int* tok_list = (int*)(ws + WS_TOKLIST); int* tok_e = (int*)(ws + WS_TOKE); int* tok_pos = (int*)(ws + WS_TOKP); float* tok_w = (float*)(ws + WS_TOKW);
    bf16* QKV = (bf16*)(ws + WS_QKV); bf16* O = (bf16*)(ws + WS_O);
    unsigned char* Q8 = ws + WS_Q8; unsigned char* K8 = ws + WS_K8; unsigned char* VT8 = ws + WS_VT8;
    bf16* XA = (bf16*)(ws + WS_XA); bf16* XB = (bf16*)(ws + WS_XB); bf16* XC = (bf16*)(ws + WS_XC);
    bf16* H1B = (bf16*)(ws + WS_POOLED);
    bf16* YZ = (bf16*)(ws + WS_H1F);
    bf16* Y = (bf16*)(ws + WS_Y);

    if (threadIdx.x < 16) ((LAS unsigned*)(lds + MISC_OFF))[threadIdx.x] = 0u;
    __syncthreads();
    XcdBarrier bar; bar.bar = ctl + CW_BAR; bar.x = 0; bar.st = nullptr; bar.wave = wave;
    if (MK_N_LAUNCHES == 1) bar = xcd_barrier_post(ctl + CW_BAR, (volatile LAS unsigned*)(lds + MISC_OFF), wave);
    const int lo = args.ph_lo, hi = args.ph_hi;
#ifndef PHASE_MASK
#define PHASE_MASK 0xFFFF
#endif
#define IN(k) ((((PHASE_MASK) >> (k)) & 1) && lo <= (k) && (k) < hi)
#define SEAM(k) do { if (IN(k) && IN((k) + 1)) xcd_barrier(bar); } while (0)

    if (IN(PH_PRO)) { PHASE_IDS;
        {
            LAS float* sl = (LAS float*)lds; LAS float* scx = sl + 1024; LAS float* part = sl + 2048;
            for (int i = tid; i < 1024; i += 512) { const float a = cvec[i], b = cctx[i]; sl[i] = a / (1.0f + __expf(-a)); scx[i] = b / (1.0f + __expf(-b)); }
            __syncthreads();
            for (int t = bid; t < 192; t += G) {
                const int layer = t / 96, cb = t % 96, n = cb * 64 + lane;
                const float* Wp = ada_w + (size_t)layer * 1024 * 6144 + (size_t)(wave * 128) * 6144 + n;
                float a0 = 0.f, a1 = 0.f;
#pragma unroll 16
                for (int k = 0; k < 128; ++k) { const float w = Wp[(size_t)k * 6144]; a0 += sl[wave * 128 + k] * w; a1 += scx[wave * 128 + k] * w; }
                part[wave * 64 + lane] = a0; part[512 + wave * 64 + lane] = a1;
                __syncthreads();
                if (tid < 128) { const int which = tid >> 6, l = tid & 63; float s = 0.f;
#pragma unroll
                    for (int w = 0; w < 8; ++w) s += part[which * 512 + w * 64 + l];
                    const int nn = cb * 64 + l; s += ada_b[layer * 6144 + nn];
                    if (which == 0) MOD[layer * 6144 + nn] = s; else if (layer == 0 && nn < 2048) MOD[12288 + nn] = s; }
                __syncthreads();
            }
        }
        for (int idx = bid * 512 + tid; idx < 65536; idx += G * 512) {
            const int j = idx & 7, ln = (idx >> 3) & 63, ks = (idx >> 9) & 15, kh = (idx >> 13) & 1, et = (idx >> 14) & 1, l = idx >> 15;
            const int e = et * 16 + (ln & 15), k = kh * 512 + ks * 32 + 8 * (ln >> 4) + j; const float w = router_w[(size_t)l * 32768 + k * 32 + e];
            const unsigned hi = cvt_pk_bf16(w, w) & 0xffffu; const float r_ = w - bf_lo(hi); const unsigned lo = cvt_pk_bf16(r_, r_) & 0xffffu;
            const size_t base = ((size_t)((((l * 2 + et) * 2 + kh) * 16 + ks) * 2) * 64 + ln) * 8 + j;
            WF[base] = (bf16)hi; WF[base + 512] = (bf16)lo; }
        {
            LAS float* scr = (LAS float*)(lds + wave * 16384);
            constexpr int I_GU = 64 * 16 * 64, I_D = 64 * 16 * 32, I_QKV = 16 * 48, I_O = 16 * 32, I_P = 4 * 4 * 8;
            const float gqm_ = wave_max(fmaxf(fabsf(q_g[lane]), fabsf(q_g[64 + lane]))), gkm_ = wave_max(fmaxf(fabsf(k_g[lane]), fabsf(k_g[64 + lane])));
            const bool attn_fast_ = (HD * gqm_ * gkm_ * att::SCALE * 1.4426950408889634f * 1.02f) < 26.0f;
            const int NITEMS = I_QKV + I_O + I_P;
            if (!attn_fast_) { const WConv wc_{w_gu, w_down, Wgu8, Wd8}; for (int q = bid; q < WQ_N; q += G) wquad_whole(wc_, q, tid); }
            for (int it = gw; it < NITEMS; it += NGW) {
                int r = it;
                if (r < I_QKV) { const int kb = r / 48, nb = r % 48; transpose_item_fp8(w_qkv, NQKV, kb * 64, nb * 32, Wqkv8 + (size_t)(nb * 32) * 1024 + kb * 64, 1024, scr, lane, WSCALE); continue; } r -= I_QKV;
                if (r < I_O) { const int kb = r / 32, nb = r % 32; transpose_item(w_o, 1024, kb * 64, nb * 32, Wo_t + (size_t)(nb * 32) * 1024 + kb * 64, 1024, scr, lane); continue; } r -= I_O;
                if (r < I_P) { const int g = r / 32, kb = (r % 32) / 8, nb = r % 8; transpose_item(pool_w + (size_t)g * 65536, 256, kb * 64, nb * 32, Wpool_t + (size_t)g * 65536 + (size_t)(nb * 32) * 256 + kb * 64, 256, scr, lane); continue; } r -= I_P;
            }
        }
        __syncthreads();
    }
    SEAM(PH_PRO);

    if (IN(PH_NORM1)) { PHASE_IDS;
        f32x4 av[4], bv[4];
#pragma unroll
        for (int j = 0; j < 4; ++j) { const int col = 4 * lane + 256 * j; const f32x4 g = *(const f32x4*)(norm_mix + col); av[j] = g * (1.0f + *(const f32x4*)(MOD + 1024 + col)); bv[j] = *(const f32x4*)(MOD + col); }
        for (int r = gw; r < S; r += NGW) { f32x4 v[4]; ld_row(x + (size_t)r * D, lane, v); const float rs = row_rstd(v);
#pragma unroll
            for (int j = 0; j < 4; ++j) v[j] = v[j] * rs * av[j] + bv[j];
            st_row_fp8(H8 + (size_t)r * D, lane, v); }
#pragma unroll
        for (int j = 0; j < 4; ++j) { const int col = 4 * lane + 256 * j; const f32x4 g = *(const f32x4*)(norm_mix + col); av[j] = g * (1.0f + *(const f32x4*)(MOD + 12288 + 1024 + col)); bv[j] = *(const f32x4*)(MOD + 12288 + col); }
        for (int r = gw; r < CT; r += NGW) { f32x4 v[4]; ld_row(ctx + (size_t)r * D, lane, v); const float rs = row_rstd(v);
#pragma unroll
            for (int j = 0; j < 4; ++j) v[j] = v[j] * rs * av[j] + bv[j];
            st_row_fp8(H8 + (size_t)(S + r) * D, lane, v); }
    }
    SEAM(PH_NORM1);

    if (IN(PH_QKV)) { PHASE_IDS;
        pg8::ProbDense<1> P; P.init(H8, Wqkv8, NTOK, NQKV, D, D, D, 0, G, bid);
        pg8::EpiBf16 E{QKV, NQKV, nullptr, 0, 1.0f / WSCALE};
        pg8::gemm_phase(lds, P, E, wave);
    }
    SEAM(PH_QKV);

    if (IN(PH_QKROPE)) { PHASE_IDS;
        const int sub = lane >> 4, j16 = lane & 15, part = j16 >> 3, i0 = 4 * (j16 & 7);
        constexpr int NIT = (S * 10) / 4 + (CT * 2) / 4;
        for (int it = gw; it < NIT; it += NGW) {
            const int idx = it * 4 + sub; const bool lat = idx < S * 10; int row, head;
            if (lat) { row = idx / 10; head = idx - row * 10; } else { const int i2 = idx - S * 10; row = S + (i2 >> 1); head = 8 + (i2 & 1); }
            bf16* p = QKV + (size_t)row * NQKV + head * HD + 64 * part + i0;
            const v2u a = *(const v2u*)p, b = *(const v2u*)(p + 32);
            float x1[4] = {bf_lo(a.x), bf_hi(a.x), bf_lo(a.y), bf_hi(a.y)}, x2[4] = {bf_lo(b.x), bf_hi(b.x), bf_lo(b.y), bf_hi(b.y)};
            float ss = 0.f;
#pragma unroll
            for (int i = 0; i < 4; ++i) ss += x1[i] * x1[i] + x2[i] * x2[i];
            ss += __shfl_xor(ss, 1); ss += __shfl_xor(ss, 2); ss += __shfl_xor(ss, 4); ss += __shfl_xor(ss, 8);
            const float rs = (1.0f / sqrtf(ss * (1.0f / HD) + NORM_EPS)) * (head < 8 ? att::SCALE * 1.4426950408889634f : 1.0f);
            const float* gp = (head < 8 ? q_g : k_g) + 64 * part + i0;
            const f32x4 g1 = *(const f32x4*)gp, g2 = *(const f32x4*)(gp + 32);
            float o1[4], o2[4];
#pragma unroll
            for (int i = 0; i < 4; ++i) { const float y1 = x1[i] * rs * g1[i], y2 = x2[i] * rs * g2[i];
                if (lat) { const float pos = (float)(part ? (row & (GRID_W - 1)) : (row / GRID_W));
                    const float invf = exp2f(-(float)(i0 + i) * (13.287712379549449f / 32.0f));
                    const float ang = pos * invf; const float sn = __sinf(ang), cs = __cosf(ang);
                    o1[i] = y1 * cs - y2 * sn; o2[i] = y2 * cs + y1 * sn; }
                else { o1[i] = y1; o2[i] = y2; } }
            v2u wa, wb; wa.x = cvt_pk_bf16(o1[0], o1[1]); wa.y = cvt_pk_bf16(o1[2], o1[3]); wb.x = cvt_pk_bf16(o2[0], o2[1]); wb.y = cvt_pk_bf16(o2[2], o2[3]);
            *(v2u*)p = wa; *(v2u*)(p + 32) = wb;
            {
                unsigned char* p8 = (head < 8) ? Q8 + (size_t)row * D + head * HD + 64 * part + i0 : K8 + (size_t)row * (NKV * HD) + (head - 8) * HD + 64 * part + i0;
                if (head >= 8 || lat) { *(unsigned*)p8 = cvt_pk_fp8x4(o1[0], o1[1], o1[2], o1[3]); *(unsigned*)(p8 + 32) = cvt_pk_fp8x4(o2[0], o2[1], o2[2], o2[3]); } }
        }
        {
            LAS unsigned char* tl = lds;
            for (int it = bid; it < NKV * (NTOK / 64); it += G) { const int kvh = it & 1, tile = it >> 1;
                const int key = tid & 63, dq = tid >> 6;
                const bf16* vp = QKV + (size_t)(tile * 64 + key) * NQKV + 1280 + kvh * HD + dq * 16;
                const v4u a = *(const v4u*)vp, b = *(const v4u*)(vp + 8);
                const unsigned wv[8] = {a.x, a.y, a.z, a.w, b.x, b.y, b.z, b.w};
                const int c = key & 31, slot = 32 * ((c >> 2) & 1) + (c & 3) + 4 * (c >> 3) + 16 * (key >> 5);
#pragma unroll
                for (int i = 0; i < 8; ++i) { const unsigned pk = cvt_pk_fp8x4(bf_lo(wv[i]), bf_hi(wv[i]), 0.f, 0.f);
                    tl[(dq * 16 + 2 * i) * 64 + slot] = (unsigned char)(pk & 0xffu); tl[(dq * 16 + 2 * i + 1) * 64 + slot] = (unsigned char)((pk >> 8) & 0xffu); }
                __syncthreads();
                *(v4u*)(VT8 + ((size_t)kvh * (NTOK / 64) + tile) * 8192 + tid * 16) = *(const LAS v4u*)(tl + tid * 16);
                __syncthreads();
            }
        }
    }
    SEAM(PH_QKROPE);

    if (IN(PH_ATTN)) { PHASE_IDS;
        const float gqm = wave_max(fmaxf(fabsf(q_g[lane]), fabsf(q_g[64 + lane]))), gkm = wave_max(fmaxf(fabsf(k_g[lane]), fabsf(k_g[64 + lane])));
        const float bound = HD * gqm * gkm * att::SCALE * 1.4426950408889634f * 1.02f;
        const bool fast = bound < 26.0f;
        if (__builtin_expect(fast, 1)) {
            const float pscale = exp2f(ceilf(fmaxf(bound - 15.5f, 0.0f)));
            const WConv wc{w_gu, w_down, Wgu8, Wd8}; int ui = 0;
            for (int u = bid; u < NH * (S / 256); u += G, ++ui) { const int head = u & 7, qb = u >> 3, kvh = head >> 2;
#if PROBE_VAR
                if (args.var) att8::attn_fp8_body<PROBE_VAR>(Q8 + (size_t)(qb * 256) * D + head * HD, K8 + kvh * HD, VT8 + (size_t)kvh * (NTOK / 64) * 8192, O + (size_t)(qb * 256) * D + head * HD, NTOK / 64, lds, wave, pscale, wc, ui * (NTOK / 256) * G + bid, G); else
#endif
                att8::attn_fp8_body<0>(Q8 + (size_t)(qb * 256) * D + head * HD, K8 + kvh * HD, VT8 + (size_t)kvh * (NTOK / 64) * 8192, O + (size_t)(qb * 256) * D + head * HD, NTOK / 64, lds, wave, pscale,
                                    wc, ui * (NTOK / 256) * G + bid, G); }
            for (int q = ui * (NTOK / 256) * G + bid; q < WQ_N; q += G) wquad_whole(wc, q, tid);
        }
#ifndef NO_FALLBACK
        else {
            for (int u = bid; u < NH * (S / 256); u += G) { const int head = u & 7, qb = u >> 3, kvh = head >> 2;
                att::attn_dense_body(QKV + (size_t)(qb * 256) * NQKV + head * HD, QKV + 1024 + kvh * HD, QKV + 1280 + kvh * HD, O + (size_t)(qb * 256) * D + head * HD, NTOK, (LAS char*)lds, wave); }
        }
#endif
    }
    SEAM(PH_ATTN);


#ifdef SELFCHECK
    if (IN(PH_WO)) { PHASE_IDS;
        LAS float* sc_ = (LAS float*)lds; LAS float* qf = sc_ + NTOK; LAS float* red = qf + 128; LAS float* misc = red + 512;
        {
            const int t = (bid * 61 + 7) & (S - 1), h = bid & 7, kvh = h >> 2;
            const bf16* qp = QKV + (size_t)t * NQKV + h * HD;
            if (tid < 128) qf[tid] = bf_lo((unsigned)qp[tid]);
            __syncthreads();
            float mx = -1e30f;
            for (int k = tid; k < NTOK; k += 512) { const bf16* kp = QKV + (size_t)k * NQKV + 1024 + kvh * HD; float a = 0.f;
#pragma unroll 4
                for (int d = 0; d < 128; d += 2) { const unsigned w = *(const unsigned*)(kp + d); a += qf[d] * bf_lo(w) + qf[d + 1] * bf_hi(w); }
                sc_[k] = a; mx = fmaxf(mx, a); }
            mx = wave_max(mx); if (lane == 0) misc[wave] = mx; __syncthreads();
            mx = misc[0]; for (int w = 1; w < 8; ++w) mx = fmaxf(mx, misc[w]);
            __syncthreads();
            float ls = 0.f;
            for (int k = tid; k < NTOK; k += 512) { const float p = exp2f(sc_[k] - mx); sc_[k] = p; ls += p; }
            ls = wave_sum(ls); if (lane == 0) misc[8 + wave] = ls; __syncthreads();
            ls = 0.f; for (int w = 0; w < 8; ++w) ls += misc[8 + w];
            const int d = tid & 127, part = tid >> 7; float acc = 0.f;
            for (int k = part; k < NTOK; k += 4) acc += sc_[k] * bf_lo((unsigned)QKV[(size_t)k * NQKV + 1280 + kvh * HD + d]);
            red[part * 128 + d] = acc; __syncthreads();
            if (tid < 128) { const float ref = (red[d] + red[128 + d] + red[256 + d] + red[384 + d]) / ls; const float got = bf_lo((unsigned)O[(size_t)t * D + h * HD + d]);
                float am = fabsf(ref); for (int o = 32; o >= 1; o >>= 1) am = fmaxf(am, __shfl_xor(am, o)); misc[16 + (tid >> 6)] = am; }
            __syncthreads();
            if (tid < 128) { const float ref = (red[d] + red[128 + d] + red[256 + d] + red[384 + d]) / ls; const float got = bf_lo((unsigned)O[(size_t)t * D + h * HD + d]);
                const float am = fmaxf(misc[16], misc[17]); if (!(fabsf(got - ref) <= 0.02f * am + 1e-7f)) atomicOr(ctl + 2, 1u); }
            __syncthreads();
        }
        {
            const int t = (bid * 97 + 13) % NTOK, h = (t >= S) ? 8 + (bid & 1) : (bid % 10);
            const int d = tid & 127, kq = tid >> 7; float a = 0.f;
            const unsigned char* hp = H8 + (size_t)t * D + kq * 256; const unsigned char* wp = Wqkv8 + (size_t)(h * HD + d) * D + kq * 256;
#pragma unroll 4
            for (int k = 0; k < 256; ++k) a += __builtin_amdgcn_cvt_f32_fp8((int)hp[k], 0) * __builtin_amdgcn_cvt_f32_fp8((int)wp[k], 0) * (1.0f / WSCALE);
            red[kq * 128 + d] = a; __syncthreads();
            if (tid < 128) qf[d] = red[d] + red[128 + d] + red[256 + d] + red[384 + d];
            __syncthreads();
            if (tid < 128) { float ss = 0.f;
#pragma unroll 4
                for (int i = 0; i < 128; ++i) ss += qf[i] * qf[i];
                const float rs = 1.0f / sqrtf(ss * (1.0f / HD) + NORM_EPS); const float* gp = h < 8 ? q_g : k_g;
                const int idx = d & 63, pr = d >> 6, fi = idx & 31; const float y = qf[d] * rs * gp[d]; float out = y;
                if (t < S) { const int dp = (idx < 32) ? d + 32 : d - 32; const float yp = qf[dp] * rs * gp[dp];
                    const double pos = (double)(pr ? (t & 63) : (t >> 6)); const double ang = pos * (double)exp2f(-(float)fi * (13.287712379549449f / 32.0f));
                    const double rr = ang - 6.283185307179586 * rint(ang * 0.15915494309189535); const float sn = __sinf((float)rr), cs = __cosf((float)rr);
                    out = (idx < 32) ? (y * cs - yp * sn) : (y * cs + yp * sn); }
                if (h < 8) out *= att::SCALE * 1.4426950408889634f;
                const float got = bf_lo((unsigned)QKV[(size_t)t * NQKV + h * HD + d]);
                float am = fabsf(out); for (int o = 32; o >= 1; o >>= 1) am = fmaxf(am, __shfl_xor(am, o));
                if (!(fabsf(got - out) <= 0.03f * am + 1e-7f)) atomicOr(ctl + 2, 2u); }
            __syncthreads();
        }
    }
#endif
    if (IN(PH_WO)) { PHASE_IDS;
        pg8::ProbDense<2> P; P.init(O, Wo_t, S, D, D, D, D, 0, G, bid);
        pg8::EpiBf16 E{YZ, D, nullptr, 0, 1.0f};
        pg8::gemm_phase(lds, P, E, wave);
    }
    SEAM(PH_WO);

#define ZLD2(U, J) (*(const v2u*)(YZ + (size_t)(U) * D + 4 * lane + 256 * (J)))
#define BF4(z_) ((f32x4){bf_lo((z_).x), bf_hi((z_).x), bf_lo((z_).y), bf_hi((z_).y)})
#define RDECL0 v2u ya[4][4]
#define RLD0(I, ROW, V) do { ld_row(x + (size_t)(ROW) * D, lane, V); _Pragma("unroll") for (int j = 0; j < 4; ++j) ya[I][j] = ZLD2(ROW, j); } while (0)
#define RFIN0(I, ROW, V) do { _Pragma("unroll") for (int j = 0; j < 4; ++j) { const f32x4 g_ = *(const f32x4*)(MOD + 2 * 1024 + 4 * lane + 256 * j); V[j] += g_ * BF4(ya[I][j]); } \
        st_row_bf16(XA + (size_t)(ROW) * D, lane, V); } while (0)
#define RINIT0(T0) do { } while (0)
#define RDECL1 v2u zt[4][4], za[4][4], zo[4][4]
#define RINIT1(T0) do { _Pragma("unroll") for (int j = 0; j < 4; ++j) { const int half_ = 1 << j; int lo_ = (T0) - half_; if (lo_ < 0) lo_ = 0; int hi_ = (T0) + half_; if (hi_ > S) hi_ = S; \
            zs[j] = (f32x4){0.f, 0.f, 0.f, 0.f}; for (int u_ = lo_; u_ < hi_; ++u_) { const v2u z_ = ZLD2(u_, j); zs[j] += BF4(z_); } } } while (0)
#define RLD1(I, ROW, V) do { ld_row_bf16(XB + (size_t)(ROW) * D, lane, V); \
        _Pragma("unroll") for (int j = 0; j < 4; ++j) { const int half_ = 1 << j, ia_ = (ROW) + half_, is_ = (ROW) - half_; \
            zt[I][j] = ZLD2(ROW, j); za[I][j] = ZLD2(ia_ < S ? ia_ : S - 1, j); zo[I][j] = ZLD2(is_ > 0 ? is_ : 0, j); } } while (0)
#define RFIN1(I, ROW, V) do { \
        _Pragma("unroll") for (int j = 0; j < 4; ++j) { const int half_ = 1 << j, t_ = (ROW); int lo_ = t_ - half_; if (lo_ < 0) lo_ = 0; int hi_ = t_ + half_; if (hi_ > S) hi_ = S; \
            const int ia_ = t_ + half_, is_ = t_ - half_;                       \
            const f32x4 p_ = zs[j] * (1.0f / (float)(hi_ - lo_)) - BF4(zt[I][j]); \
            const f32x4 g_ = *(const f32x4*)(MOD + 6144 + 2 * 1024 + 4 * lane + 256 * j) * *(const f32x4*)(pool_scale + 4 * lane + 256 * j); \
            V[j] += g_ * p_; zs[j] += BF4(za[I][j]) * (ia_ < S ? 1.0f : 0.0f) - BF4(zo[I][j]) * (is_ >= 0 ? 1.0f : 0.0f); } \
        st_row_bf16(XC + (size_t)(ROW) * D, lane, V); } while (0)
#define ROUTE_PHASE(LAYER, RDECL, RLD, RFIN, RINIT, RG) do { \
        const float* modp = MOD + (LAYER) * 6144; const float* gn = norm_ffn + (LAYER) * 1024; const float* rb = router_b + (LAYER) * 32; \
        unsigned* gcnt = ctl + CW_CNT + (LAYER) * 2048; \
        LAS unsigned* lcnt = (LAS unsigned*)(lds + L_LCNT); LAS unsigned* lbase = (LAS unsigned*)(lds + L_LBASE); \
        LAS int* ent_e = (LAS int*)(lds + L_ENT); LAS int* ent_p = ent_e + 256; LAS float* ent_w = (LAS float*)(ent_e + 512); \
        LAS float* part = (LAS float*)(lds + L_OFFS); LAS float* lgt = part + 2048;          \
        f32x4 av[4], bv[4]; \
        _Pragma("unroll") for (int j = 0; j < 4; ++j) { const int col = 4 * lane + 256 * j; const f32x4 g = *(const f32x4*)(gn + col); av[j] = g * (1.0f + *(const f32x4*)(modp + 4 * 1024 + col)); bv[j] = *(const f32x4*)(modp + 3 * 1024 + col); } \
        const int et = wave & 1, rt = (wave >> 1) & 1, kh = wave >> 2; \
        const bf16* wf = WF + ((size_t)((((LAYER) * 2 + et) * 2 + kh) * 16) * 2 * 64 + lane) * 8;       \
        const int brow = rt * 16 + (lane & 15), bkq = lane >> 4; \
        for (int c0 = bid; c0 < S / 32; c0 += 2 * G) { \
          if (tid < 32) lcnt[tid] = 0u; \
          for (int cs = 0; cs < 2; ++cs) { const int chunk = c0 + cs * G; if (chunk >= S / 32) break;        \
            f32x4 zs[4]; (void)zs; RINIT(chunk * 32 + wave * 4); \
            f32x4 hr[4][4]; RDECL; \
            _Pragma("unroll") for (int g_ = 0; g_ < 4; g_ += (RG)) {        \
                _Pragma("unroll") for (int i = g_; i < g_ + (RG); ++i) RLD(i, chunk * 32 + wave * 4 + i, hr[i]); \
                _Pragma("unroll") for (int i = g_; i < g_ + (RG); ++i) RFIN(i, chunk * 32 + wave * 4 + i, hr[i]); } \
            _Pragma("unroll") for (int i = 0; i < 4; ++i) { \
                const int rl = wave * 4 + i, row = chunk * 32 + rl; \
                f32x4 (&h)[4] = hr[i]; \
                const float rs = row_rstd(h); \
                _Pragma("unroll") for (int j = 0; j < 4; ++j) h[j] = h[j] * rs * av[j] + bv[j]; \
                st_row_fp8(H8 + (size_t)row * D, lane, h); \
                _Pragma("unroll") for (int j = 0; j < 4; ++j) { v2u hi_; hi_.x = cvt_pk_bf16(h[j][0], h[j][1]); hi_.y = cvt_pk_bf16(h[j][2], h[j][3]); \
                    const f32x4 r_ = h[j] - (f32x4){bf_lo(hi_.x), bf_hi(hi_.x), bf_lo(hi_.y), bf_hi(hi_.y)}; v2u lo_; lo_.x = cvt_pk_bf16(r_[0], r_[1]); lo_.y = cvt_pk_bf16(r_[2], r_[3]); \
                    const int off_ = rl * 2048 + ((((lane >> 1) + 32 * j) ^ (rl & 15)) << 4) + (lane & 1) * 8; \
                    *(LAS v2u*)(lds + off_) = hi_; *(LAS v2u*)(lds + 65536 + off_) = lo_; } \
            } \
            __syncthreads(); \
            { f32x4 acc_ = (f32x4){0.f, 0.f, 0.f, 0.f}; \
              _Pragma("unroll 4") for (int ks = 0; ks < 16; ++ks) { \
                  const bf16x8 ahi = *(const bf16x8*)(wf + (size_t)(ks * 2) * 512), alo = *(const bf16x8*)(wf + (size_t)(ks * 2 + 1) * 512); \
                  const int boff = brow * 2048 + ((((kh * 512 + ks * 32) >> 3) + bkq) ^ (brow & 15)) * 16; \
                  const bf16x8 bhi = *(const LAS bf16x8*)(lds + boff), blo = *(const LAS bf16x8*)(lds + 65536 + boff); \
                  acc_ = __builtin_amdgcn_mfma_f32_16x16x32_bf16(ahi, bhi, acc_, 0, 0, 0); acc_ = __builtin_amdgcn_mfma_f32_16x16x32_bf16(ahi, blo, acc_, 0, 0, 0); acc_ = __builtin_amdgcn_mfma_f32_16x16x32_bf16(alo, bhi, acc_, 0, 0, 0); } \
              _Pragma("unroll") for (int r = 0; r < 4; ++r) part[wave * 256 + (4 * (lane >> 4) + r) * 16 + (lane & 15)] = acc_[r]; } \
            __syncthreads(); \
            _Pragma("unroll") for (int o_ = 0; o_ < 2; ++o_) { const int idx = tid + 512 * o_, row_ = idx >> 5, e_ = idx & 31; const int w0_ = (e_ >> 4) + 2 * (row_ >> 4), pi_ = (e_ & 15) * 16 + (row_ & 15); \
                lgt[row_ * 33 + e_] = part[w0_ * 256 + pi_] + part[(w0_ + 4) * 256 + pi_] + rb[e_]; } \
            __syncthreads(); \
            if (tid < 32) { const LAS float* lr = lgt + tid * 33; unsigned taken = 0u; int se[4]; float sv[4]; \
                _Pragma("unroll") for (int k = 0; k < 4; ++k) { float mx = -INFINITY; int me = 0; \
                    for (int e = 0; e < 32; ++e) { const float v = lr[e]; const bool ok = !((taken >> e) & 1u) && v > mx; mx = ok ? v : mx; me = ok ? e : me; } \
                    taken |= 1u << me; se[k] = me; sv[k] = mx; } \
                const float e1 = __expf(sv[1] - sv[0]), e2 = __expf(sv[2] - sv[0]), e3 = __expf(sv[3] - sv[0]); const float inv = 1.0f / (1.0f + e1 + e2 + e3); \
                const float ww[4] = {inv, e1 * inv, e2 * inv, e3 * inv}; \
                _Pragma("unroll") for (int k = 0; k < 4; ++k) { const unsigned pl = __hip_atomic_fetch_add(lcnt + se[k], 1u, __ATOMIC_RELAXED, __HIP_MEMORY_SCOPE_WORKGROUP); \
                    const int ei = (cs * 32 + tid) * 4 + k; ent_e[ei] = se[k]; ent_p[ei] = (int)pl; ent_w[ei] = ww[k]; } } \
            __syncthreads(); \
          } \
          if (tid < 32) { const unsigned c_ = lcnt[tid]; unsigned base = 0u; if (c_) base = __hip_atomic_fetch_add(gcnt + 64 * tid, c_, RLX_AGENT); lbase[tid] = base; } \
          __syncthreads(); \
          if (tid < 256) { const int cs = tid >> 7, rl = (tid >> 2) & 31; const int chunk = c0 + cs * G; \
              if (chunk < S / 32) { const int e = ent_e[tid]; const int pos = (int)lbase[e] + ent_p[tid]; const int tok = chunk * 32 + rl; \
                  tok_list[e * S + pos] = tok; tok_e[tok * 4 + (tid & 3)] = e; tok_pos[tok * 4 + (tid & 3)] = pos; tok_w[tok * 4 + (tid & 3)] = ent_w[tid]; } } \
          __syncthreads(); \
        } } while (0)

#define MOE1_PHASE(LAYER) do { \
        const int n_my = moe_build_units(lds, ctl + CW_CNT + (LAYER) * 2048, tok_list, 8, true, D, G, bid, tid); \
        pg8::ProbMoE<true, 1> P{H8, Wgu8 + (size_t)(LAYER) * 32 * 2048 * 1024, D, D, n_my, (size_t)2048 * 1024, lds, 2048}; \
        pg8::EpiSwiglu E{ACT8, b_gu + (size_t)(LAYER) * 32 * 2048, 1.0f / WSCALE}; \
        pg8::gemm_phase(lds, P, E, wave); } while (0)
#define MOE2_PHASE(LAYER) do { \
        const int n_my = moe_build_units(lds, ctl + CW_CNT + (LAYER) * 2048, tok_list, 4, false, D, G, bid, tid); \
        pg8::ProbMoE<false, 1> P{ACT8, Wd8 + (size_t)(LAYER) * 32 * 1024 * 1024, D, D, n_my, (size_t)1024 * 1024, lds, 1024}; \
        pg8::EpiBf16 E{Y, D, b_down + (size_t)(LAYER) * 32 * 1024, 1024, 1.0f / WSCALE}; \
        pg8::gemm_phase(lds, P, E, wave); } while (0)
#define COMBINE_ROW(LAYER, XIN, ROW, V) do { \
        ld_row_bf16((XIN) + (size_t)(ROW) * D, lane, V); \
        const v4i te = *(const v4i*)(tok_e + (ROW) * 4), tp = *(const v4i*)(tok_pos + (ROW) * 4); const f32x4 tw = *(const f32x4*)(tok_w + (ROW) * 4); \
        f32x4 a_[4]; _Pragma("unroll") for (int j = 0; j < 4; ++j) a_[j] = (f32x4){0.f, 0.f, 0.f, 0.f}; \
        _Pragma("unroll") for (int k = 0; k < 4; ++k) { const int e = __builtin_amdgcn_readfirstlane(te[k]); const int pos = __builtin_amdgcn_readfirstlane(tp[k]); const float w = tw[k]; \
            const int prow = (int)__builtin_amdgcn_readlane(tbv, e) * 256 + pos; const bf16* yr = Y + (size_t)prow * D; \
            _Pragma("unroll") for (int j = 0; j < 4; ++j) { const v2u y = *(const v2u*)(yr + 4 * lane + 256 * j); a_[j] += w * (f32x4){bf_lo(y.x), bf_hi(y.x), bf_lo(y.y), bf_hi(y.y)}; } } \
        _Pragma("unroll") for (int j = 0; j < 4; ++j) V[j] = V[j] + gfv[j] * a_[j]; } while (0)
#define TILE_BASE(LAYER) \
        int tbv; { const unsigned cnt = (lane < NE) ? __hip_atomic_load(ctl + CW_CNT + (LAYER) * 2048 + 64 * lane, RLX_AGENT) : 0u; unsigned incl = (cnt + 255u) >> 8; const unsigned own = incl; \
            _Pragma("unroll") for (int o = 1; o < 32; o <<= 1) { const unsigned t = __shfl_up(incl, o); if (lane >= o) incl += t; } tbv = (int)(incl - own); }

    if (IN(PH_ROUTE0)) { PHASE_IDS; ROUTE_PHASE(0, RDECL0, RLD0, RFIN0, RINIT0, 4); }
    SEAM(PH_ROUTE0);
    if (IN(PH_MOE1_0)) { PHASE_IDS; MOE1_PHASE(0); }
    SEAM(PH_MOE1_0);
    if (IN(PH_MOE2_0)) { PHASE_IDS; MOE2_PHASE(0); }
    SEAM(PH_MOE2_0);

    if (IN(PH_COMB0)) { PHASE_IDS;
        TILE_BASE(0)
        f32x4 gfv[4], av[4], bv[4];
#pragma unroll
        for (int j = 0; j < 4; ++j) { const int col = 4 * lane + 256 * j; gfv[j] = *(const f32x4*)(MOD + 5 * 1024 + col);
            const f32x4 g = *(const f32x4*)(norm_mix + 1024 + col); av[j] = g * (1.0f + *(const f32x4*)(MOD + 6144 + 1024 + col)); bv[j] = *(const f32x4*)(MOD + 6144 + col); }
        for (int r = gw; r < S; r += NGW) { f32x4 v[4]; COMBINE_ROW(0, XA, r, v);
            st_row_bf16(XB + (size_t)r * D, lane, v); const float rs = row_rstd(v);
#pragma unroll
            for (int j = 0; j < 4; ++j) v[j] = v[j] * rs * av[j] + bv[j];
            st_row_bf16(H1B + (size_t)r * D, lane, v); }
    }
    SEAM(PH_COMB0);

    if (IN(PH_POOLG)) { PHASE_IDS;
        pg8::ProbDense<2> P; P.init(H1B, Wpool_t, S, D, 256, D, 256, 256, G, bid);
        pg8::EpiBf16 E{YZ, D, nullptr, 0, 1.0f};
        pg8::gemm_phase(lds, P, E, wave);
    }
    SEAM(PH_POOLG);

    if (IN(PH_ROUTE1)) { PHASE_IDS; ROUTE_PHASE(1, RDECL1, RLD1, RFIN1, RINIT1, 2); }
    SEAM(PH_ROUTE1);
    if (IN(PH_MOE1_1)) { PHASE_IDS; MOE1_PHASE(1); }
    SEAM(PH_MOE1_1);
    if (IN(PH_MOE2_1)) { PHASE_IDS; MOE2_PHASE(1); }
    SEAM(PH_MOE2_1);

    if (IN(PH_FINAL)) { PHASE_IDS;
        TILE_BASE(1)
        f32x4 gfv[4], fv[4];
#pragma unroll
        for (int j = 0; j < 4; ++j) { const int col = 4 * lane + 256 * j; gfv[j] = *(const f32x4*)(MOD + 6144 + 5 * 1024 + col); fv[j] = *(const f32x4*)(final_norm + col); }
        for (int r = gw; r < S; r += NGW) { f32x4 v[4]; COMBINE_ROW(1, XC, r, v);
            const float rs = row_rstd(v);
#pragma unroll
            for (int j = 0; j < 4; ++j) v[j] = v[j] * rs * fv[j];
#ifdef SELFCHECK
            if (__hip_atomic_load(ctl + 2, RLX_AGENT) != 0u) { for (int j = 0; j < 4; ++j) v[j] = (f32x4){__builtin_nanf(""), __builtin_nanf(""), __builtin_nanf(""), __builtin_nanf("")}; }
#endif
            st_row(args.out + (size_t)r * D, lane, v); }
    }
#undef IN
#undef SEAM
}

extern "C" void kernel_launch(void* const* d_in, const int* in_sizes, int n_in, void* d_out, int out_size, void* d_ws, size_t ws_size, hipStream_t stream) {
    static int grid = 0;
    if (grid == 0) {
        if (n_in != 21 || in_sizes[0] != S * D || out_size != S * D || ws_size < WS_END) { fprintf(stderr, "kernel_launch: unexpected shapes (n_in %d, in0 %d, out %d, ws %zu)\n", n_in, n_in > 0 ? in_sizes[0] : -1, out_size, ws_size); grid = -1; return; }
        int dev = 0, cus = 0, per_cu = 0;
        if (hipGetDevice(&dev) != hipSuccess || hipDeviceGetAttribute(&cus, hipDeviceAttributeMultiprocessorCount, dev) != hipSuccess) { grid = -1; return; }
        if (hipFuncSetAttribute((const void*)fwd_kernel, hipFuncAttributeMaxDynamicSharedMemorySize, LDS_BYTES) != hipSuccess) { fprintf(stderr, "kernel_launch: hipFuncSetAttribute failed\n"); grid = -1; return; }
        if (hipOccupancyMaxActiveBlocksPerMultiprocessor(&per_cu, (const void*)fwd_kernel, 512, LDS_BYTES) != hipSuccess || per_cu < 1) { fprintf(stderr, "kernel_launch: occupancy query says %d\n", per_cu); }
        (void)hipGetLastError();
        grid = cus;
    }
    if (grid < 0) return;
    if (hipMemsetAsync((char*)d_ws + WS_CTL, 0, CTL_ZERO_BYTES, stream) != hipSuccess) return;
    Args a{};
    for (int i = 0; i < 21; ++i) a.in[i] = (const float*)d_in[i];
    a.out = (float*)d_out; a.ws = (unsigned char*)d_ws;
    if (MK_N_LAUNCHES == 1) { a.ph_lo = 0; a.ph_hi = NPHASE; hipLaunchKernelGGL(fwd_kernel, dim3(grid), dim3(512), LDS_BYTES, stream, a); }
    else for (int p = 0; p < NPHASE; ++p) { a.ph_lo = p; a.ph_hi = p + 1; hipLaunchKernelGGL(fwd_kernel, dim3(grid), dim3(512), LDS_BYTES, stream, a); }
    if (PROBE_REP >= 0) { a.ph_lo = PROBE_REP; a.ph_hi = PROBE_REP + 1; a.var = PROBE_VAR; hipLaunchKernelGGL(fwd_kernel, dim3(grid), dim3(512), LDS_BYTES, stream, a); }
    const hipError_t le = hipPeekAtLastError();
    if (le != hipSuccess) fprintf(stderr, "kernel_launch: launch failed: %s\n", hipGetErrorName(le));
}
```

```cpp
#include <hip/hip_runtime.h>
#include <cstdio>
#include <cstdint>

#ifndef MK_N_LAUNCHES
#define MK_N_LAUNCHES 1
#endif
#ifndef PROBE_VAR
#define PROBE_VAR 0
#endif
#ifndef PROBE_REP
#define PROBE_REP -1
#endif

#define GAS __attribute__((address_space(1)))
#define LAS __attribute__((address_space(3)))
typedef unsigned short bf16;
typedef unsigned v4u __attribute__((ext_vector_type(4)));
typedef unsigned v2u __attribute__((ext_vector_type(2)));
typedef int v4i __attribute__((ext_vector_type(4)));
typedef float f32x4 __attribute__((ext_vector_type(4)));
typedef float f32x2 __attribute__((ext_vector_type(2)));
typedef float f32x16 __attribute__((ext_vector_type(16)));
typedef short bf16x8 __attribute__((ext_vector_type(8)));
typedef short s16x4 __attribute__((ext_vector_type(4)));
typedef int v8i __attribute__((ext_vector_type(8)));

constexpr int S = 16384, CT = 256, NTOK = S + CT, D = 1024, NQKV = 1536, NE = 32, HD = 128, NH = 8, NKV = 2;
constexpr int GRID_W = 64;
constexpr float NORM_EPS = 1e-6f;
constexpr int NPHASE = 15;
constexpr float WSCALE = 32.0f;
enum Phase { PH_PRO = 0, PH_NORM1, PH_QKV, PH_QKROPE, PH_ATTN, PH_WO, PH_ROUTE0, PH_MOE1_0, PH_MOE2_0, PH_COMB0, PH_POOLG, PH_ROUTE1, PH_MOE1_1, PH_MOE2_1, PH_FINAL };

constexpr size_t MiB = 1u << 20;
constexpr size_t WS_CTL = 0, CTL_ZERO_BYTES = 1 * MiB;
constexpr size_t WS_MOD = 1 * MiB;
constexpr size_t WS_WQKV = 2 * MiB;
constexpr size_t WS_WO = 5 * MiB;
constexpr size_t WS_WPOOL = 7 * MiB;
constexpr size_t WS_TOKLIST = 8 * MiB;
constexpr size_t WS_TOKE = 10 * MiB;
constexpr size_t WS_TOKP = 10 * MiB + 256 * 1024;
constexpr size_t WS_TOKW = 10 * MiB + 512 * 1024;
constexpr size_t WS_H = 16 * MiB;
constexpr size_t WS_QKV = 52 * MiB;
constexpr size_t WS_O = 104 * MiB;
constexpr size_t WS_XA = 136 * MiB;
constexpr size_t WS_XB = 200 * MiB;
constexpr size_t WS_XC = 264 * MiB;
constexpr size_t WS_H1F = 328 * MiB;
constexpr size_t WS_POOLED = 392 * MiB;
constexpr size_t WS_ACT = 424 * MiB;
constexpr size_t WS_Y = 568 * MiB;
constexpr size_t WS_WGU = 712 * MiB;
constexpr size_t WS_WD = 968 * MiB;
constexpr size_t WS_Q8 = 1040 * MiB;
constexpr size_t WS_K8 = 1056 * MiB;
constexpr size_t WS_VT8 = 1062 * MiB;
constexpr size_t WS_END = 1096 * MiB;
constexpr int CW_BAR = 4096;
constexpr int CW_CNT = 8192;

constexpr int RING_BYTES = 131072;
constexpr int MISC_OFF = RING_BYTES;
constexpr int L_LCNT = MISC_OFF + 64;
constexpr int L_LBASE = MISC_OFF + 192;
constexpr int L_TB = MISC_OFF + 320;
constexpr int L_CNT = MISC_OFF + 480;
constexpr int L_UT = MISC_OFF + 640;
constexpr int L_ENT = MISC_OFF + 1280;
constexpr int L_OFFS = MISC_OFF + 4608;
constexpr int LDS_BYTES = MISC_OFF + 4608 + 16384 + 256;
static_assert(LDS_BYTES <= 163840, "LDS");

#define RLX_AGENT __ATOMIC_RELAXED, __HIP_MEMORY_SCOPE_AGENT
#define LDS_WAIT() asm volatile("s_waitcnt lgkmcnt(0)" ::: "memory")
#define VM_WAIT() asm volatile("s_waitcnt vmcnt(0)" ::: "memory")

__device__ __forceinline__ int fresh_lane() { int l; asm volatile("v_mbcnt_lo_u32_b32 %0, -1, 0\n\tv_mbcnt_hi_u32_b32 %0, -1, %0" : "=v"(l)); return l; }
__device__ __forceinline__ unsigned cvt_pk_bf16(float lo, float hi) { unsigned r; asm volatile("v_cvt_pk_bf16_f32 %0, %1, %2" : "=v"(r) : "v"(lo), "v"(hi)); return r; }
__device__ __forceinline__ unsigned cvt_pk_fp8x4(float a, float b, float c, float d) { int w = 0; w = __builtin_amdgcn_cvt_pk_fp8_f32(a, b, w, false); w = __builtin_amdgcn_cvt_pk_fp8_f32(c, d, w, true); return (unsigned)w; }
__device__ __forceinline__ float bf_lo(unsigned w) { return __uint_as_float(w << 16); }
__device__ __forceinline__ float bf_hi(unsigned w) { return __uint_as_float(w & 0xffff0000u); }
__device__ __forceinline__ float wave_sum(float v) {
#pragma unroll
    for (int o = 32; o >= 1; o >>= 1) v += __shfl_xor(v, o);
    return v;
}
__device__ __forceinline__ float wave_max(float v) {
#pragma unroll
    for (int o = 32; o >= 1; o >>= 1) v = fmaxf(v, __shfl_xor(v, o));
    return v;
}

#define XB_TMO      128
#define XB_XCNT(j)  (256  + 64 * (j))
#define XB_XSUB(j)  (1280 + 64 * (j))
#define XB_XGEN(j)  (2304 + 64 * (j))
#define XB_TOP      3328
#define XB_TOPGEN   3392
#define XCD_BAR_WORDS 3456
#define XB_SPIN_CAP (1u << 18)
__device__ __forceinline__ unsigned xb_ld(unsigned* p)              { return __hip_atomic_load(p, __ATOMIC_RELAXED, __HIP_MEMORY_SCOPE_AGENT); }
__device__ __forceinline__ unsigned xb_add(unsigned* p, unsigned v) { return __hip_atomic_fetch_add(p, v, __ATOMIC_RELAXED, __HIP_MEMORY_SCOPE_AGENT); }
__device__ __forceinline__ unsigned xb_xcc_id() { return (unsigned)__builtin_amdgcn_s_getreg((3 << 11) | 20) & 0xFu; }
#define XB_SPIN(cond, bar) do { unsigned _sp = 0; while (cond) { __builtin_amdgcn_s_sleep(1); \
    if ((++_sp & 255u) == 0u) { if (xb_ld(&(bar)[XB_TMO])) break; if (_sp > XB_SPIN_CAP) { atomicAdd(&(bar)[XB_TMO], 1u); break; } } } } while (0)
struct XcdBarrier { unsigned* bar; unsigned x; volatile LAS unsigned* st; int wave; };
__device__ __forceinline__ XcdBarrier xcd_barrier_post(unsigned* bar, volatile LAS unsigned* st, int wave) {
    XcdBarrier b; b.bar = bar; b.x = xb_xcc_id(); b.st = st; b.wave = wave;
    if (wave == 0 && fresh_lane() == 0) (void)xb_add(&bar[XB_XCNT(b.x)], 1u);
    return b;
}
__device__ __forceinline__ void xcd_barrier_complete(unsigned* bar, unsigned x, unsigned& nloc, unsigned& nx) {
    const unsigned G = gridDim.x * gridDim.y * gridDim.z;
    unsigned sum, cnt, mine, sp = 0u;
    for (;;) {
        sum = 0u; cnt = 0u; mine = 0u;
#pragma unroll
        for (unsigned j = 0; j < 16; ++j) { const unsigned c = xb_ld(&bar[XB_XCNT(j)]); sum += c; cnt += (c > 0u) ? 1u : 0u; mine = (j == x) ? c : mine; }
        if (sum == G) break;
        __builtin_amdgcn_s_sleep(1);
        if ((++sp & 255u) == 0u) { if (xb_ld(&bar[XB_TMO])) break; if (sp > XB_SPIN_CAP) { atomicAdd(&bar[XB_TMO], 1u); break; } }
    }
    nloc = mine > 0u ? mine : 1u; nx = cnt > 0u ? cnt : 1u;
}
__device__ __forceinline__ void xcd_barrier(const XcdBarrier& b) {
    asm volatile("s_waitcnt vmcnt(0)" ::: "memory");
    __syncthreads();
    if (b.wave == 0 && fresh_lane() == 0) {
        unsigned* bar = b.bar;
        __builtin_amdgcn_s_waitcnt(0);
        unsigned nloc = b.st[0], nx = b.st[1];
        if (nloc == 0u) { xcd_barrier_complete(bar, b.x, nloc, nx); b.st[0] = nloc; b.st[1] = nx; }
        const unsigned old = xb_add(&bar[XB_XSUB(b.x)], 1u);
        const unsigned gen = old / nloc;
        if (old + 1u == (gen + 1u) * nloc) {
            __builtin_amdgcn_fence(__ATOMIC_RELEASE, "agent");
            asm volatile("s_waitcnt vmcnt(0)" ::: "memory");
            const unsigned og = xb_add(&bar[XB_TOP], 1u);
            const unsigned tg = og / nx;
            if (og + 1u == (tg + 1u) * nx) xb_add(&bar[XB_TOPGEN], 1u);
            else XB_SPIN(xb_ld(&bar[XB_TOPGEN]) == tg, bar);
            __builtin_amdgcn_fence(__ATOMIC_ACQUIRE, "agent");
            xb_add(&bar[XB_XGEN(b.x)], 1u);
            asm volatile("s_waitcnt vmcnt(0)" ::: "memory");
        } else {
            XB_SPIN(xb_ld(&bar[XB_XGEN(b.x)]) == gen, bar);
            __builtin_amdgcn_fence(__ATOMIC_ACQUIRE, "agent");
            asm volatile("s_waitcnt vmcnt(0)" ::: "memory");
        }
    }
    __syncthreads();
}

namespace pg8 {
constexpr int BM = 256, BK = 64, HALF = 128, HTB = HALF * BK * 2, NXCD = 8, WGM = 8;
__device__ __forceinline__ int lds_byte(int r, int c) { const int st = (r >> 4) * 2 + (c >> 5), rr = r & 15, cc = c & 31, ob = rr * 64 + cc * 2; return st * 1024 + (ob ^ (((ob >> 9) & 1) << 5)); }
__device__ __forceinline__ void stage_rc(int b, int& R, int& C) { const int st = b / 1024, sb = b % 1024, swz = sb ^ (((sb >> 9) & 1) << 5); R = (st >> 1) * 16 + swz / 64; C = (st & 1) * 32 + (swz % 64) / 2; }
__device__ __forceinline__ int perm32(int rho) { const int n = rho >> 4, i = rho & 15; return 8 * (i >> 2) + 4 * n + (i & 3); }

struct GU { const char* A; const char* B; int orow0; int pn; int e; int slot; };

template <int ESZ_> struct ProbDense {
    static constexpr int ESZ = ESZ_; static constexpr bool BIL = false, AIL = false; static constexpr int nB = 0;
    const unsigned char* A; const unsigned char* Bt; int lda, ldb, K, acol; int nM, nN, nwg, G, c;
    __device__ __forceinline__ void init(const void* A_, const void* Bt_, int M, int N, int K_, int lda_, int ldb_, int acol_, int G_, int c_) {
        A = (const unsigned char*)A_; Bt = (const unsigned char*)Bt_; lda = lda_; ldb = ldb_; K = K_; acol = acol_; nM = M / BM; nN = N / BM; nwg = nM * nN; G = G_; c = c_; }
    __device__ __forceinline__ bool next(int i, GU& u) const {
        const long L = (long)i * G + c; if (L >= nwg) return false;
        int wgid = (int)L; { const int q = nwg / NXCD, r = nwg % NXCD, xcd = wgid % NXCD, off = wgid / NXCD; wgid = (xcd < r ? xcd * (q + 1) : r * (q + 1) + (xcd - r) * q) + off; }
        const int nig = WGM * nN, gid = wgid / nig, fm = gid * WGM, gsz = (nM - fm) < WGM ? (nM - fm) : WGM;
        const int pm = fm + ((wgid % nig) % gsz), pn = (wgid % nig) / gsz;
        u.A = (const char*)(A + ((size_t)pm * BM * lda + (size_t)pn * acol) * ESZ); u.B = (const char*)(Bt + (size_t)pn * BM * ldb * ESZ); u.orow0 = pm * BM; u.pn = pn; u.e = 0; u.slot = i; return true;
    }
    __device__ __forceinline__ void a_offs(const GU&, const int (&R)[2], const int (&C)[2], unsigned (&vo)[2][2], LAS unsigned char*, int) const {
#pragma unroll
        for (int h = 0; h < 2; ++h)
#pragma unroll
            for (int i = 0; i < 2; ++i) vo[h][i] = (unsigned)((R[i] + HALF * h) * lda * ESZ + C[i] * 2);
    }
};
template <bool GATHER, int ESZ_> struct ProbMoE {
    static constexpr int ESZ = ESZ_; static constexpr bool BIL = true, AIL = !GATHER;
    const unsigned char* A; const unsigned char* Bt; int ldb, K; int n_my; size_t b_expert_stride  ; LAS unsigned char* ldsp; int nB;
    __device__ __forceinline__ bool next(int i, GU& u) const {
        if (i >= n_my) return false;
        const LAS int* ut = (const LAS int*)(ldsp + L_UT) + i * 8;
        const int e = __builtin_amdgcn_readfirstlane(ut[0]), pn = __builtin_amdgcn_readfirstlane(ut[2]), mtg = __builtin_amdgcn_readfirstlane(ut[3]);
        u.e = e; u.pn = pn; u.orow0 = mtg * BM; u.slot = i;
        u.A = GATHER ? (const char*)A : (const char*)(A + (size_t)mtg * BM * D * ESZ);
        u.B = (const char*)(Bt + (size_t)e * b_expert_stride + (size_t)pn * BM * 16);
        return true;
    }
    __device__ __forceinline__ void a_offs(const GU& u, const int (&R)[2], const int (&C)[2], unsigned (&vo)[2][2], LAS unsigned char* lds, int tid) const {
        if (GATHER) {
            const LAS unsigned* offs = (const LAS unsigned*)(lds + L_OFFS) + u.slot * 256;
#pragma unroll
            for (int h = 0; h < 2; ++h)
#pragma unroll
                for (int i = 0; i < 2; ++i) vo[h][i] = offs[R[i] + HALF * h] + (unsigned)C[i] * 2u;
        } else {
#pragma unroll
            for (int h = 0; h < 2; ++h)
#pragma unroll
                for (int i = 0; i < 2; ++i) { const int sti = (tid >> 6) + 8 * i, aR = (sti >> 1) * 16 + (tid & 15), aC = (sti & 1) * 4 + ((tid >> 4) & 3);
                    vo[h][i] = (unsigned)(aC * (BM * 16) + (aR + HALF * h) * 16); }
        }
    }
};

typedef f32x4 Acc[2][2][4][2];

struct EpiBf16 {
    static constexpr bool PERM = true;
    bf16* O; int ldc; const float* bias; int bias_stride; float scale;
    __device__ __forceinline__ void operator()(const Acc& acc, const GU& u, int wr, int wc, int fr, int fq) const {
        const int row0 = u.orow0 + wr * 64 + fr, col0 = u.pn * BM + wc * 32 + 8 * fq;
        f32x4 bv[2][2];
#pragma unroll
        for (int bj = 0; bj < 2; ++bj)
#pragma unroll
            for (int n = 0; n < 2; ++n) bv[bj][n] = bias ? *(const f32x4*)(bias + (size_t)u.e * bias_stride + col0 + bj * HALF + 4 * n) : (f32x4){0.f, 0.f, 0.f, 0.f};
#pragma unroll
        for (int ai = 0; ai < 2; ++ai)
#pragma unroll
            for (int m = 0; m < 4; ++m) { bf16* rowp = O + (size_t)(row0 + ai * HALF + m * 16) * ldc + col0;
#pragma unroll
                for (int bj = 0; bj < 2; ++bj) { const f32x4 v0 = acc[ai][bj][m][0] * scale + bv[bj][0], v1 = acc[ai][bj][m][1] * scale + bv[bj][1];
                    v4u w; w.x = cvt_pk_bf16(v0[0], v0[1]); w.y = cvt_pk_bf16(v0[2], v0[3]); w.z = cvt_pk_bf16(v1[0], v1[1]); w.w = cvt_pk_bf16(v1[2], v1[3]);
                    *(v4u*)(rowp + bj * HALF) = w; } }
    }
};
struct EpiResid {
    static constexpr bool PERM = false;
    const float* Base; float* Out; const float* gate; const float* gate2;
    __device__ __forceinline__ void operator()(const Acc& acc, const GU& u, int wr, int wc, int fr, int fq) const {
        const int row0 = u.orow0 + wr * 64 + fr, col0 = u.pn * BM + wc * 32 + 4 * fq;
#pragma unroll
        for (int bj = 0; bj < 2; ++bj)
#pragma unroll
            for (int n = 0; n < 2; ++n) { const int col = col0 + bj * HALF + n * 16;
                f32x4 gv = *(const f32x4*)(gate + col); if (gate2) gv = gv * *(const f32x4*)(gate2 + col);
#pragma unroll
                for (int ai = 0; ai < 2; ++ai) {
#pragma unroll
                    for (int m = 0; m < 4; ++m) { const size_t off = (size_t)(row0 + ai * HALF + m * 16) * D + col;
                        const f32x4 b4 = *(const f32x4*)(Base + off); *(f32x4*)(Out + off) = b4 + gv * acc[ai][bj][m][n]; }
                    asm volatile("" ::: "memory"); } }
    }
};
struct EpiSwiglu {
    static constexpr bool PERM = true;
    unsigned char* O; const float* bias; float scale;
    __device__ __forceinline__ void operator()(const Acc& acc, const GU& u, int wr, int wc, int fr, int fq) const {
        const int row0 = u.orow0 + wr * 64 + fr, c0 = u.pn * HALF + wc * 32 + 8 * fq;
        const float* bp = bias + (size_t)u.e * 2048 + c0;
        f32x4 bg[2], bu[2];
#pragma unroll
        for (int n = 0; n < 2; ++n) { bg[n] = *(const f32x4*)(bp + 4 * n); bu[n] = *(const f32x4*)(bp + 1024 + 4 * n); }
#pragma unroll
        for (int ai = 0; ai < 2; ++ai)
#pragma unroll
            for (int m = 0; m < 4; ++m) { const int rt_ = wr * 64 + fr + ai * HALF + m * 16, k16_ = c0 >> 4;
                unsigned char* rowp = O + (size_t)u.orow0 * D + ((size_t)k16_ * BM + rt_) * 16 + (c0 & 15);
                float r[8];
#pragma unroll
                for (int n = 0; n < 2; ++n) { const f32x4 g4 = acc[ai][0][m][n] * scale + bg[n], u4 = acc[ai][1][m][n] * scale + bu[n];
#pragma unroll
                    for (int j = 0; j < 4; ++j) { const float g = fminf(g4[j], 7.0f), up = fminf(fmaxf(u4[j], -7.0f), 7.0f);
                        const float sg = __builtin_amdgcn_rcpf(1.0f + __builtin_amdgcn_exp2f(g * (-1.702f * 1.4426950408889634f)));
                        r[n * 4 + j] = (up + 1.0f) * (g * sg); } }
                v2u w; w.x = cvt_pk_fp8x4(r[0], r[1], r[2], r[3]); w.y = cvt_pk_fp8x4(r[4], r[5], r[6], r[7]);
                *(v2u*)rowp = w; }
    }
};

__device__ __forceinline__ const char* uni(const char* p) {
    const unsigned long long v = (unsigned long long)p; const unsigned lo = __builtin_amdgcn_readfirstlane((unsigned)v), hi = __builtin_amdgcn_readfirstlane((unsigned)(v >> 32));
    return (const char*)(((unsigned long long)hi << 32) | lo); }
template <int ESZ> struct FragT;
template <> struct FragT<2> { struct T { bf16x8 k0, k1; };
    static __device__ __forceinline__ T ld(const LAS v4i* p) { T r; r.k0 = __builtin_bit_cast(bf16x8, p[0]); r.k1 = __builtin_bit_cast(bf16x8, p[64]); return r; }
    template <int KK> static __device__ __forceinline__ void mma(const T& b, const T& a, f32x4& c) {
        if (KK == 0) asm volatile("v_mfma_f32_16x16x32_bf16 %0, %1, %2, %0" : "+v"(c) : "v"(b.k0), "v"(a.k0));
        else asm volatile("v_mfma_f32_16x16x32_bf16 %0, %1, %2, %0" : "+v"(c) : "v"(b.k1), "v"(a.k1)); }
    static constexpr int NK = 2; };
template <> struct FragT<1> { typedef v8i T;
    static __device__ __forceinline__ T ld(const LAS v4i* p) { const v4i lo = p[0], hi = p[64]; return __builtin_shufflevector(lo, hi, 0, 1, 2, 3, 4, 5, 6, 7); }
    template <int KK> static __device__ __forceinline__ void mma(const T& b, const T& a, f32x4& c) { asm volatile("v_mfma_f32_16x16x128_f8f6f4 %0, %1, %2, %0" : "+v"(c) : "v"(b), "v"(a)); }
    static constexpr int NK = 1; };

template <class Prob, class Epi>
__device__ __forceinline__ void gemm_phase(LAS unsigned char* lds, const Prob& P, const Epi& E, const int wid) {
    const int lane = fresh_lane(), tid = wid * 64 + lane, wr = wid >> 2, wc = wid & 3, fr = lane & 15, fq = lane >> 4;
    constexpr int ESZ = Prob::ESZ;
    const int K = P.K, nt = K * ESZ / (BK * 2);
    int R[2], C[2]; unsigned voffB[2];
#pragma unroll
    for (int i = 0; i < 2; ++i) { stage_rc(tid * 16 + i * 8192, R[i], C[i]); const int Rb = Epi::PERM ? ((R[i] & ~31) + perm32(R[i] & 31)) : R[i];
        const int sti = wid + 8 * i, bR = (sti >> 1) * 16 + (lane & 15), bC = (sti & 1) * 4 + (lane >> 4);
        voffB[i] = Prob::BIL ? (unsigned)(bC * (P.nB * 16) + bR * 16) : (unsigned)(Rb * P.ldb * ESZ + C[i] * 2); }
    const size_t kstep = (size_t)(BK * 2);
    const size_t kstepA = Prob::AIL ? (size_t)8 * BM * 16 : kstep;
    const size_t kstepB = Prob::BIL ? (size_t)8 * P.nB * 16 : kstep;
    const size_t hstepB = Prob::BIL ? (size_t)HALF * 16 : (size_t)HALF * P.ldb * ESZ;
    const unsigned ldsw = (unsigned)wid * 1024u;
    const int aoff = Prob::AIL ? (wr * 8192 + fq * 256 + fr * 16) : lds_byte(wr * 64 + fr, fq * 8), boff = Prob::BIL ? (wc * 4096 + fq * 256 + fr * 16) : lds_byte(wc * 32 + fr, fq * 8);
#define PG8_SA(b, h) (((b) * 2 + (h)) * HTB)
#define PG8_SB(b, h) ((4 + (b) * 2 + (h)) * HTB)
#define PG8_STAGE(bufoff, gbase, voff) do { _Pragma("unroll") for (int _i = 0; _i < 2; ++_i) { unsigned o_ = (voff)[_i]; asm volatile("" : "+v"(o_));     \
        __builtin_amdgcn_global_load_lds((const unsigned*)((const char*)(gbase) + o_), (LAS unsigned*)(lds + (bufoff) + ldsw + _i * 8192), 16, 0, 0); } } while (0)
#define PG8_LD2(p) FragT<ESZ>::ld((const LAS v4i*)(p))
#define PG8_LDA(dst, b, h) do { _Pragma("unroll") for (int m = 0; m < 4; ++m) dst[m] = PG8_LD2(lds + PG8_SA(b, h) + aoff + m * 2048); } while (0)
#define PG8_LDB(dst, b, h) do { _Pragma("unroll") for (int n = 0; n < 2; ++n) dst[n] = PG8_LD2(lds + PG8_SB(b, h) + boff + n * 2048); } while (0)
#define PG8_MMA(ai, bj, At, Bt) do { __builtin_amdgcn_s_setprio(1); \
        _Pragma("unroll") for (int m = 0; m < 4; ++m) _Pragma("unroll") for (int n = 0; n < 2; ++n) FragT<ESZ>::template mma<0>(Bt[n], At[m], acc[ai][bj][m][n]); \
        if constexpr (FragT<ESZ>::NK == 2) { _Pragma("unroll") for (int m = 0; m < 4; ++m) _Pragma("unroll") for (int n = 0; n < 2; ++n) FragT<ESZ>::template mma<1>(Bt[n], At[m], acc[ai][bj][m][n]); } \
        __builtin_amdgcn_s_setprio(0); } while (0)
#define PG8_WAIT_V(n) asm volatile("s_waitcnt vmcnt(" #n ")" ::: "memory")
#define PG8_WAIT_L(n) asm volatile("s_waitcnt lgkmcnt(" #n ")" ::: "memory")
#define PG8_BAR __builtin_amdgcn_s_barrier()
#define PG8_SCHED __builtin_amdgcn_sched_barrier(0)
    GU cur, nxt; int ui = 0;
    if (!P.next(0, cur)) return;
    Acc acc;
#pragma unroll
    for (int a = 0; a < 2; ++a)
#pragma unroll
        for (int b = 0; b < 2; ++b)
#pragma unroll
            for (int m = 0; m < 4; ++m)
#pragma unroll
                for (int n = 0; n < 2; ++n) acc[a][b][m][n] = (f32x4){0.f, 0.f, 0.f, 0.f};
    typename FragT<ESZ>::T At[4], B0[2], B1[2];
    unsigned cvo[2][2];
    P.a_offs(cur, R, C, cvo, lds, tid);
    const char* cA = uni(cur.A); const char* cB = uni(cur.B);
    PG8_STAGE(PG8_SB(0, 0), cB, voffB); PG8_STAGE(PG8_SB(0, 1), cB + hstepB, voffB); PG8_STAGE(PG8_SA(0, 0), cA, cvo[0]); PG8_STAGE(PG8_SA(0, 1), cA, cvo[1]);
    if (wr == 1) PG8_BAR;
    PG8_WAIT_V(2); PG8_BAR;
    PG8_STAGE(PG8_SB(1, 0), cB + kstepB, voffB); PG8_STAGE(PG8_SA(1, 0), cA + kstepA, cvo[0]); PG8_STAGE(PG8_SB(1, 1), cB + hstepB + kstepB, voffB);
    PG8_WAIT_V(6); PG8_BAR;
    for (;;) {
        const bool has_next = P.next(ui + 1, nxt);
        const char* nA = uni(has_next ? nxt.A : cA); const char* nB = uni(has_next ? nxt.B : cB);
#define PG8_KBODY(VA2) do { \
              \
            PG8_LDB(B0, 0, 0); PG8_LDB(B1, 0, 1); PG8_SCHED; PG8_LDA(At, 0, 0); PG8_STAGE(PG8_SA(1, 1), a1, cvo[1]); \
            PG8_WAIT_V(8); PG8_WAIT_L(0); PG8_BAR; PG8_MMA(0, 0, At, B0); PG8_MMA(0, 1, At, B1); PG8_BAR; PG8_SCHED; \
              \
            PG8_LDA(At, 0, 1); PG8_STAGE(PG8_SB(0, 0), b2, voffB); PG8_STAGE(PG8_SB(0, 1), b2 + hstepB, voffB); PG8_STAGE(PG8_SA(0, 0), a2, VA2[0]); \
            PG8_WAIT_V(8); PG8_WAIT_L(0); PG8_BAR; PG8_MMA(1, 0, At, B0); PG8_MMA(1, 1, At, B1); PG8_BAR; PG8_SCHED; \
              \
            PG8_LDB(B0, 1, 0); PG8_LDB(B1, 1, 1); PG8_SCHED; PG8_LDA(At, 1, 0); PG8_STAGE(PG8_SA(0, 1), a2, VA2[1]); \
            PG8_WAIT_V(8); PG8_WAIT_L(0); PG8_BAR; PG8_MMA(0, 0, At, B0); PG8_MMA(0, 1, At, B1); PG8_BAR; PG8_SCHED; \
              \
            PG8_LDA(At, 1, 1); PG8_STAGE(PG8_SB(1, 0), b3, voffB); PG8_STAGE(PG8_SB(1, 1), b3 + hstepB, voffB); PG8_STAGE(PG8_SA(1, 0), a3, VA2[0]); \
            PG8_WAIT_V(8); PG8_WAIT_L(0); PG8_BAR; PG8_MMA(1, 0, At, B0); PG8_MMA(1, 1, At, B1); PG8_BAR; PG8_SCHED; } while (0)
        for (int t = 0; t < nt - 2; t += 2) {
            const char* a1 = cA + (size_t)(t + 1) * kstepA; const char* a2 = cA + (size_t)(t + 2) * kstepA; const char* b2 = cB + (size_t)(t + 2) * kstepB;
            const char* a3 = a2 + kstepA; const char* b3 = b2 + kstepB;
            PG8_KBODY(cvo);
        }
        unsigned nv[2][2];
        {
            if (has_next) {
                int l2_; asm volatile("v_mbcnt_lo_u32_b32 %0, -1, 0\n\tv_mbcnt_hi_u32_b32 %0, -1, %0" : "=v"(l2_)); int R2[2], C2[2];
#pragma unroll
                for (int i = 0; i < 2; ++i) stage_rc((wid * 64 + l2_) * 16 + i * 8192, R2[i], C2[i]);
                P.a_offs(nxt, R2, C2, nv, lds, wid * 64 + l2_);
            } else {
#pragma unroll
                for (int h = 0; h < 2; ++h)
#pragma unroll
                    for (int i = 0; i < 2; ++i) nv[h][i] = cvo[h][i]; }
            const char* a1 = cA + (size_t)(nt - 1) * kstepA; const char* a2 = nA; const char* b2 = nB; const char* a3 = a2 + kstepA; const char* b3 = b2 + kstepB;
            PG8_KBODY(nv);
        }
#undef PG8_KBODY
        asm volatile("s_nop 7\n\ts_nop 7\n\ts_nop 7" ::: "memory");
        if (wr == 0) PG8_BAR;
        { int l3_; asm volatile("v_mbcnt_lo_u32_b32 %0, -1, 0\n\tv_mbcnt_hi_u32_b32 %0, -1, %0" : "=v"(l3_));
          E(acc, cur, wr, wc, l3_ & 15, l3_ >> 4); }
        if (!has_next) break;
#pragma unroll
        for (int a = 0; a < 2; ++a)
#pragma unroll
            for (int b = 0; b < 2; ++b)
#pragma unroll
                for (int m = 0; m < 4; ++m)
#pragma unroll
                    for (int n = 0; n < 2; ++n) acc[a][b][m][n] = (f32x4){0.f, 0.f, 0.f, 0.f};
        cur = nxt; cA = nA; cB = nB; ++ui;
#pragma unroll
        for (int h = 0; h < 2; ++h)
#pragma unroll
            for (int i = 0; i < 2; ++i) cvo[h][i] = nv[h][i];
        if (wr == 1) PG8_BAR;
    }
    PG8_WAIT_V(0);
    PG8_BAR;
#undef PG8_SA
#undef PG8_SB
#undef PG8_STAGE
#undef PG8_LDA
#undef PG8_LDB
#undef PG8_MMA
#undef PG8_LD2
#undef PG8_WAIT_V
#undef PG8_WAIT_L
#undef PG8_BAR
#undef PG8_SCHED
}
}

namespace att {
constexpr int NW = 8, QBLK = 32, KVBLK = 64;
constexpr float SCALE = 0.088388347648318440f;
constexpr float THR = 8.f;
constexpr int LDQ = NQKV, LDK = NQKV, LDO = D;
constexpr int SHM_V = KVBLK * HD * 2, SHM_K = KVBLK * HD * 2, SHM_ATTN = 2 * SHM_V + 2 * SHM_K + NW * 64 * 4;
#define KSWZ(row, colB) ((row) * 256 + ((colB) ^ (((row) & 7) << 4)))
#define SBAR() __builtin_amdgcn_sched_barrier(0)
__device__ __forceinline__ int crow(int r, int hi) { return (r & 3) + 8 * (r >> 2) + 4 * hi; }
__device__ __forceinline__ void partialSM(f32x16& p0, f32x16& p1, float& m_reg, float& mn, float& alpha) {
    constexpr float C = 1.0f;
    float pmax = p0[0];
#pragma unroll
    for (int r = 1; r < 16; ++r) pmax = fmaxf(pmax, p0[r]);
#pragma unroll
    for (int r = 0; r < 16; ++r) pmax = fmaxf(pmax, p1[r]);
    { auto rr = __builtin_amdgcn_permlane32_swap(__float_as_uint(pmax), __float_as_uint(pmax), false, false);
      pmax = fmaxf(__uint_as_float(rr[0]), __uint_as_float(rr[1])); }
    if (__builtin_expect(__all(pmax - m_reg <= THR * 1.4426950408889634f), 1)) { mn = m_reg; alpha = 1.f; }
    else { mn = fmaxf(m_reg, pmax); alpha = __builtin_amdgcn_exp2f((m_reg - mn) * C); m_reg = mn; }
    const float mnC = -mn * C;
#pragma unroll
    for (int r = 0; r < 16; ++r) p0[r] = fmaf(p0[r], C, mnC);
#pragma unroll
    for (int r = 0; r < 16; ++r) p1[r] = fmaf(p1[r], C, mnC);
#pragma unroll
    for (int r = 0; r < 16; ++r) p0[r] = __builtin_amdgcn_exp2f(p0[r]);
}
__device__ __forceinline__ void finishSM(f32x16& p0, f32x16& p1, float alpha, float& l_reg, bf16x8& pa0, bf16x8& pa1, bf16x8& pa2, bf16x8& pa3) {
#pragma unroll
    for (int r = 0; r < 16; ++r) p1[r] = __builtin_amdgcn_exp2f(p1[r]);
    float ps = 0;
#pragma unroll
    for (int r = 0; r < 16; ++r) ps += p0[r];
#pragma unroll
    for (int r = 0; r < 16; ++r) ps += p1[r];
    { auto rr = __builtin_amdgcn_permlane32_swap(__float_as_uint(ps), __float_as_uint(ps), false, false);
      ps = __uint_as_float(rr[0]) + __uint_as_float(rr[1]); }
    l_reg = l_reg * alpha + ps;
#define PK4(P, BASE, OUT) do { unsigned a0 = cvt_pk_bf16(P[BASE + 0], P[BASE + 1]), a1 = cvt_pk_bf16(P[BASE + 2], P[BASE + 3]);   \
    unsigned b0 = cvt_pk_bf16(P[BASE + 4], P[BASE + 5]), b1 = cvt_pk_bf16(P[BASE + 6], P[BASE + 7]);                              \
    auto r0 = __builtin_amdgcn_permlane32_swap(a0, b0, false, false); auto r1 = __builtin_amdgcn_permlane32_swap(a1, b1, false, false); \
    v4u w = {r0[0], r1[0], r0[1], r1[1]}; OUT = *reinterpret_cast<bf16x8*>(&w); } while (0)
    PK4(p0, 0, pa0); PK4(p0, 8, pa1); PK4(p1, 0, pa2); PK4(p1, 8, pa3);
#undef PK4
}
__device__ __forceinline__ void qkt(f32x16& p0, f32x16& p1, const LAS char* Ks, const bf16x8* qr, int r32, int hi) {
    p0 = f32x16{}; p1 = f32x16{};
#pragma unroll
    for (int d0 = 0; d0 < 8; ++d0) {
        const int a4 = r32 * 256 + ((((d0 & 3) * 32) + hi * 16) ^ ((r32 & 7) << 4));
        const bf16x8 b0 = *reinterpret_cast<const LAS bf16x8*>(Ks + a4 + (d0 >> 2) * 128);
        const bf16x8 b1 = *reinterpret_cast<const LAS bf16x8*>(Ks + a4 + (d0 >> 2) * 128 + 8192);
        p0 = __builtin_amdgcn_mfma_f32_32x32x16_bf16(b0, qr[d0], p0, 0, 0, 0);
        p1 = __builtin_amdgcn_mfma_f32_32x32x16_bf16(b1, qr[d0], p1, 0, 0, 0); }
}
__device__ __forceinline__ int v_st(int k, int c) { const int kk = (k & ~0xC) | ((k & 4) << 1) | ((k & 8) >> 1); return ((kk >> 3) * 4 + (c >> 5)) * 512 + ((kk & 7) * 32 + (c & 31)) * 2; }
__device__ __forceinline__ int v_rd_base(int lane) { return ((lane & 3) << 3) | (((lane >> 2) & 3) << 6) | (((lane >> 4) & 1) << 5) | (((lane >> 5) & 1) << 8); }
constexpr int v_rd_off(int d0, int ks, int half) { return d0 * 512 + ks * 4096 + half * 2048; }
template <int OFF> __device__ __forceinline__ s16x4 tr_read(int vb) {
    s16x4 r; asm volatile("ds_read_b64_tr_b16 %0, %1 offset:%2" : "=&v"(r) : "v"(vb), "i"(OFF) : "memory"); return r;
}
template <int D0> __device__ __forceinline__ void pv_one(f32x16& od, int vb, bf16x8 pa0, bf16x8 pa1, bf16x8 pa2, bf16x8 pa3) {
    const s16x4 l0 = tr_read<v_rd_off(D0, 0, 0)>(vb), h0 = tr_read<v_rd_off(D0, 0, 1)>(vb), l1 = tr_read<v_rd_off(D0, 1, 0)>(vb), h1 = tr_read<v_rd_off(D0, 1, 1)>(vb);
    const s16x4 l2 = tr_read<v_rd_off(D0, 2, 0)>(vb), h2 = tr_read<v_rd_off(D0, 2, 1)>(vb), l3 = tr_read<v_rd_off(D0, 3, 0)>(vb), h3 = tr_read<v_rd_off(D0, 3, 1)>(vb);
    asm volatile("s_waitcnt lgkmcnt(0)" ::: "memory"); SBAR();
#define PK(L, H) (bf16x8){L[0], L[1], L[2], L[3], H[0], H[1], H[2], H[3]}
    od = __builtin_amdgcn_mfma_f32_32x32x16_bf16(pa0, PK(l0, h0), od, 0, 0, 0);
    od = __builtin_amdgcn_mfma_f32_32x32x16_bf16(pa1, PK(l1, h1), od, 0, 0, 0);
    od = __builtin_amdgcn_mfma_f32_32x32x16_bf16(pa2, PK(l2, h2), od, 0, 0, 0);
    od = __builtin_amdgcn_mfma_f32_32x32x16_bf16(pa3, PK(l3, h3), od, 0, 0, 0);
#undef PK
}
__device__ __forceinline__ void pv_d0(f32x16* o, int vb, bf16x8 pa0, bf16x8 pa1, bf16x8 pa2, bf16x8 pa3) {
    pv_one<0>(o[0], vb, pa0, pa1, pa2, pa3); pv_one<1>(o[1], vb, pa0, pa1, pa2, pa3); pv_one<2>(o[2], vb, pa0, pa1, pa2, pa3); pv_one<3>(o[3], vb, pa0, pa1, pa2, pa3);
}
__device__ __forceinline__ void attn_dense_body(const bf16* __restrict__ Qb, const bf16* __restrict__ Kh, const bf16* __restrict__ Vh, bf16* __restrict__ Ob, int seq, LAS char* lds, const int wid) {
    const int lane = fresh_lane(), tid = wid * 64 + lane, r32 = lane & 31, hi = lane >> 5;
    LAS char* V_lds = lds; LAS char* K_lds = lds + 2 * SHM_V;
    LAS float* ws = (LAS float*)(lds + 2 * SHM_V + 2 * SHM_K) + wid * 64; LAS float* li_l = ws; LAS float* al_l = ws + 32;
    float m_reg = -1e30f, l_reg = 0; f32x16 o[4] = {}; bf16x8 qr[8];
    const bf16* Qw = Qb + (long)(wid * QBLK + r32) * LDQ + hi * 8;
#pragma unroll
    for (int d0 = 0; d0 < 8; ++d0) qr[d0] = *reinterpret_cast<const bf16x8*>(Qw + d0 * 16);
    const int sr = tid >> 4, sc = (tid & 15) * 8, vst0 = v_st(sr, sc), vst1 = v_st(32 + sr, sc);
    const int vb0 = (int)(unsigned)(uintptr_t)V_lds + v_rd_base(lane);
    struct { bf16x8 vs0, vs1, ks0, ks1; } sr_[2];
#define SLOAD(i, k0) do { sr_[i].vs0 = *reinterpret_cast<const bf16x8*>(&Vh[(long)((k0) + sr) * LDK + sc]); sr_[i].vs1 = *reinterpret_cast<const bf16x8*>(&Vh[(long)((k0) + 32 + sr) * LDK + sc]); \
    sr_[i].ks0 = *reinterpret_cast<const bf16x8*>(&Kh[(long)((k0) + sr) * LDK + sc]); sr_[i].ks1 = *reinterpret_cast<const bf16x8*>(&Kh[(long)((k0) + 32 + sr) * LDK + sc]); } while (0)
#define SWRITE(b, i) do { *(LAS bf16x8*)(V_lds + (b) * SHM_V + vst0) = sr_[i].vs0;          \
    *(LAS bf16x8*)(V_lds + (b) * SHM_V + vst1) = sr_[i].vs1; const int kc = sc * 2;               \
    *(LAS bf16x8*)(K_lds + (b) * SHM_K + KSWZ(sr, kc)) = sr_[i].ks0;                       \
    *(LAS bf16x8*)(K_lds + (b) * SHM_K + KSWZ(32 + sr, kc)) = sr_[i].ks1; } while (0)
#define SWAIT() asm volatile("s_waitcnt vmcnt(4)" ::: "memory")
#define RESC(a) do { if (__any((a) < 1.f)) { if (hi == 0) al_l[r32] = (a); asm volatile("s_waitcnt lgkmcnt(0)" ::: "memory"); \
    _Pragma("unroll") for (int d = 0; d < 4; ++d) _Pragma("unroll") for (int r = 0; r < 16; ++r) o[d][r] *= al_l[crow(r, hi)]; } } while (0)
    f32x16 pA0, pA1, pB0, pB1; float mnA, mnB, alA, alB; bf16x8 pa0, pa1, pa2, pa3; const int NT = seq / KVBLK;
    constexpr int SE = 0, SO = 1;
    SLOAD(SE, 0); asm volatile("s_waitcnt vmcnt(0)" ::: "memory"); SWRITE(0, SE); __syncthreads();
    qkt(pA0, pA1, K_lds, qr, r32, hi); partialSM(pA0, pA1, m_reg, mnA, alA);
    SLOAD(SO, KVBLK); if (2 < NT) SLOAD(SE, 2 * KVBLK);
    SWAIT(); SWRITE(1, SO); __syncthreads();
    for (int j = 1; j + 1 < NT; j += 2) {
        SBAR(); qkt(pB0, pB1, K_lds + SHM_K, qr, r32, hi);
        finishSM(pA0, pA1, alA, l_reg, pa0, pa1, pa2, pa3); SBAR();
        SLOAD(SO, (j + 2) * KVBLK); SBAR();
        pv_d0(o, vb0, pa0, pa1, pa2, pa3); partialSM(pB0, pB1, m_reg, mnB, alB);
        __syncthreads(); SWAIT(); SWRITE(0, SE);
        RESC(alB); __syncthreads();
        SBAR(); qkt(pA0, pA1, K_lds, qr, r32, hi);
        finishSM(pB0, pB1, alB, l_reg, pa0, pa1, pa2, pa3); SBAR();
        if (j + 3 < NT) SLOAD(SE, (j + 3) * KVBLK); SBAR();
        pv_d0(o, vb0 + (int)SHM_V, pa0, pa1, pa2, pa3); partialSM(pA0, pA1, m_reg, mnA, alA);
        __syncthreads(); SWAIT(); SWRITE(1, SO);
        RESC(alA); __syncthreads();
    }
    SBAR(); qkt(pB0, pB1, K_lds + SHM_K, qr, r32, hi);
    finishSM(pA0, pA1, alA, l_reg, pa0, pa1, pa2, pa3); SBAR();
    pv_d0(o, vb0, pa0, pa1, pa2, pa3); partialSM(pB0, pB1, m_reg, mnB, alB);
    __syncthreads(); RESC(alB);
    finishSM(pB0, pB1, alB, l_reg, pa0, pa1, pa2, pa3); SBAR();
    pv_d0(o, vb0 + (int)SHM_V, pa0, pa1, pa2, pa3);
    if (hi == 0) li_l[r32] = l_reg; asm volatile("s_waitcnt lgkmcnt(0)" ::: "memory");
    float rli[16];
#pragma unroll
    for (int r = 0; r < 16; ++r) rli[r] = __builtin_amdgcn_rcpf(li_l[crow(r, hi)]);
    bf16* Ow = Ob + (long)(wid * QBLK) * LDO;
#pragma unroll
    for (int r = 0; r < 16; ++r) { const int orow = crow(r, hi);
#pragma unroll
        for (int d0 = 0; d0 < 4; ++d0) { const float v = o[d0][r] * rli[r]; Ow[(long)orow * LDO + d0 * 32 + r32] = (bf16)(cvt_pk_bf16(v, v) & 0xffffu); } }
    __syncthreads();
#undef SLOAD
#undef SWRITE
#undef SWAIT
#undef RESC
}

}


struct WConv { const float* w_gu; const float* w_down; unsigned char* Wgu8; unsigned char* Wd8; };
constexpr int WQ_GU = 64 * 64 * 4, WQ_D = 64 * 64 * 2, WQ_N = WQ_GU + WQ_D;
__device__ __forceinline__ void wquad_src(const WConv& W, int q, int tid, const float*& src  , int& N) {
    if (q < WQ_GU) { N = 2048; src = W.w_gu + (size_t)(q >> 8) * (1024 * 2048) + (size_t)(16 * ((q >> 2) & 63)) * 2048 + 512 * (q & 3); }
    else { q -= WQ_GU; N = 1024; src = W.w_down + (size_t)(q >> 7) * (1024 * 1024) + (size_t)(16 * ((q >> 1) & 63)) * 1024 + 512 * (q & 1); }
}
__device__ __forceinline__ unsigned char* wquad_dst(const WConv& W, int q, int tid) {
    if (q < WQ_GU) { const int n = 512 * (q & 3) + tid, j = n & 1023, np = 256 * (j >> 7) + 128 * (n >> 10) + (j & 127), c = np & 31, rho = 16 * ((c >> 2) & 1) + 4 * (c >> 3) + (c & 3);
        return W.Wgu8 + (size_t)(q >> 8) * (2048 * 1024) + ((size_t)((q >> 2) & 63) * 2048 + (np & ~31) + rho) * 16; }
    q -= WQ_GU; { const int n = 512 * (q & 1) + tid, c = n & 31, rho = 16 * ((c >> 2) & 1) + 4 * (c >> 3) + (c & 3);
        return W.Wd8 + (size_t)(q >> 7) * (1024 * 1024) + ((size_t)((q >> 1) & 63) * 1024 + (n & ~31) + rho) * 16; }
}
__device__ __forceinline__ unsigned wquad_cvt(float a, float b, float c, float d) {
    int w_; const float isc = 1.0f / WSCALE;
    asm volatile("v_cvt_scalef32_pk_fp8_f32 %0, %1, %2, %3" : "=v"(w_) : "v"(a), "v"(b), "s"(isc));
    asm volatile("v_cvt_scalef32_pk_fp8_f32 %0, %1, %2, %3 op_sel:[0,0,0,1]" : "+v"(w_) : "v"(c), "v"(d), "s"(isc));
    return (unsigned)w_;
}
__device__ __forceinline__ void wquad_whole(const WConv& W, int q, int tid) {
    const float* src; int N; wquad_src(W, q, tid, src, N); float r[16];
#pragma unroll
    for (int i = 0; i < 16; ++i) r[i] = src[(size_t)i * N + tid];
    v4u o; o.x = wquad_cvt(r[0], r[1], r[2], r[3]); o.y = wquad_cvt(r[4], r[5], r[6], r[7]); o.z = wquad_cvt(r[8], r[9], r[10], r[11]); o.w = wquad_cvt(r[12], r[13], r[14], r[15]);
    *(v4u*)wquad_dst(W, q, tid) = o;
}

namespace att8 {
constexpr int TB = 8192, NB = 8, VOFF = NB * TB;
static_assert((NTOK / 64) % 8 == 4 && 2 * NB * TB <= 131072, "attn_fp8_body: 4 peeled tiles + whole groups of 8; 8 buffers in the ring");
#define MF8Z(Dd, A, Bv) do { if (VAR != 2) asm volatile("v_mfma_f32_32x32x64_f8f6f4 %0, %1, %2, 0" : "=&v"(Dd) : "v"(A), "v"(Bv)); else asm volatile("v_mov_b32 %0, 0" : "=v"(Dd[0]) : "v"(A), "v"(Bv)); } while (0)
#define MF8(Dd, A, Bv) do { if (VAR != 2) asm volatile("v_mfma_f32_32x32x64_f8f6f4 %0, %1, %2, %0" : "+v"(Dd) : "v"(A), "v"(Bv)); else asm volatile("" : "+v"(Dd) : "v"(A), "v"(Bv)); } while (0)
#define MFP(Dd, A, Bv) do { if (VAR != 2) asm volatile("v_mfma_f32_32x32x64_f8f6f4 %0, %1, %2, %0 cbsz:1" : "+v"(Dd) : "v"(A), "v"(Bv)); else asm volatile("" : "+v"(Dd) : "v"(A), "v"(Bv)); } while (0)
#define FEXP(x) do { if (VAR != 1) asm volatile("v_exp_f32_e32 %0, %0" : "+v"(x)); } while (0)
#define FADD(acc, x) do { if (VAR != 1) asm volatile("v_add_f32_e32 %0, %0, %1" : "+v"(acc) : "v"(x)); } while (0)
#define CVLO(w, a, b) do { if (VAR != 1) asm volatile("v_cvt_scalef32_pk_bf8_f32 %0, %1, %2, %3" : "=v"(w) : "v"(a), "v"(b), "s"(pscale)); else w = 0; } while (0)
#define CVHI(w, a, b) do { if (VAR != 1) asm volatile("v_cvt_scalef32_pk_bf8_f32 %0, %1, %2, %3 op_sel:[0,0,0,1]" : "+v"(w) : "v"(a), "v"(b), "s"(pscale)); } while (0)
__device__ __forceinline__ v8i ld32(const LAS unsigned char* p0, const LAS unsigned char* p1) { const v4i a = *(const LAS v4i*)p0, b = *(const LAS v4i*)p1; return __builtin_shufflevector(a, b, 0, 1, 2, 3, 4, 5, 6, 7); }
__device__ __forceinline__ void softmax8(f32x16& PC0, f32x16& PC1, float& l0, float& l1, v8i& pa, const float pscale) {
    constexpr int VAR = 0;
    int w0, w1, w2, w3, w4, w5, w6, w7;
    FEXP(PC0[0]); FEXP(PC0[1]); FEXP(PC0[2]); FEXP(PC0[3]); FADD(l0, PC0[0]); FEXP(PC0[4]); FADD(l1, PC0[1]); FEXP(PC0[5]); FADD(l0, PC0[2]); FEXP(PC0[6]); FADD(l1, PC0[3]); FEXP(PC0[7]); FADD(l0, PC0[4]); FEXP(PC0[8]); FADD(l1, PC0[5]); FEXP(PC0[9]); FADD(l0, PC0[6]); FEXP(PC0[10]); FADD(l1, PC0[7]); FEXP(PC0[11]); FADD(l0, PC0[8]); FEXP(PC0[12]); FADD(l1, PC0[9]); FEXP(PC0[13]); FADD(l0, PC0[10]); FEXP(PC0[14]); FADD(l1, PC0[11]); FEXP(PC0[15]); FADD(l0, PC0[12]); FEXP(PC1[0]); FADD(l1, PC0[13]); FEXP(PC1[1]); FADD(l0, PC0[14]); FEXP(PC1[2]); FADD(l1, PC0[15]); FEXP(PC1[3]); FADD(l0, PC1[0]); FEXP(PC1[4]); FADD(l1, PC1[1]); FEXP(PC1[5]); FADD(l0, PC1[2]); FEXP(PC1[6]); FADD(l1, PC1[3]); FEXP(PC1[7]); FADD(l0, PC1[4]); FEXP(PC1[8]); FADD(l1, PC1[5]); FEXP(PC1[9]); FADD(l0, PC1[6]); FEXP(PC1[10]); FADD(l1, PC1[7]); FEXP(PC1[11]); FADD(l0, PC1[8]); FEXP(PC1[12]); FADD(l1, PC1[9]); FEXP(PC1[13]); FADD(l0, PC1[10]); FEXP(PC1[14]); FADD(l1, PC1[11]); FEXP(PC1[15]); FADD(l0, PC1[12]); FADD(l1, PC1[13]); FADD(l0, PC1[14]); FADD(l1, PC1[15]); CVLO(w0, PC0[0], PC0[1]); CVHI(w0, PC0[2], PC0[3]); CVLO(w1, PC0[4], PC0[5]); CVHI(w1, PC0[6], PC0[7]); CVLO(w2, PC0[8], PC0[9]); CVHI(w2, PC0[10], PC0[11]); CVLO(w3, PC0[12], PC0[13]); CVHI(w3, PC0[14], PC0[15]); CVLO(w4, PC1[0], PC1[1]); CVHI(w4, PC1[2], PC1[3]); CVLO(w5, PC1[4], PC1[5]); CVHI(w5, PC1[6], PC1[7]); CVLO(w6, PC1[8], PC1[9]); CVHI(w6, PC1[10], PC1[11]); CVLO(w7, PC1[12], PC1[13]); CVHI(w7, PC1[14], PC1[15]);
    pa = (v8i){w0, w1, w2, w3, w4, w5, w6, w7};
}
template <int VAR> __device__ __forceinline__ void attn_fp8_body(const unsigned char* __restrict__ Qb, const unsigned char* __restrict__ Kh, const unsigned char* __restrict__ Vth, bf16* __restrict__ Ob,
                                              int NT, LAS unsigned char* lds, const int wid, const float pscale_in, const WConv& wc, const int wq0, const int wqs) {
    const int lane = fresh_lane(), tid = wid * 64 + lane, r32 = lane & 31, hi = lane >> 5;
    float l0 = 0.f, l1 = 0.f; f32x16 o[4] = {}; v8i qr[2];
    { const unsigned char* qp = Qb + (size_t)(wid * 32 + r32) * D + 32 * hi;
#pragma unroll
      for (int s_ = 0; s_ < 2; ++s_) { const v4i a = *(const v4i*)(qp + 64 * s_), b = *(const v4i*)(qp + 64 * s_ + 16); qr[s_] = __builtin_shufflevector(a, b, 0, 1, 2, 3, 4, 5, 6, 7); } }
    const float pscale = __uint_as_float(__builtin_amdgcn_readfirstlane(__float_as_uint(pscale_in)));
    const int kx = (r32 >> 1) & 7, vx = (r32 >> 2) & 3;
    int ka[2][2], va[2];
#pragma unroll
    for (int s_ = 0; s_ < 2; ++s_)
#pragma unroll
        for (int c = 0; c < 2; ++c) ka[s_][c] = r32 * 128 + (((4 * s_ + 2 * hi + c) ^ kx) << 4);
#pragma unroll
    for (int c = 0; c < 2; ++c) va[c] = VOFF + r32 * 64 + (((2 * hi + c) ^ vx) << 4);
    const int skey = tid >> 3, sch = tid & 7, sd = tid >> 2, svc = tid & 3;
    const int lw = (int)(unsigned)(uintptr_t)lds;
    const int kst = lw + skey * 128 + ((sch ^ ((skey >> 1) & 7)) << 4), vst = lw + VOFF + sd * 64 + ((svc ^ ((sd >> 2) & 3)) << 4);
    const __amdgpu_buffer_rsrc_t krs = __builtin_amdgcn_make_buffer_rsrc((void*)Kh, 0, 0x7fffffff, 0x00020000);
    const __amdgpu_buffer_rsrc_t vrs = __builtin_amdgcn_make_buffer_rsrc((void*)Vth, 0, 0x7fffffff, 0x00020000);
    const int kgo = skey * (NKV * HD) + sch * 16, vgo = tid * 16; int kso = 0, vso = 0;
    v4i ks0, vs0, ks1, vs1;
#define FLOAD(ks, vs) do { ks = __builtin_bit_cast(v4i, __builtin_amdgcn_raw_buffer_load_b128(krs, kgo, kso, 0)); vs = __builtin_bit_cast(v4i, __builtin_amdgcn_raw_buffer_load_b128(vrs, vgo, vso, 0)); \
        if (kso < (NT - 1) * 64 * NKV * HD) { kso += 64 * NKV * HD; vso += 8192; } } while (0)
#define DSW(addr, val, OFF) asm volatile("ds_write_b128 %0, %1 offset:%2" :: "v"(addr), "v"(val), "i"(OFF) : "memory")
#define FWRITE(B, ks, vs) do { DSW(kst, ks, (B) * TB); DSW(vst, vs, (B) * TB); } while (0)
#define KF(B, kb, s_) ((VAR == 5) ? qr[0] : ld32(lds + (B) * TB + (kb) * 4096 + ka[s_][0], lds + (B) * TB + (kb) * 4096 + ka[s_][1]))
#define VF(B, d0) ((VAR == 5) ? qr[1] : ld32(lds + (B) * TB + (d0) * 2048 + va[0], lds + (B) * TB + (d0) * 2048 + va[1]))
    f32x16 pA0, pA1, pB0, pB1; v8i paX, paY; float wrow[16] = {}; unsigned wd0 = 0, wd1 = 0, wd2 = 0; const unsigned tid4 = tid * 4u; int wq_cur = min(wq0, WQ_N - 1), wq_prev = wq_cur, wN = 0; const float* wsrc = nullptr;
    FLOAD(ks0, vs0); FLOAD(ks1, vs1); asm volatile("s_waitcnt vmcnt(0)" ::: "memory"); FWRITE(0, ks0, vs0); FWRITE(1, ks1, vs1);
    FLOAD(ks0, vs0); asm volatile("s_waitcnt vmcnt(0)" ::: "memory"); FWRITE(2, ks0, vs0);
    FLOAD(ks1, vs1); FLOAD(ks0, vs0);
    asm volatile("s_waitcnt lgkmcnt(0)" ::: "memory"); __syncthreads();
    { const v8i k00 = KF(0, 0, 0), k10 = KF(0, 1, 0), k01 = KF(0, 0, 1), k11 = KF(0, 1, 1);
      MF8Z(pA0, k00, qr[0]); MF8Z(pA1, k10, qr[0]); MF8(pA0, k01, qr[1]); MF8(pA1, k11, qr[1]); }
#define FSTEP(PC0, PC1, PN0, PN1, PCUR, PPRV, J, T8, B, EM) do { \
        if (VAR != 6) { if ((T8) & 1) { if ((J) + 3 < NT) FWRITE(((T8) + 3) & 7, ks0, vs0); FLOAD(ks0, vs0); } else { if ((J) + 3 < NT) FWRITE(((T8) + 3) & 7, ks1, vs1); FLOAD(ks1, vs1); } } \
        __builtin_amdgcn_sched_barrier(0); \
        if (VAR != 3) {   \
          const unsigned dw_ = wquad_cvt(wrow[4 * (B)], wrow[4 * (B) + 1], wrow[4 * (B) + 2], wrow[4 * (B) + 3]); \
          if ((B) == 0) wd0 = dw_; else if ((B) == 1) wd1 = dw_; else if ((B) == 2) wd2 = dw_; \
          else if (EM) { v4u o_ = {wd0, wd1, wd2, dw_}; *(v4u*)wquad_dst(wc, wq_prev, tid) = o_; } \
          if ((B) == 0) { if (EM) { wq_prev = wq_cur; wq_cur = min(wq_cur + wqs, WQ_N - 1); } wquad_src(wc, wq_cur, tid, wsrc, wN); }        \
          { unsigned t4_ = tid4; asm volatile("" : "+v"(t4_));        \
            const char* p_ = (const char*)wsrc + (size_t)(4 * (B)) * (unsigned)(wN * 4); \
            _Pragma("unroll") for (int i_ = 0; i_ < 4; ++i_) wrow[4 * (B) + i_] = *(const float*)(p_ + (size_t)i_ * (unsigned)(wN * 4) + t4_); } } \
        __builtin_amdgcn_sched_barrier(0); \
        { int w0, w1, w2, w3, w4, w5, w6, w7; const bool qk_ = (J) + 1 < NT, pv_ = (J) > 0; \
            \
          v8i kA = KF(((T8) + 1) & 7, 0, 0), vA = VF(((T8) + 7) & 7, 0), kB, vB; \
          __builtin_amdgcn_sched_barrier(0); \
          kB = KF(((T8) + 1) & 7, 1, 0); vB = VF(((T8) + 7) & 7, 1); \
          if (qk_) MF8Z(PN0, kA, qr[0]);       G0(PC0, PC1) \
          if (pv_) MFP(o[0], PPRV, vA);        G1(PC0, PC1) \
          __builtin_amdgcn_sched_barrier(0); \
          kA = KF(((T8) + 1) & 7, 0, 1); vA = VF(((T8) + 7) & 7, 2); \
          if (qk_) MF8Z(PN1, kB, qr[0]);       G2(PC0, PC1) \
          if (pv_) MFP(o[1], PPRV, vB);        G3(PC0, PC1) \
          __builtin_amdgcn_sched_barrier(0); \
          kB = KF(((T8) + 1) & 7, 1, 1); vB = VF(((T8) + 7) & 7, 3); \
          if (qk_) MF8(PN0, kA, qr[1]);        G4(PC0, PC1) \
          if (pv_) MFP(o[2], PPRV, vA);        G5(PC0, PC1) \
          __builtin_amdgcn_sched_barrier(0); \
          if (qk_) MF8(PN1, kB, qr[1]);        G6(PC0, PC1) \
          if (pv_) MFP(o[3], PPRV, vB);        G7(PC0, PC1) \
          PCUR = (v8i){w0, w1, w2, w3, w4, w5, w6, w7}; } \
        if ((T8) & 1) { asm volatile("s_waitcnt lgkmcnt(0)" ::: "memory"); if (VAR != 4) __syncthreads(); } } while (0)
#define G0(PC0, PC1) FEXP(PC0[0]); FEXP(PC0[1]); FEXP(PC0[2]); FEXP(PC0[3]); FADD(l0, PC0[0]); FEXP(PC0[4]); FADD(l1, PC0[1]); FEXP(PC0[5]); FADD(l0, PC0[2]); FEXP(PC0[6]);
#define G1(PC0, PC1) FADD(l1, PC0[3]); FEXP(PC0[7]); FADD(l0, PC0[4]); FEXP(PC0[8]); FADD(l1, PC0[5]); FEXP(PC0[9]); FADD(l0, PC0[6]); FEXP(PC0[10]); FADD(l1, PC0[7]); FEXP(PC0[11]);
#define G2(PC0, PC1) FADD(l0, PC0[8]); FEXP(PC0[12]); FADD(l1, PC0[9]); FEXP(PC0[13]); FADD(l0, PC0[10]); FEXP(PC0[14]); FADD(l1, PC0[11]); FEXP(PC0[15]); FADD(l0, PC0[12]); FEXP(PC1[0]);
#define G3(PC0, PC1) FADD(l1, PC0[13]); FEXP(PC1[1]); FADD(l0, PC0[14]); FEXP(PC1[2]); FADD(l1, PC0[15]); FEXP(PC1[3]); FADD(l0, PC1[0]); FEXP(PC1[4]); FADD(l1, PC1[1]); FEXP(PC1[5]);
#define G4(PC0, PC1) FADD(l0, PC1[2]); FEXP(PC1[6]); FADD(l1, PC1[3]); FEXP(PC1[7]); FADD(l0, PC1[4]); FEXP(PC1[8]); FADD(l1, PC1[5]); FEXP(PC1[9]); FADD(l0, PC1[6]); FEXP(PC1[10]);
#define G5(PC0, PC1) FADD(l1, PC1[7]); FEXP(PC1[11]); FADD(l0, PC1[8]); FEXP(PC1[12]); FADD(l1, PC1[9]); FEXP(PC1[13]); FADD(l0, PC1[10]); FEXP(PC1[14]); FADD(l1, PC1[11]); FEXP(PC1[15]);
#define G6(PC0, PC1) FADD(l0, PC1[12]); FADD(l1, PC1[13]); FADD(l0, PC1[14]); FADD(l1, PC1[15]); CVLO(w0, PC0[0], PC0[1]); CVHI(w0, PC0[2], PC0[3]); CVLO(w1, PC0[4], PC0[5]); CVHI(w1, PC0[6], PC0[7]); CVLO(w2, PC0[8], PC0[9]); CVHI(w2, PC0[10], PC0[11]);
#define G7(PC0, PC1) CVLO(w3, PC0[12], PC0[13]); CVHI(w3, PC0[14], PC0[15]); CVLO(w4, PC1[0], PC1[1]); CVHI(w4, PC1[2], PC1[3]); CVLO(w5, PC1[4], PC1[5]); CVHI(w5, PC1[6], PC1[7]); CVLO(w6, PC1[8], PC1[9]); CVHI(w6, PC1[10], PC1[11]); CVLO(w7, PC1[12], PC1[13]); CVHI(w7, PC1[14], PC1[15]);
    FSTEP(pA0, pA1, pB0, pB1, paX, paY, 0, 0, 0, 0); FSTEP(pB0, pB1, pA0, pA1, paY, paX, 1, 1, 1, 0); FSTEP(pA0, pA1, pB0, pB1, paX, paY, 2, 2, 2, 0); FSTEP(pB0, pB1, pA0, pA1, paY, paX, 3, 3, 3, 0);
    for (int j = 4; j < NT; j += 8) {
        FSTEP(pA0, pA1, pB0, pB1, paX, paY, j, 4, 0, 1); FSTEP(pB0, pB1, pA0, pA1, paY, paX, j + 1, 5, 1, 1); FSTEP(pA0, pA1, pB0, pB1, paX, paY, j + 2, 6, 2, 1); FSTEP(pB0, pB1, pA0, pA1, paY, paX, j + 3, 7, 3, 1);
        FSTEP(pA0, pA1, pB0, pB1, paX, paY, j + 4, 0, 0, 1); FSTEP(pB0, pB1, pA0, pA1, paY, paX, j + 5, 1, 1, 1); FSTEP(pA0, pA1, pB0, pB1, paX, paY, j + 6, 2, 2, 1); FSTEP(pB0, pB1, pA0, pA1, paY, paX, j + 7, 3, 3, 1); }
    {
        v4u o_ = {wquad_cvt(wrow[0], wrow[1], wrow[2], wrow[3]), wquad_cvt(wrow[4], wrow[5], wrow[6], wrow[7]), wquad_cvt(wrow[8], wrow[9], wrow[10], wrow[11]), wquad_cvt(wrow[12], wrow[13], wrow[14], wrow[15])};
        *(v4u*)wquad_dst(wc, wq_cur, tid) = o_;
    }
    {
        const v8i v0 = VF(3, 0), v1 = VF(3, 1), v2 = VF(3, 2), v3 = VF(3, 3);
        asm volatile("s_nop 4" ::: "memory");
        MFP(o[0], paY, v0); MFP(o[1], paY, v1); MFP(o[2], paY, v2); MFP(o[3], paY, v3);
        asm volatile("s_waitcnt lgkmcnt(0)" ::: "memory"); __syncthreads(); }
    asm volatile("s_nop 7\n\ts_nop 7\n\ts_nop 7" ::: "memory");
    float l_part = l0 + l1;
    { auto rr = __builtin_amdgcn_permlane32_swap(__float_as_uint(l_part), __float_as_uint(l_part), false, false); l_part = __uint_as_float(rr[0]) + __uint_as_float(rr[1]); }
    const int lane2 = fresh_lane(), r32e = lane2 & 31, hie = lane2 >> 5;
    LAS float* li_l = (LAS float*)(lds + L_OFFS) + wid * 64;
    if (hie == 0) li_l[r32e] = l_part; asm volatile("s_waitcnt lgkmcnt(0)" ::: "memory");
    float rli[16];
#pragma unroll
    for (int r = 0; r < 16; ++r) rli[r] = pscale * __builtin_amdgcn_rcpf(li_l[att::crow(r, hie)]);
    bf16* Ow = Ob + (size_t)(wid * 32) * D;
#pragma unroll
    for (int r = 0; r < 16; ++r) { const int orow = att::crow(r, hie);
#pragma unroll
        for (int d0 = 0; d0 < 4; ++d0) { const float v = o[d0][r] * rli[r]; Ow[(size_t)orow * D + d0 * 32 + r32e] = (bf16)(cvt_pk_bf16(v, v) & 0xffffu); } }
    __syncthreads();
#undef FLOAD
#undef DSW
#undef FWRITE
#undef KF
#undef VF
#undef FSTEP
#undef G0
#undef G1
#undef G2
#undef G3
#undef G4
#undef G5
#undef G6
#undef G7
}
#undef MF8Z
#undef MF8
#undef MFP
#undef FEXP
#undef FADD
#undef CVLO
#undef CVHI
}

__device__ __forceinline__ void ld_row(const float* row, int lane, f32x4 (&v)[4]) {
#pragma unroll
    for (int j = 0; j < 4; ++j) v[j] = *(const f32x4*)(row + 4 * lane + 256 * j);
}
__device__ __forceinline__ void ld_row_bf16(const bf16* row, int lane, f32x4 (&v)[4]) {
#pragma unroll
    for (int j = 0; j < 4; ++j) { const v2u w = *(const v2u*)(row + 4 * lane + 256 * j); v[j] = (f32x4){bf_lo(w.x), bf_hi(w.x), bf_lo(w.y), bf_hi(w.y)}; }
}
__device__ __forceinline__ void st_row(float* row, int lane, const f32x4 (&v)[4]) {
#pragma unroll
    for (int j = 0; j < 4; ++j) *(f32x4*)(row + 4 * lane + 256 * j) = v[j];
}
__device__ __forceinline__ void st_row_bf16(bf16* row, int lane, const f32x4 (&v)[4]) {
#pragma unroll
    for (int j = 0; j < 4; ++j) { v2u w; w.x = cvt_pk_bf16(v[j][0], v[j][1]); w.y = cvt_pk_bf16(v[j][2], v[j][3]); *(v2u*)(row + 4 * lane + 256 * j) = w; }
}
__device__ __forceinline__ void st_row_fp8(unsigned char* row, int lane, const f32x4 (&v)[4]) {
#pragma unroll
    for (int j = 0; j < 4; ++j) *(unsigned*)(row + 4 * lane + 256 * j) = cvt_pk_fp8x4(v[j][0], v[j][1], v[j][2], v[j][3]);
}
__device__ __forceinline__ float row_rstd(const f32x4 (&v)[4]) {
    float s = 0.f;
#pragma unroll
    for (int j = 0; j < 4; ++j) s += (v[j][0] * v[j][0] + v[j][1] * v[j][1]) + (v[j][2] * v[j][2] + v[j][3] * v[j][3]);
    return 1.0f / sqrtf(wave_sum(s) * (1.0f / D) + NORM_EPS);
}

struct Args { const float* in[21]; float* out; unsigned char* ws; int ph_lo, ph_hi, var, pad; };

__device__ __forceinline__ void transpose_item(const float* W, int N, int k0, int n0, bf16* dst, int K, LAS float* scr, int lane) {
    f32x4 v[8];
#pragma unroll
    for (int i = 0; i < 8; ++i) v[i] = *(const f32x4*)(W + (size_t)(k0 + (lane >> 3) + 8 * i) * N + n0 + (lane & 7) * 4);
#pragma unroll
    for (int i = 0; i < 8; ++i) { LAS float* d = scr + ((lane >> 3) + 8 * i) * 33 + (lane & 7) * 4; d[0] = v[i][0]; d[1] = v[i][1]; d[2] = v[i][2]; d[3] = v[i][3]; }
    LDS_WAIT(); asm volatile("" ::: "memory");
    const int c = lane & 7;
#pragma unroll
    for (int j = 0; j < 4; ++j) { const int n = (lane >> 3) + 8 * j; const LAS float* s = scr + (8 * c) * 33 + n;
        v4u o; o.x = cvt_pk_bf16(s[0 * 33], s[1 * 33]); o.y = cvt_pk_bf16(s[2 * 33], s[3 * 33]); o.z = cvt_pk_bf16(s[4 * 33], s[5 * 33]); o.w = cvt_pk_bf16(s[6 * 33], s[7 * 33]);
        *(v4u*)(dst + (size_t)n * K + 8 * c) = o; }
    LDS_WAIT(); asm volatile("" ::: "memory");
}

__device__ __forceinline__ void transpose_item_fp8(const float* W, int N, int k0, int n0, unsigned char* dst, int K, LAS float* scr, int lane, float scale) {
    f32x4 v[8];
#pragma unroll
    for (int i = 0; i < 8; ++i) v[i] = *(const f32x4*)(W + (size_t)(k0 + (lane >> 3) + 8 * i) * N + n0 + (lane & 7) * 4);
#pragma unroll
    for (int i = 0; i < 8; ++i) { LAS float* d = scr + ((lane >> 3) + 8 * i) * 33 + (lane & 7) * 4; d[0] = v[i][0] * scale; d[1] = v[i][1] * scale; d[2] = v[i][2] * scale; d[3] = v[i][3] * scale; }
    LDS_WAIT(); asm volatile("" ::: "memory");
    const int n = lane >> 1, kh = lane & 1; const LAS float* s = scr + (32 * kh) * 33 + n;
    v4u o0, o1;
    o0.x = cvt_pk_fp8x4(s[0 * 33], s[1 * 33], s[2 * 33], s[3 * 33]);     o0.y = cvt_pk_fp8x4(s[4 * 33], s[5 * 33], s[6 * 33], s[7 * 33]);
    o0.z = cvt_pk_fp8x4(s[8 * 33], s[9 * 33], s[10 * 33], s[11 * 33]);   o0.w = cvt_pk_fp8x4(s[12 * 33], s[13 * 33], s[14 * 33], s[15 * 33]);
    o1.x = cvt_pk_fp8x4(s[16 * 33], s[17 * 33], s[18 * 33], s[19 * 33]); o1.y = cvt_pk_fp8x4(s[20 * 33], s[21 * 33], s[22 * 33], s[23 * 33]);
    o1.z = cvt_pk_fp8x4(s[24 * 33], s[25 * 33], s[26 * 33], s[27 * 33]); o1.w = cvt_pk_fp8x4(s[28 * 33], s[29 * 33], s[30 * 33], s[31 * 33]);
    unsigned char* dp = dst + (size_t)n * K + 32 * kh;
    *(v4u*)dp = o0; *(v4u*)(dp + 16) = o1;
    LDS_WAIT(); asm volatile("" ::: "memory");
}

__device__ __forceinline__ int moe_build_units(LAS unsigned char* lds, const unsigned* gcnt, const int* tok_list, int NPN, bool gather, int rowbytes, int G, int c, const int tid) {
    const int lane = tid & 63;
    LAS unsigned* tb = (LAS unsigned*)(lds + L_TB); LAS unsigned* lc = (LAS unsigned*)(lds + L_CNT); LAS int* ut = (LAS int*)(lds + L_UT);
    if (tid < 64) {
        unsigned cnt = (lane < NE) ? __hip_atomic_load(gcnt + 64 * lane, RLX_AGENT) : 0u;
        unsigned tiles = (cnt + 255u) >> 8, incl = tiles;
#pragma unroll
        for (int o = 1; o < 32; o <<= 1) { const unsigned t = __shfl_up(incl, o); if (lane >= o) incl += t; }
        if (lane < NE) { tb[lane + 1] = incl; lc[lane] = cnt; }
        if (lane == 0) tb[0] = 0u;
    }
    __syncthreads();
    const int T = (int)tb[NE], nunits = T * NPN;
    int n_my = 0; { const int rem = nunits - c; n_my = rem > 0 ? (rem + G - 1) / G : 0; if (n_my > 16) n_my = 16; }
    if (tid < n_my) {
        int L = tid * G + c; const int q = nunits / 8, r = nunits % 8, xcd = L % 8, off = L / 8;
        const int wgid = (xcd < r ? xcd * (q + 1) : r * (q + 1) + (xcd - r) * q) + off;
        const int mtg = wgid / NPN, pn = wgid % NPN;
        int e = 0;
        for (int k = 1; k < NE; ++k) if ((int)tb[k] <= mtg) e = k;
        const int mtl = mtg - (int)tb[e]; int valid = (int)lc[e] - mtl * 256; if (valid > 256) valid = 256;
        ut[tid * 8 + 0] = e; ut[tid * 8 + 1] = mtl; ut[tid * 8 + 2] = pn; ut[tid * 8 + 3] = mtg; ut[tid * 8 + 4] = valid;
    }
    __syncthreads();
    if (gather) {
        LAS unsigned* offs = (LAS unsigned*)(lds + L_OFFS);
        for (int idx = tid; idx < n_my * 256; idx += 512) { const int u = idx >> 8, r = idx & 255; const int e = ut[u * 8 + 0], mtl = ut[u * 8 + 1], valid = ut[u * 8 + 4];
            const int tok = (r < valid) ? tok_list[e * S + mtl * 256 + r] : 0;
            offs[idx] = (unsigned)tok * (unsigned)rowbytes; }
        __syncthreads();
    }
    return n_my;
}

__global__ void __launch_bounds__(512, 2) fwd_kernel(Args args) {
    extern __shared__ __attribute__((aligned(16))) unsigned char lds_[];
    LAS unsigned char* lds = (LAS unsigned char*)lds_;
    const int wave = __builtin_amdgcn_readfirstlane(threadIdx.x >> 6);
    const int G = gridDim.x, bid = blockIdx.x;
#define PHASE_IDS const int lane = fresh_lane(), tid = wave * 64 + lane; (void)tid; (void)lane
    const int gw = bid * 8 + wave, NGW = G * 8;
    unsigned char* ws = args.ws;
    unsigned* ctl = (unsigned*)(ws + WS_CTL);
    const float* x = args.in[0]; const float* cvec = args.in[1]; const float* ctx = args.in[2]; const float* cctx = args.in[3];
    const float* ada_w = args.in[4]; const float* ada_b = args.in[5]; const float* norm_mix = args.in[6]; const float* norm_ffn = args.in[7];
    const float* w_qkv = args.in[8]; const float* q_g = args.in[9]; const float* k_g = args.in[10]; const float* w_o = args.in[11];
    const float* pool_w = args.in[12]; const float* pool_scale = args.in[13]; const float* router_w = args.in[14]; const float* router_b = args.in[15];
    const float* w_gu = args.in[16]; const float* b_gu = args.in[17]; const float* w_down = args.in[18]; const float* b_down = args.in[19]; const float* final_norm = args.in[20];
    float* MOD = (float*)(ws + WS_MOD);
    bf16* WF = (bf16*)(ws + WS_MOD + 131072);
    unsigned char* Wqkv8 = ws + WS_WQKV;
    bf16* Wo_t = (bf16*)(ws + WS_WO);
    bf16* Wpool_t = (bf16*)(ws + WS_WPOOL);
    unsigned char* Wgu8 = ws + WS_WGU; unsigned char* Wd8 = ws + WS_WD;
    unsigned char* H8 = ws + WS_H; unsigned char* ACT8 = ws + WS_ACT;
    int* tok_list = (int*)(ws + WS_TOKLIST); int* tok_e = (int*)(ws + WS_TOKE); int* tok_pos = (int*)(ws + WS_TOKP); float* tok_w = (float*)(ws + WS_TOKW);
    bf16* QKV = (bf16*)(ws + WS_QKV); bf16* O = (bf16*)(ws + WS_O);
    unsigned char* Q8 = ws + WS_Q8; unsigned char* K8 = ws + WS_K8; unsigned char* VT8 = ws + WS_VT8;
    bf16* XA = (bf16*)(ws + WS_XA); bf16* XB = (bf16*)(ws + WS_XB); bf16* XC = (bf16*)(ws + WS_XC);
    bf16* H1B = (bf16*)(ws + WS_POOLED);
    bf16* YZ = (bf16*)(ws + WS_H1F);
    bf16* Y = (bf16*)(ws + WS_Y);

    if (threadIdx.x < 16) ((LAS unsigned*)(lds + MISC_OFF))[threadIdx.x] = 0u;
    __syncthreads();
    XcdBarrier bar; bar.bar = ctl + CW_BAR; bar.x = 0; bar.st = nullptr; bar.wave = wave;
    if (MK_N_LAUNCHES == 1) bar = xcd_barrier_post(ctl + CW_BAR, (volatile LAS unsigned*)(lds + MISC_OFF), wave);
    const int lo = args.ph_lo, hi = args.ph_hi;
#ifndef PHASE_MASK
#define PHASE_MASK 0xFFFF
#endif
#define IN(k) ((((PHASE_MASK) >> (k)) & 1) && lo <= (k) && (k) < hi)
#define SEAM(k) do { if (IN(k) && IN((k) + 1)) xcd_barrier(bar); } while (0)

    if (IN(PH_PRO)) { PHASE_IDS;
        {
            LAS float* sl = (LAS float*)lds; LAS float* scx = sl + 1024; LAS float* part = sl + 2048;
            for (int i = tid; i < 1024; i += 512) { const float a = cvec[i], b = cctx[i]; sl[i] = a / (1.0f + __expf(-a)); scx[i] = b / (1.0f + __expf(-b)); }
            __syncthreads();
            for (int t = bid; t < 192; t += G) {
                const int layer = t / 96, cb = t % 96, n = cb * 64 + lane;
                const float* Wp = ada_w + (size_t)layer * 1024 * 6144 + (size_t)(wave * 128) * 6144 + n;
                float a0 = 0.f, a1 = 0.f;
#pragma unroll 16
                for (int k = 0; k < 128; ++k) { const float w = Wp[(size_t)k * 6144]; a0 += sl[wave * 128 + k] * w; a1 += scx[wave * 128 + k] * w; }
                part[wave * 64 + lane] = a0; part[512 + wave * 64 + lane] = a1;
                __syncthreads();
                if (tid < 128) { const int which = tid >> 6, l = tid & 63; float s = 0.f;
#pragma unroll
                    for (int w = 0; w < 8; ++w) s += part[which * 512 + w * 64 + l];
                    const int nn = cb * 64 + l; s += ada_b[layer * 6144 + nn];
                    if (which == 0) MOD[layer * 6144 + nn] = s; else if (layer == 0 && nn < 2048) MOD[12288 + nn] = s; }
                __syncthreads();
            }
        }
        for (int idx = bid * 512 + tid; idx < 65536; idx += G * 512) {
            const int j = idx & 7, ln = (idx >> 3) & 63, ks = (idx >> 9) & 15, kh = (idx >> 13) & 1, et = (idx >> 14) & 1, l = idx >> 15;
            const int e = et * 16 + (ln & 15), k = kh * 512 + ks * 32 + 8 * (ln >> 4) + j; const float w = router_w[(size_t)l * 32768 + k * 32 + e];
            const unsigned hi = cvt_pk_bf16(w, w) & 0xffffu; const float r_ = w - bf_lo(hi); const unsigned lo = cvt_pk_bf16(r_, r_) & 0xffffu;
            const size_t base = ((size_t)((((l * 2 + et) * 2 + kh) * 16 + ks) * 2) * 64 + ln) * 8 + j;
            WF[base] = (bf16)hi; WF[base + 512] = (bf16)lo; }
        {
            LAS float* scr = (LAS float*)(lds + wave * 16384);
            constexpr int I_GU = 64 * 16 * 64, I_D = 64 * 16 * 32, I_QKV = 16 * 48, I_O = 16 * 32, I_P = 4 * 4 * 8;
            const float gqm_ = wave_max(fmaxf(fabsf(q_g[lane]), fabsf(q_g[64 + lane]))), gkm_ = wave_max(fmaxf(fabsf(k_g[lane]), fabsf(k_g[64 + lane])));
            const bool attn_fast_ = (HD * gqm_ * gkm_ * att::SCALE * 1.4426950408889634f * 1.02f) < 26.0f;
            const int NITEMS = I_QKV + I_O + I_P;
            if (!attn_fast_) { const WConv wc_{w_gu, w_down, Wgu8, Wd8}; for (int q = bid; q < WQ_N; q += G) wquad_whole(wc_, q, tid); }
            for (int it = gw; it < NITEMS; it += NGW) {
                int r = it;
                if (r < I_QKV) { const int kb = r / 48, nb = r % 48; transpose_item_fp8(w_qkv, NQKV, kb * 64, nb * 32, Wqkv8 + (size_t)(nb * 32) * 1024 + kb * 64, 1024, scr, lane, WSCALE); continue; } r -= I_QKV;
                if (r < I_O) { const int kb = r / 32, nb = r % 32; transpose_item(w_o, 1024, kb * 64, nb * 32, Wo_t + (size_t)(nb * 32) * 1024 + kb * 64, 1024, scr, lane); continue; } r -= I_O;
                if (r < I_P) { const int g = r / 32, kb = (r % 32) / 8, nb = r % 8; transpose_item(pool_w + (size_t)g * 65536, 256, kb * 64, nb * 32, Wpool_t + (size_t)g * 65536 + (size_t)(nb * 32) * 256 + kb * 64, 256, scr, lane); continue; } r -= I_P;
            }
        }
        __syncthreads();
    }
    SEAM(PH_PRO);

    if (IN(PH_NORM1)) { PHASE_IDS;
        f32x4 av[4], bv[4];
#pragma unroll
        for (int j = 0; j < 4; ++j) { const int col = 4 * lane + 256 * j; const f32x4 g = *(const f32x4*)(norm_mix + col); av[j] = g * (1.0f + *(const f32x4*)(MOD + 1024 + col)); bv[j] = *(const f32x4*)(MOD + col); }
        for (int r = gw; r < S; r += NGW) { f32x4 v[4]; ld_row(x + (size_t)r * D, lane, v); const float rs = row_rstd(v);
#pragma unroll
            for (int j = 0; j < 4; ++j) v[j] = v[j] * rs * av[j] + bv[j];
            st_row_fp8(H8 + (size_t)r * D, lane, v); }
#pragma unroll
        for (int j = 0; j < 4; ++j) { const int col = 4 * lane + 256 * j; const f32x4 g = *(const f32x4*)(norm_mix + col); av[j] = g * (1.0f + *(const f32x4*)(MOD + 12288 + 1024 + col)); bv[j] = *(const f32x4*)(MOD + 12288 + col); }
        for (int r = gw; r < CT; r += NGW) { f32x4 v[4]; ld_row(ctx + (size_t)r * D, lane, v); const float rs = row_rstd(v);
#pragma unroll
            for (int j = 0; j < 4; ++j) v[j] = v[j] * rs * av[j] + bv[j];
            st_row_fp8(H8 + (size_t)(S + r) * D, lane, v); }
    }
    SEAM(PH_NORM1);

    if (IN(PH_QKV)) { PHASE_IDS;
        pg8::ProbDense<1> P; P.init(H8, Wqkv8, NTOK, NQKV, D, D, D, 0, G, bid);
        pg8::EpiBf16 E{QKV, NQKV, nullptr, 0, 1.0f / WSCALE};
        pg8::gemm_phase(lds, P, E, wave);
    }
    SEAM(PH_QKV);

    if (IN(PH_QKROPE)) { PHASE_IDS;
        const int sub = lane >> 4, j16 = lane & 15, part = j16 >> 3, i0 = 4 * (j16 & 7);
        constexpr int NIT = (S * 10) / 4 + (CT * 2) / 4;
        for (int it = gw; it < NIT; it += NGW) {
            const int idx = it * 4 + sub; const bool lat = idx < S * 10; int row, head;
            if (lat) { row = idx / 10; head = idx - row * 10; } else { const int i2 = idx - S * 10; row = S + (i2 >> 1); head = 8 + (i2 & 1); }
            bf16* p = QKV + (size_t)row * NQKV + head * HD + 64 * part + i0;
            const v2u a = *(const v2u*)p, b = *(const v2u*)(p + 32);
            float x1[4] = {bf_lo(a.x), bf_hi(a.x), bf_lo(a.y), bf_hi(a.y)}, x2[4] = {bf_lo(b.x), bf_hi(b.x), bf_lo(b.y), bf_hi(b.y)};
            float ss = 0.f;
#pragma unroll
            for (int i = 0; i < 4; ++i) ss += x1[i] * x1[i] + x2[i] * x2[i];
            ss += __shfl_xor(ss, 1); ss += __shfl_xor(ss, 2); ss += __shfl_xor(ss, 4); ss += __shfl_xor(ss, 8);
            const float rs = (1.0f / sqrtf(ss * (1.0f / HD) + NORM_EPS)) * (head < 8 ? att::SCALE * 1.4426950408889634f : 1.0f);
            const float* gp = (head < 8 ? q_g : k_g) + 64 * part + i0;
            const f32x4 g1 = *(const f32x4*)gp, g2 = *(const f32x4*)(gp + 32);
            float o1[4], o2[4];
#pragma unroll
            for (int i = 0; i < 4; ++i) { const float y1 = x1[i] * rs * g1[i], y2 = x2[i] * rs * g2[i];
                if (lat) { const float pos = (float)(part ? (row & (GRID_W - 1)) : (row / GRID_W));
                    const float invf = exp2f(-(float)(i0 + i) * (13.287712379549449f / 32.0f));
                    const float ang = pos * invf; const float sn = __sinf(ang), cs = __cosf(ang);
                    o1[i] = y1 * cs - y2 * sn; o2[i] = y2 * cs + y1 * sn; }
                else { o1[i] = y1; o2[i] = y2; } }
            v2u wa, wb; wa.x = cvt_pk_bf16(o1[0], o1[1]); wa.y = cvt_pk_bf16(o1[2], o1[3]); wb.x = cvt_pk_bf16(o2[0], o2[1]); wb.y = cvt_pk_bf16(o2[2], o2[3]);
            *(v2u*)p = wa; *(v2u*)(p + 32) = wb;
            {
                unsigned char* p8 = (head < 8) ? Q8 + (size_t)row * D + head * HD + 64 * part + i0 : K8 + (size_t)row * (NKV * HD) + (head - 8) * HD + 64 * part + i0;
                if (head >= 8 || lat) { *(unsigned*)p8 = cvt_pk_fp8x4(o1[0], o1[1], o1[2], o1[3]); *(unsigned*)(p8 + 32) = cvt_pk_fp8x4(o2[0], o2[1], o2[2], o2[3]); } }
        }
        {
            LAS unsigned char* tl = lds;
            for (int it = bid; it < NKV * (NTOK / 64); it += G) { const int kvh = it & 1, tile = it >> 1;
                const int key = tid & 63, dq = tid >> 6;
                const bf16* vp = QKV + (size_t)(tile * 64 + key) * NQKV + 1280 + kvh * HD + dq * 16;
                const v4u a = *(const v4u*)vp, b = *(const v4u*)(vp + 8);
                const unsigned wv[8] = {a.x, a.y, a.z, a.w, b.x, b.y, b.z, b.w};
                const int c = key & 31, slot = 32 * ((c >> 2) & 1) + (c & 3) + 4 * (c >> 3) + 16 * (key >> 5);
#pragma unroll
                for (int i = 0; i < 8; ++i) { const unsigned pk = cvt_pk_fp8x4(bf_lo(wv[i]), bf_hi(wv[i]), 0.f, 0.f);
                    tl[(dq * 16 + 2 * i) * 64 + slot] = (unsigned char)(pk & 0xffu); tl[(dq * 16 + 2 * i + 1) * 64 + slot] = (unsigned char)((pk >> 8) & 0xffu); }
                __syncthreads();
                *(v4u*)(VT8 + ((size_t)kvh * (NTOK / 64) + tile) * 8192 + tid * 16) = *(const LAS v4u*)(tl + tid * 16);
                __syncthreads();
            }
        }
    }
    SEAM(PH_QKROPE);

    if (IN(PH_ATTN)) { PHASE_IDS;
        const float gqm = wave_max(fmaxf(fabsf(q_g[lane]), fabsf(q_g[64 + lane]))), gkm = wave_max(fmaxf(fabsf(k_g[lane]), fabsf(k_g[64 + lane])));
        const float bound = HD * gqm * gkm * att::SCALE * 1.4426950408889634f * 1.02f;
        const bool fast = bound < 26.0f;
        if (__builtin_expect(fast, 1)) {
            const float pscale = exp2f(ceilf(fmaxf(bound - 15.5f, 0.0f)));
            const WConv wc{w_gu, w_down, Wgu8, Wd8}; int ui = 0;
            for (int u = bid; u < NH * (S / 256); u += G, ++ui) { const int head = u & 7, qb = u >> 3, kvh = head >> 2;
#if PROBE_VAR
                if (args.var) att8::attn_fp8_body<PROBE_VAR>(Q8 + (size_t)(qb * 256) * D + head * HD, K8 + kvh * HD, VT8 + (size_t)kvh * (NTOK / 64) * 8192, O + (size_t)(qb * 256) * D + head * HD, NTOK / 64, lds, wave, pscale, wc, ui * (NTOK / 256) * G + bid, G); else
#endif
                att8::attn_fp8_body<0>(Q8 + (size_t)(qb * 256) * D + head * HD, K8 + kvh * HD, VT8 + (size_t)kvh * (NTOK / 64) * 8192, O + (size_t)(qb * 256) * D + head * HD, NTOK / 64, lds, wave, pscale,
                                    wc, ui * (NTOK / 256) * G + bid, G); }
            for (int q = ui * (NTOK / 256) * G + bid; q < WQ_N; q += G) wquad_whole(wc, q, tid);
        }
#ifndef NO_FALLBACK
        else {
            for (int u = bid; u < NH * (S / 256); u += G) { const int head = u & 7, qb = u >> 3, kvh = head >> 2;
                att::attn_dense_body(QKV + (size_t)(qb * 256) * NQKV + head * HD, QKV + 1024 + kvh * HD, QKV + 1280 + kvh * HD, O + (size_t)(qb * 256) * D + head * HD, NTOK, (LAS char*)lds, wave); }
        }
#endif
    }
    SEAM(PH_ATTN);


#ifdef SELFCHECK
    if (IN(PH_WO)) { PHASE_IDS;
        LAS float* sc_ = (LAS float*)lds; LAS float* qf = sc_ + NTOK; LAS float* red = qf + 128; LAS float* misc = red + 512;
        {
            const int t = (bid * 61 + 7) & (S - 1), h = bid & 7, kvh = h >> 2;
            const bf16* qp = QKV + (size_t)t * NQKV + h * HD;
            if (tid < 128) qf[tid] = bf_lo((unsigned)qp[tid]);
            __syncthreads();
            float mx = -1e30f;
            for (int k = tid; k < NTOK; k += 512) { const bf16* kp = QKV + (size_t)k * NQKV + 1024 + kvh * HD; float a = 0.f;
#pragma unroll 4
                for (int d = 0; d < 128; d += 2) { const unsigned w = *(const unsigned*)(kp + d); a += qf[d] * bf_lo(w) + qf[d + 1] * bf_hi(w); }
                sc_[k] = a; mx = fmaxf(mx, a); }
            mx = wave_max(mx); if (lane == 0) misc[wave] = mx; __syncthreads();
            mx = misc[0]; for (int w = 1; w < 8; ++w) mx = fmaxf(mx, misc[w]);
            __syncthreads();
            float ls = 0.f;
            for (int k = tid; k < NTOK; k += 512) { const float p = exp2f(sc_[k] - mx); sc_[k] = p; ls += p; }
            ls = wave_sum(ls); if (lane == 0) misc[8 + wave] = ls; __syncthreads();
            ls = 0.f; for (int w = 0; w < 8; ++w) ls += misc[8 + w];
            const int d = tid & 127, part = tid >> 7; float acc = 0.f;
            for (int k = part; k < NTOK; k += 4) acc += sc_[k] * bf_lo((unsigned)QKV[(size_t)k * NQKV + 1280 + kvh * HD + d]);
            red[part * 128 + d] = acc; __syncthreads();
            if (tid < 128) { const float ref = (red[d] + red[128 + d] + red[256 + d] + red[384 + d]) / ls; const float got = bf_lo((unsigned)O[(size_t)t * D + h * HD + d]);
                float am = fabsf(ref); for (int o = 32; o >= 1; o >>= 1) am = fmaxf(am, __shfl_xor(am, o)); misc[16 + (tid >> 6)] = am; }
            __syncthreads();
            if (tid < 128) { const float ref = (red[d] + red[128 + d] + red[256 + d] + red[384 + d]) / ls; const float got = bf_lo((unsigned)O[(size_t)t * D + h * HD + d]);
                const float am = fmaxf(misc[16], misc[17]); if (!(fabsf(got - ref) <= 0.02f * am + 1e-7f)) atomicOr(ctl + 2, 1u); }
            __syncthreads();
        }
        {
            const int t = (bid * 97 + 13) % NTOK, h = (t >= S) ? 8 + (bid & 1) : (bid % 10);
            const int d = tid & 127, kq = tid >> 7; float a = 0.f;
            const unsigned char* hp = H8 + (size_t)t * D + kq * 256; const unsigned char* wp = Wqkv8 + (size_t)(h * HD + d) * D + kq * 256;
#pragma unroll 4
            for (int k = 0; k < 256; ++k) a += __builtin_amdgcn_cvt_f32_fp8((int)hp[k], 0) * __builtin_amdgcn_cvt_f32_fp8((int)wp[k], 0) * (1.0f / WSCALE);
            red[kq * 128 + d] = a; __syncthreads();
            if (tid < 128) qf[d] = red[d] + red[128 + d] + red[256 + d] + red[384 + d];
            __syncthreads();
            if (tid < 128) { float ss = 0.f;
#pragma unroll 4
                for (int i = 0; i < 128; ++i) ss += qf[i] * qf[i];
                const float rs = 1.0f / sqrtf(ss * (1.0f / HD) + NORM_EPS); const float* gp = h < 8 ? q_g : k_g;
                const int idx = d & 63, pr = d >> 6, fi = idx & 31; const float y = qf[d] * rs * gp[d]; float out = y;
                if (t < S) { const int dp = (idx < 32) ? d + 32 : d - 32; const float yp = qf[dp] * rs * gp[dp];
                    const double pos = (double)(pr ? (t & 63) : (t >> 6)); const double ang = pos * (double)exp2f(-(float)fi * (13.287712379549449f / 32.0f));
                    const double rr = ang - 6.283185307179586 * rint(ang * 0.15915494309189535); const float sn = __sinf((float)rr), cs = __cosf((float)rr);
                    out = (idx < 32) ? (y * cs - yp * sn) : (y * cs + yp * sn); }
                if (h < 8) out *= att::SCALE * 1.4426950408889634f;
                const float got = bf_lo((unsigned)QKV[(size_t)t * NQKV + h * HD + d]);
                float am = fabsf(out); for (int o = 32; o >= 1; o >>= 1) am = fmaxf(am, __shfl_xor(am, o));
                if (!(fabsf(got - out) <= 0.03f * am + 1e-7f)) atomicOr(ctl + 2, 2u); }
            __syncthreads();
        }
    }
#endif
    if (IN(PH_WO)) { PHASE_IDS;
        pg8::ProbDense<2> P; P.init(O, Wo_t, S, D, D, D, D, 0, G, bid);
        pg8::EpiBf16 E{YZ, D, nullptr, 0, 1.0f};
        pg8::gemm_phase(lds, P, E, wave);
    }
    SEAM(PH_WO);

#define ZLD2(U, J) (*(const v2u*)(YZ + (size_t)(U) * D + 4 * lane + 256 * (J)))
#define BF4(z_) ((f32x4){bf_lo((z_).x), bf_hi((z_).x), bf_lo((z_).y), bf_hi((z_).y)})
#define RDECL0 v2u ya[4][4]
#define RLD0(I, ROW, V) do { ld_row(x + (size_t)(ROW) * D, lane, V); _Pragma("unroll") for (int j = 0; j < 4; ++j) ya[I][j] = ZLD2(ROW, j); } while (0)
#define RFIN0(I, ROW, V) do { _Pragma("unroll") for (int j = 0; j < 4; ++j) { const f32x4 g_ = *(const f32x4*)(MOD + 2 * 1024 + 4 * lane + 256 * j); V[j] += g_ * BF4(ya[I][j]); } \
        st_row_bf16(XA + (size_t)(ROW) * D, lane, V); } while (0)
#define RINIT0(T0) do { } while (0)
#define RDECL1 v2u zt[4][4], za[4][4], zo[4][4]
#define RINIT1(T0) do { const int t0_ = (T0);        \
        _Pragma("unroll") for (int j = 0; j < 4; ++j) { zs[j] = (f32x4){0.f, 0.f, 0.f, 0.f}; \
            _Pragma("unroll") for (int d_ = -(1 << j); d_ < (1 << j); ++d_) { const int u_ = t0_ + d_; const bool ok_ = u_ >= 0 && u_ < S; const v2u z_ = ZLD2(ok_ ? u_ : t0_, j); zs[j] += BF4(z_) * (ok_ ? 1.0f : 0.0f); } } } while (0)
#define RLD1(I, ROW, V) do { ld_row_bf16(XB + (size_t)(ROW) * D, lane, V); \
        _Pragma("unroll") for (int j = 0; j < 4; ++j) { const int half_ = 1 << j, ia_ = (ROW) + half_, is_ = (ROW) - half_; \
            zt[I][j] = ZLD2(ROW, j); za[I][j] = ZLD2(ia_ < S ? ia_ : S - 1, j); zo[I][j] = ZLD2(is_ > 0 ? is_ : 0, j); } } while (0)
#define RFIN1(I, ROW, V) do { \
        _Pragma("unroll") for (int j = 0; j < 4; ++j) { const int half_ = 1 << j, t_ = (ROW); int lo_ = t_ - half_; if (lo_ < 0) lo_ = 0; int hi_ = t_ + half_; if (hi_ > S) hi_ = S; \
            const int ia_ = t_ + half_, is_ = t_ - half_;                       \
            const f32x4 p_ = zs[j] * (1.0f / (float)(hi_ - lo_)) - BF4(zt[I][j]); \
            const f32x4 g_ = *(const f32x4*)(MOD + 6144 + 2 * 1024 + 4 * lane + 256 * j) * *(const f32x4*)(pool_scale + 4 * lane + 256 * j); \
            V[j] += g_ * p_; zs[j] += BF4(za[I][j]) * (ia_ < S ? 1.0f : 0.0f) - BF4(zo[I][j]) * (is_ >= 0 ? 1.0f : 0.0f); } \
        st_row_bf16(XC + (size_t)(ROW) * D, lane, V); } while (0)
#define ROUTE_PHASE(LAYER, RDECL, RLD, RFIN, RINIT, RG) do { \
        const float* modp = MOD + (LAYER) * 6144; const float* gn = norm_ffn + (LAYER) * 1024; const float* rb = router_b + (LAYER) * 32; \
        unsigned* gcnt = ctl + CW_CNT + (LAYER) * 2048; \
        LAS unsigned* lcnt = (LAS unsigned*)(lds + L_LCNT); LAS unsigned* lbase = (LAS unsigned*)(lds + L_LBASE); \
        LAS int* ent_e = (LAS int*)(lds + L_ENT); LAS int* ent_p = ent_e + 256; LAS float* ent_w = (LAS float*)(ent_e + 512); \
        LAS float* part = (LAS float*)(lds + L_OFFS); LAS float* lgt = part + 2048;          \
        f32x4 av[4], bv[4]; \
        _Pragma("unroll") for (int j = 0; j < 4; ++j) { const int col = 4 * lane + 256 * j; const f32x4 g = *(const f32x4*)(gn + col); av[j] = g * (1.0f + *(const f32x4*)(modp + 4 * 1024 + col)); bv[j] = *(const f32x4*)(modp + 3 * 1024 + col); } \
        const int et = wave & 1, rt = (wave >> 1) & 1, kh = wave >> 2; \
        const bf16* wf = WF + ((size_t)((((LAYER) * 2 + et) * 2 + kh) * 16) * 2 * 64 + lane) * 8;       \
        const int brow = rt * 16 + (lane & 15), bkq = lane >> 4; \
        for (int c0 = bid; c0 < S / 32; c0 += 2 * G) { \
          if (tid < 32) lcnt[tid] = 0u; \
          for (int cs = 0; cs < 2; ++cs) { const int chunk = c0 + cs * G; if (chunk >= S / 32) break;        \
            f32x4 zs[4]; (void)zs; RINIT(chunk * 32 + wave * 4); \
            f32x4 hr[4][4]; RDECL; \
            _Pragma("unroll") for (int g_ = 0; g_ < 4; g_ += (RG)) {        \
                _Pragma("unroll") for (int i = g_; i < g_ + (RG); ++i) RLD(i, chunk * 32 + wave * 4 + i, hr[i]); \
                _Pragma("unroll") for (int i = g_; i < g_ + (RG); ++i) RFIN(i, chunk * 32 + wave * 4 + i, hr[i]); } \
            _Pragma("unroll") for (int i = 0; i < 4; ++i) { \
                const int rl = wave * 4 + i, row = chunk * 32 + rl; \
                f32x4 (&h)[4] = hr[i]; \
                const float rs = row_rstd(h); \
                _Pragma("unroll") for (int j = 0; j < 4; ++j) h[j] = h[j] * rs * av[j] + bv[j]; \
                st_row_fp8(H8 + (size_t)row * D, lane, h); \
                _Pragma("unroll") for (int j = 0; j < 4; ++j) { v2u hi_; hi_.x = cvt_pk_bf16(h[j][0], h[j][1]); hi_.y = cvt_pk_bf16(h[j][2], h[j][3]); \
                    const f32x4 r_ = h[j] - (f32x4){bf_lo(hi_.x), bf_hi(hi_.x), bf_lo(hi_.y), bf_hi(hi_.y)}; v2u lo_; lo_.x = cvt_pk_bf16(r_[0], r_[1]); lo_.y = cvt_pk_bf16(r_[2], r_[3]); \
                    const int off_ = rl * 2048 + ((((lane >> 1) + 32 * j) ^ (rl & 15)) << 4) + (lane & 1) * 8; \
                    *(LAS v2u*)(lds + off_) = hi_; *(LAS v2u*)(lds + 65536 + off_) = lo_; } \
            } \
            __syncthreads(); \
            { f32x4 acc_ = (f32x4){0.f, 0.f, 0.f, 0.f}; \
              _Pragma("unroll 4") for (int ks = 0; ks < 16; ++ks) { \
                  const bf16x8 ahi = *(const bf16x8*)(wf + (size_t)(ks * 2) * 512), alo = *(const bf16x8*)(wf + (size_t)(ks * 2 + 1) * 512); \
                  const int boff = brow * 2048 + ((((kh * 512 + ks * 32) >> 3) + bkq) ^ (brow & 15)) * 16; \
                  const bf16x8 bhi = *(const LAS bf16x8*)(lds + boff), blo = *(const LAS bf16x8*)(lds + 65536 + boff); \
                  acc_ = __builtin_amdgcn_mfma_f32_16x16x32_bf16(ahi, bhi, acc_, 0, 0, 0); acc_ = __builtin_amdgcn_mfma_f32_16x16x32_bf16(ahi, blo, acc_, 0, 0, 0); acc_ = __builtin_amdgcn_mfma_f32_16x16x32_bf16(alo, bhi, acc_, 0, 0, 0); } \
              _Pragma("unroll") for (int r = 0; r < 4; ++r) part[wave * 256 + (4 * (lane >> 4) + r) * 16 + (lane & 15)] = acc_[r]; } \
            __syncthreads(); \
            _Pragma("unroll") for (int o_ = 0; o_ < 2; ++o_) { const int idx = tid + 512 * o_, row_ = idx >> 5, e_ = idx & 31; const int w0_ = (e_ >> 4) + 2 * (row_ >> 4), pi_ = (e_ & 15) * 16 + (row_ & 15); \
                lgt[row_ * 33 + e_] = part[w0_ * 256 + pi_] + part[(w0_ + 4) * 256 + pi_] + rb[e_]; } \
            __syncthreads(); \
            if (tid < 32) { const LAS float* lr = lgt + tid * 33; int se[4]; float sv[4]; float lg_[32];        \
                _Pragma("unroll") for (int e = 0; e < 32; ++e) lg_[e] = lr[e]; \
                _Pragma("unroll") for (int k = 0; k < 4; ++k) { float mx = lg_[0]; int me = 0; \
                    _Pragma("unroll") for (int e = 1; e < 32; ++e) { const bool c_ = lg_[e] > mx; mx = c_ ? lg_[e] : mx; me = c_ ? e : me; } \
                    se[k] = me; sv[k] = mx; \
                    if (k < 3) { _Pragma("unroll") for (int e = 0; e < 32; ++e) lg_[e] = (e == me) ? -INFINITY : lg_[e]; } } \
                const float e1 = __expf(sv[1] - sv[0]), e2 = __expf(sv[2] - sv[0]), e3 = __expf(sv[3] - sv[0]); const float inv = 1.0f / (1.0f + e1 + e2 + e3); \
                const float ww[4] = {inv, e1 * inv, e2 * inv, e3 * inv}; \
                _Pragma("unroll") for (int k = 0; k < 4; ++k) { const unsigned pl = __hip_atomic_fetch_add(lcnt + se[k], 1u, __ATOMIC_RELAXED, __HIP_MEMORY_SCOPE_WORKGROUP); \
                    const int ei = (cs * 32 + tid) * 4 + k; ent_e[ei] = se[k]; ent_p[ei] = (int)pl; ent_w[ei] = ww[k]; } } \
            __syncthreads(); \
          } \
          if (tid < 32) { const unsigned c_ = lcnt[tid]; unsigned base = 0u; if (c_) base = __hip_atomic_fetch_add(gcnt + 64 * tid, c_, RLX_AGENT); lbase[tid] = base; } \
          __syncthreads(); \
          if (tid < 256) { const int cs = tid >> 7, rl = (tid >> 2) & 31; const int chunk = c0 + cs * G; \
              if (chunk < S / 32) { const int e = ent_e[tid]; const int pos = (int)lbase[e] + ent_p[tid]; const int tok = chunk * 32 + rl; \
                  tok_list[e * S + pos] = tok; tok_e[tok * 4 + (tid & 3)] = e; tok_pos[tok * 4 + (tid & 3)] = pos; tok_w[tok * 4 + (tid & 3)] = ent_w[tid]; } } \
          __syncthreads(); \
        } } while (0)

#define MOE1_PHASE(LAYER) do { \
        const int n_my = moe_build_units(lds, ctl + CW_CNT + (LAYER) * 2048, tok_list, 8, true, D, G, bid, tid); \
        pg8::ProbMoE<true, 1> P{H8, Wgu8 + (size_t)(LAYER) * 32 * 2048 * 1024, D, D, n_my, (size_t)2048 * 1024, lds, 2048}; \
        pg8::EpiSwiglu E{ACT8, b_gu + (size_t)(LAYER) * 32 * 2048, 1.0f / WSCALE}; \
        pg8::gemm_phase(lds, P, E, wave); } while (0)
#define MOE2_PHASE(LAYER) do { \
        const int n_my = moe_build_units(lds, ctl + CW_CNT + (LAYER) * 2048, tok_list, 4, false, D, G, bid, tid); \
        pg8::ProbMoE<false, 1> P{ACT8, Wd8 + (size_t)(LAYER) * 32 * 1024 * 1024, D, D, n_my, (size_t)1024 * 1024, lds, 1024}; \
        pg8::EpiBf16 E{Y, D, b_down + (size_t)(LAYER) * 32 * 1024, 1024, 1.0f / WSCALE}; \
        pg8::gemm_phase(lds, P, E, wave); } while (0)
#define COMBINE_ROW(LAYER, XIN, ROW, V) do { \
        ld_row_bf16((XIN) + (size_t)(ROW) * D, lane, V); \
        const v4i te = *(const v4i*)(tok_e + (ROW) * 4), tp = *(const v4i*)(tok_pos + (ROW) * 4); const f32x4 tw = *(const f32x4*)(tok_w + (ROW) * 4); \
        f32x4 a_[4]; _Pragma("unroll") for (int j = 0; j < 4; ++j) a_[j] = (f32x4){0.f, 0.f, 0.f, 0.f}; \
        _Pragma("unroll") for (int k = 0; k < 4; ++k) { const int e = __builtin_amdgcn_readfirstlane(te[k]); const int pos = __builtin_amdgcn_readfirstlane(tp[k]); const float w = tw[k]; \
            const int prow = (int)__builtin_amdgcn_readlane(tbv, e) * 256 + pos; const bf16* yr = Y + (size_t)prow * D; \
            _Pragma("unroll") for (int j = 0; j < 4; ++j) { const v2u y = *(const v2u*)(yr + 4 * lane + 256 * j); a_[j] += w * (f32x4){bf_lo(y.x), bf_hi(y.x), bf_lo(y.y), bf_hi(y.y)}; } } \
        _Pragma("unroll") for (int j = 0; j < 4; ++j) V[j] = V[j] + gfv[j] * a_[j]; } while (0)
#define TILE_BASE(LAYER) \
        int tbv; { const unsigned cnt = (lane < NE) ? __hip_atomic_load(ctl + CW_CNT + (LAYER) * 2048 + 64 * lane, RLX_AGENT) : 0u; unsigned incl = (cnt + 255u) >> 8; const unsigned own = incl; \
            _Pragma("unroll") for (int o = 1; o < 32; o <<= 1) { const unsigned t = __shfl_up(incl, o); if (lane >= o) incl += t; } tbv = (int)(incl - own); }

    if (IN(PH_ROUTE0)) { PHASE_IDS; ROUTE_PHASE(0, RDECL0, RLD0, RFIN0, RINIT0, 4); }
    SEAM(PH_ROUTE0);
    if (IN(PH_MOE1_0)) { PHASE_IDS; MOE1_PHASE(0); }
    SEAM(PH_MOE1_0);
    if (IN(PH_MOE2_0)) { PHASE_IDS; MOE2_PHASE(0); }
    SEAM(PH_MOE2_0);

    if (IN(PH_COMB0)) { PHASE_IDS;
        TILE_BASE(0)
        f32x4 gfv[4], av[4], bv[4];
#pragma unroll
        for (int j = 0; j < 4; ++j) { const int col = 4 * lane + 256 * j; gfv[j] = *(const f32x4*)(MOD + 5 * 1024 + col);
            const f32x4 g = *(const f32x4*)(norm_mix + 1024 + col); av[j] = g * (1.0f + *(const f32x4*)(MOD + 6144 + 1024 + col)); bv[j] = *(const f32x4*)(MOD + 6144 + col); }
        for (int r = gw; r < S; r += NGW) { f32x4 v[4]; COMBINE_ROW(0, XA, r, v);
            st_row_bf16(XB + (size_t)r * D, lane, v); const float rs = row_rstd(v);
#pragma unroll
            for (int j = 0; j < 4; ++j) v[j] = v[j] * rs * av[j] + bv[j];
            st_row_bf16(H1B + (size_t)r * D, lane, v); }
    }
    SEAM(PH_COMB0);

    if (IN(PH_POOLG)) { PHASE_IDS;
        pg8::ProbDense<2> P; P.init(H1B, Wpool_t, S, D, 256, D, 256, 256, G, bid);
        pg8::EpiBf16 E{YZ, D, nullptr, 0, 1.0f};
        pg8::gemm_phase(lds, P, E, wave);
    }
    SEAM(PH_POOLG);

    if (IN(PH_ROUTE1)) { PHASE_IDS; ROUTE_PHASE(1, RDECL1, RLD1, RFIN1, RINIT1, 2); }
    SEAM(PH_ROUTE1);
    if (IN(PH_MOE1_1)) { PHASE_IDS; MOE1_PHASE(1); }
    SEAM(PH_MOE1_1);
    if (IN(PH_MOE2_1)) { PHASE_IDS; MOE2_PHASE(1); }
    SEAM(PH_MOE2_1);

    if (IN(PH_FINAL)) { PHASE_IDS;
        TILE_BASE(1)
        f32x4 gfv[4], fv[4];
#pragma unroll
        for (int j = 0; j < 4; ++j) { const int col = 4 * lane + 256 * j; gfv[j] = *(const f32x4*)(MOD + 6144 + 5 * 1024 + col); fv[j] = *(const f32x4*)(final_norm + col); }
        for (int r = gw; r < S; r += NGW) { f32x4 v[4]; COMBINE_ROW(1, XC, r, v);
            const float rs = row_rstd(v);
#pragma unroll
            for (int j = 0; j < 4; ++j) v[j] = v[j] * rs * fv[j];
#ifdef SELFCHECK
            if (__hip_atomic_load(ctl + 2, RLX_AGENT) != 0u) { for (int j = 0; j < 4; ++j) v[j] = (f32x4){__builtin_nanf(""), __builtin_nanf(""), __builtin_nanf(""), __builtin_nanf("")}; }
#endif
            st_row(args.out + (size_t)r * D, lane, v); }
    }
#undef IN
#undef SEAM
}

extern "C" void kernel_launch(void* const* d_in, const int* in_sizes, int n_in, void* d_out, int out_size, void* d_ws, size_t ws_size, hipStream_t stream) {
    static int grid = 0;
    if (grid == 0) {
        if (n_in != 21 || in_sizes[0] != S * D || out_size != S * D || ws_size < WS_END) { fprintf(stderr, "kernel_launch: unexpected shapes (n_in %d, in0 %d, out %d, ws %zu)\n", n_in, n_in > 0 ? in_sizes[0] : -1, out_size, ws_size); grid = -1; return; }
        int dev = 0, cus = 0, per_cu = 0;
        if (hipGetDevice(&dev) != hipSuccess || hipDeviceGetAttribute(&cus, hipDeviceAttributeMultiprocessorCount, dev) != hipSuccess) { grid = -1; return; }
        if (hipFuncSetAttribute((const void*)fwd_kernel, hipFuncAttributeMaxDynamicSharedMemorySize, LDS_BYTES) != hipSuccess) { fprintf(stderr, "kernel_launch: hipFuncSetAttribute failed\n"); grid = -1; return; }
        if (hipOccupancyMaxActiveBlocksPerMultiprocessor(&per_cu, (const void*)fwd_kernel, 512, LDS_BYTES) != hipSuccess || per_cu < 1) { fprintf(stderr, "kernel_launch: occupancy query says %d\n", per_cu); }
        (void)hipGetLastError();
        grid = cus;
    }
    if (grid < 0) return;
    if (hipMemsetAsync((char*)d_ws + WS_CTL, 0, CTL_ZERO_BYTES, stream) != hipSuccess) return;
    Args a{};
    for (int i = 0; i < 21; ++i) a.in[i] = (const float*)d_in[i];
    a.out = (float*)d_out; a.ws = (unsigned char*)d_ws;
    if (MK_N_LAUNCHES == 1) { a.ph_lo = 0; a.ph_hi = NPHASE; hipLaunchKernelGGL(fwd_kernel, dim3(grid), dim3(512), LDS_BYTES, stream, a); }
    else for (int p = 0; p < NPHASE; ++p) { a.ph_lo = p; a.ph_hi = p + 1; hipLaunchKernelGGL(fwd_kernel, dim3(grid), dim3(512), LDS_BYTES, stream, a); }
    if (PROBE_REP >= 0) { a.ph_lo = PROBE_REP; a.ph_hi = PROBE_REP + 1; a.var = PROBE_VAR; hipLaunchKernelGGL(fwd_kernel, dim3(grid), dim3(512), LDS_BYTES, stream, a); }
    const hipError_t le = hipPeekAtLastError();
    if (le != hipSuccess) fprintf(stderr, "kernel_launch: launch failed: %s\n", hipGetErrorName(le));
}
```
